# Optimizing an MI355X kernel written in HIP

```python
import math
import jax, jax.numpy as jnp
from jax import lax
import numpy as np

D_MODEL = 4096
BATCH = 2
SEQ = 8192
DEPTH = 1

DA_HEADS = 8
DA_HEAD_DIM = 128
DA_V_DIM = 2 * DA_HEAD_DIM
MLA_HEADS = 16
MLA_Q_RANK = 1024
MLA_KV_RANK = 512
MLA_NOPE_DIM = 128
MLA_ROPE_DIM = 64
MLA_V_DIM = 128
ROPE_THETA = 10000.0
D_FF = 11008
CONV_WIDTH = 3
Q_BLOCK = 128
LN_EPS = 1e-5
RMS_EPS = 1e-6
DEEPNORM_ALPHA = (2.0 * DEPTH) ** 0.25
DEEPNORM_BETA = (8.0 * DEPTH) ** -0.25

DA_Q_COLS = DA_HEADS * 2 * DA_HEAD_DIM
DA_K_COLS = DA_HEADS * 2 * DA_HEAD_DIM
DA_V_COLS = DA_HEADS * DA_V_DIM
GATE_COLS = 2 * D_MODEL
IN_SPLITS = [DA_Q_COLS, DA_K_COLS, DA_V_COLS, MLA_Q_RANK, MLA_KV_RANK, MLA_ROPE_DIM, GATE_COLS]
IN_COLS = sum(IN_SPLITS)
IN_OFFSETS = list(np.cumsum(IN_SPLITS)[:-1])
DA_WIDTH = DA_HEADS * DA_V_DIM
MLA_WIDTH = MLA_HEADS * MLA_V_DIM

kernel_name = "hybrid_diffattn_mla_convffn_deepnorm"


def _layernorm(x, g, b):
    xf = x.astype(jnp.float32)
    mu = jnp.mean(xf, axis=-1, keepdims=True)
    var = jnp.mean(jnp.square(xf - mu), axis=-1, keepdims=True)
    return ((xf - mu) * lax.rsqrt(var + LN_EPS) * g + b).astype(x.dtype)


def _rmsnorm(x, g):
    xf = x.astype(jnp.float32)
    return (xf * lax.rsqrt(jnp.mean(jnp.square(xf), axis=-1, keepdims=True) + RMS_EPS) * g).astype(x.dtype)


def _rope(x, positions):
    half = x.shape[-1] // 2
    inv = ROPE_THETA ** (-jnp.arange(half, dtype=jnp.float32) / half)
    ang = positions.astype(jnp.float32)[..., None] * inv
    ang = ang.reshape(ang.shape[:2] + (1,) * (x.ndim - 3) + (half,))
    cos, sin = jnp.cos(ang), jnp.sin(ang)
    xf = x.astype(jnp.float32)
    x1, x2 = xf[..., :half], xf[..., half:]
    return jnp.concatenate([x1 * cos - x2 * sin, x1 * sin + x2 * cos], axis=-1).astype(x.dtype)


def _to_blocks(a):
    b, s = a.shape[:2]
    return jnp.moveaxis(a.reshape((b, s // Q_BLOCK, Q_BLOCK) + a.shape[2:]), 1, 0)


def _from_blocks(a):
    nb, b, qb = a.shape[:3]
    return jnp.moveaxis(a, 0, 1).reshape((b, nb * qb) + a.shape[3:])


def _diff_attention(q, k, v, positions, lam):
    slopes = 2.0 ** (-8.0 * jnp.arange(1, DA_HEADS + 1, dtype=jnp.float32) / DA_HEADS)
    scale = DA_HEAD_DIM ** -0.5

    def block(args):
        qb, pq = args
        s = jnp.einsum('bqhmd,bkhmd->bhmqk', qb, k).astype(jnp.float32) * scale
        dist = pq[:, :, None] - positions[:, None, :]
        distf = dist.astype(jnp.float32)[:, None, None]
        s = jnp.where(dist[:, None, None] >= 0, s - slopes[None, :, None, None, None] * distf, -jnp.inf)
        p = jax.nn.softmax(s, axis=-1)
        a = p[:, :, 0] - lam * p[:, :, 1]
        return jnp.einsum('bhqk,bkhe->bqhe', a.astype(v.dtype), v)

    return _from_blocks(lax.map(block, (_to_blocks(q), _to_blocks(positions))))


def _mla_attention(q_nope, q_rope, k_nope, k_rope, v, positions):
    scale = (MLA_NOPE_DIM + MLA_ROPE_DIM) ** -0.5

    def block(args):
        qnb, qrb, pq = args
        s = (jnp.einsum('bqhd,bkhd->bhqk', qnb, k_nope)
             + jnp.einsum('bqhr,bkr->bhqk', qrb, k_rope)).astype(jnp.float32) * scale
        mask = (pq[:, :, None] >= positions[:, None, :])[:, None]
        p = jax.nn.softmax(jnp.where(mask, s, -jnp.inf), axis=-1)
        return jnp.einsum('bhqk,bkhe->bqhe', p.astype(v.dtype), v)

    return _from_blocks(lax.map(block, (_to_blocks(q_nope), _to_blocks(q_rope), _to_blocks(positions))))


def _conv_ffn(h, w_up, conv_w, conv_b, w_down):
    u = h @ w_up
    up = jnp.pad(u, ((0, 0), (CONV_WIDTH - 1, 0), (0, 0)))
    s = u.shape[1]
    c = conv_b + sum(conv_w[j] * up[:, j:j + s] for j in range(CONV_WIDTH))
    gate, val = c[..., :D_FF], c[..., D_FF:]
    return (jax.nn.silu(gate) * val) @ w_down


def setup_inputs(seed: int = 0) -> dict:
    key = jax.random.key(seed)
    ks = jax.random.split(key, 24)
    L, D, F = DEPTH, D_MODEL, D_FF
    nrm = lambda k, shape, fan_in: jax.random.normal(k, shape, jnp.float32) * fan_in ** -0.5
    x = jax.random.normal(ks[0], (BATCH, SEQ, D), jnp.float32)
    offset = jax.random.randint(ks[1], (BATCH, 1), 0, 1024, dtype=jnp.int32)
    positions = jnp.arange(SEQ, dtype=jnp.int32)[None, :] + offset
    col_scale = jnp.concatenate([
        jnp.ones((DA_Q_COLS + DA_K_COLS,), jnp.float32),
        jnp.full((DA_V_COLS,), DEEPNORM_BETA, jnp.float32),
        jnp.ones((MLA_Q_RANK + MLA_KV_RANK + MLA_ROPE_DIM + GATE_COLS,), jnp.float32)])
    w_in = nrm(ks[2], (L, D, IN_COLS), D) * col_scale
    b_gate = 0.02 * jax.random.normal(ks[3], (L, GATE_COLS), jnp.float32)
    da_lambda_q1 = 0.1 * jax.random.normal(ks[4], (L, DA_HEAD_DIM), jnp.float32)
    da_lambda_k1 = 0.1 * jax.random.normal(ks[5], (L, DA_HEAD_DIM), jnp.float32)
    da_lambda_q2 = 0.1 * jax.random.normal(ks[6], (L, DA_HEAD_DIM), jnp.float32)
    da_lambda_k2 = 0.1 * jax.random.normal(ks[7], (L, DA_HEAD_DIM), jnp.float32)
    da_subln_g = 1.0 + 0.02 * jax.random.normal(ks[8], (L, DA_V_DIM), jnp.float32)
    mla_q_norm_g = 1.0 + 0.02 * jax.random.normal(ks[9], (L, MLA_Q_RANK), jnp.float32)
    mla_kv_norm_g = 1.0 + 0.02 * jax.random.normal(ks[10], (L, MLA_KV_RANK), jnp.float32)
    w_uq = nrm(ks[11], (L, MLA_Q_RANK, MLA_HEADS * (MLA_NOPE_DIM + MLA_ROPE_DIM)), MLA_Q_RANK)
    ukv_scale = jnp.tile(jnp.concatenate([jnp.ones((MLA_NOPE_DIM,), jnp.float32),
                                          jnp.full((MLA_V_DIM,), DEEPNORM_BETA, jnp.float32)]), MLA_HEADS)
    w_ukv = nrm(ks[12], (L, MLA_KV_RANK, MLA_HEADS * (MLA_NOPE_DIM + MLA_V_DIM)), MLA_KV_RANK) * ukv_scale
    w_proj_a = nrm(ks[13], (L, DA_WIDTH, D), DA_WIDTH) * DEEPNORM_BETA
    w_proj_b = nrm(ks[14], (L, MLA_WIDTH, D), MLA_WIDTH) * DEEPNORM_BETA
    w_out = nrm(ks[15], (L, D, D), D) * DEEPNORM_BETA
    ln1_g = 1.0 + 0.02 * jax.random.normal(ks[16], (L, D), jnp.float32)
    ln1_b = 0.02 * jax.random.normal(ks[17], (L, D), jnp.float32)
    w_up = nrm(ks[18], (L, D, 2 * F), D) * DEEPNORM_BETA
    conv_w = nrm(ks[19], (L, CONV_WIDTH, 2 * F), CONV_WIDTH)
    conv_b = 0.02 * jax.random.normal(ks[20], (L, 2 * F), jnp.float32)
    w_down = nrm(ks[21], (L, F, D), F) * DEEPNORM_BETA
    ln2_g = 1.0 + 0.02 * jax.random.normal(ks[22], (L, D), jnp.float32)
    ln2_b = 0.02 * jax.random.normal(ks[23], (L, D), jnp.float32)
    return {"x": x, "positions": positions, "w_in": w_in, "b_gate": b_gate,
            "da_lambda_q1": da_lambda_q1, "da_lambda_k1": da_lambda_k1,
            "da_lambda_q2": da_lambda_q2, "da_lambda_k2": da_lambda_k2,
            "da_subln_g": da_subln_g, "mla_q_norm_g": mla_q_norm_g, "mla_kv_norm_g": mla_kv_norm_g,
            "w_uq": w_uq, "w_ukv": w_ukv, "w_proj_a": w_proj_a, "w_proj_b": w_proj_b,
            "w_out": w_out, "ln1_g": ln1_g, "ln1_b": ln1_b, "w_up": w_up, "conv_w": conv_w,
            "conv_b": conv_b, "w_down": w_down, "ln2_g": ln2_g, "ln2_b": ln2_b}


def reference(x, positions, w_in, b_gate, da_lambda_q1, da_lambda_k1, da_lambda_q2, da_lambda_k2,
              da_subln_g, mla_q_norm_g, mla_kv_norm_g, w_uq, w_ukv, w_proj_a, w_proj_b, w_out,
              ln1_g, ln1_b, w_up, conv_w, conv_b, w_down, ln2_g, ln2_b):
    b, s, _ = x.shape
    h = x
    for l in range(DEPTH):
        proj = h @ w_in[l]
        da_q, da_k, da_v, c_q, c_kv, k_r, gate_logits = jnp.split(proj, IN_OFFSETS, axis=-1)

        lambda_init = 0.8 - 0.6 * math.exp(-0.3 * l)
        lam = (jnp.exp(jnp.sum(da_lambda_q1[l].astype(jnp.float32) * da_lambda_k1[l].astype(jnp.float32)))
               - jnp.exp(jnp.sum(da_lambda_q2[l].astype(jnp.float32) * da_lambda_k2[l].astype(jnp.float32)))
               + lambda_init)
        qa = da_q.reshape(b, s, DA_HEADS, 2, DA_HEAD_DIM)
        ka = da_k.reshape(b, s, DA_HEADS, 2, DA_HEAD_DIM)
        va = da_v.reshape(b, s, DA_HEADS, DA_V_DIM)
        oa = _diff_attention(qa, ka, va, positions, lam)
        oa = (_rmsnorm(oa, da_subln_g[l]) * (1.0 - lambda_init)).reshape(b, s, DA_WIDTH)

        qb = (_rmsnorm(c_q, mla_q_norm_g[l]) @ w_uq[l]).reshape(b, s, MLA_HEADS, MLA_NOPE_DIM + MLA_ROPE_DIM)
        q_nope, q_rope = qb[..., :MLA_NOPE_DIM], _rope(qb[..., MLA_NOPE_DIM:], positions)
        kv = (_rmsnorm(c_kv, mla_kv_norm_g[l]) @ w_ukv[l]).reshape(b, s, MLA_HEADS, MLA_NOPE_DIM + MLA_V_DIM)
        k_nope, vb = kv[..., :MLA_NOPE_DIM], kv[..., MLA_NOPE_DIM:]
        k_rope = _rope(k_r, positions)
        ob = _mla_attention(q_nope, q_rope, k_nope, k_rope, vb, positions).reshape(b, s, MLA_WIDTH)

        g = jax.nn.sigmoid(gate_logits + b_gate[l])
        merged = g[..., :D_MODEL] * (oa @ w_proj_a[l]) + g[..., D_MODEL:] * (ob @ w_proj_b[l])
        h = _layernorm(DEEPNORM_ALPHA * h + merged @ w_out[l], ln1_g[l], ln1_b[l])

        f = _conv_ffn(h, w_up[l], conv_w[l], conv_b[l], w_down[l])
        h = _layernorm(DEEPNORM_ALPHA * h + f, ln2_g[l], ln2_b[l])
    return h
```

```cpp
#include <hip/hip_runtime.h>
#include <cstdio>
#include <cstdint>

#ifndef MK_N_LAUNCHES
#define MK_N_LAUNCHES 1
#endif

constexpr int BATCH = 2, SEQ = 8192, DM = 4096, M = BATCH * SEQ;
constexpr int DA_H = 8, ML_H = 16, DFF = 11008;
constexpr int IN_COLS = 15936, N1 = 16128;
constexpr float ALPHA = 1.189207115002721f;
constexpr float LN_EPS = 1e-5f, RMS_EPS = 1e-6f;
constexpr float LOG2E = 1.4426950408889634f;
constexpr float C2A = 0.08838834764831845f * LOG2E;
constexpr float C2B = 0.07216878364870323f * LOG2E;
constexpr float LAMBDA_INIT = 0.2f;

constexpr size_t MiB = 1u << 20;
constexpr size_t WS_CTL = 0, CTL_ZERO_BYTES = 65536;
constexpr size_t WS_ROPE = 1 * MiB;
constexpr size_t WS_ROWSS = 5 * MiB;
constexpr size_t WS_NPART = 6 * MiB;
constexpr size_t WS_WIN = 8 * MiB, WS_WUQ = 134 * MiB, WS_WUKV = 140 * MiB, WS_WPA = 144 * MiB, WS_WPB = 160 * MiB, WS_WOUT = 176 * MiB, WS_WUP = 208 * MiB, WS_WDN = 380 * MiB;
constexpr size_t WS_XB = 466 * MiB;
constexpr size_t WS_OAB = WS_XB, WS_H1B = WS_XB;
constexpr size_t WS_QKV = 594 * MiB;
constexpr size_t WS_QB = 786 * MiB;
constexpr size_t WS_KVB = 882 * MiB;
constexpr size_t WS_LAT = 1042 * MiB;
constexpr size_t WS_G = 1090 * MiB;
constexpr size_t WS_TMP = 594 * MiB;
constexpr size_t WS_MRG = 850 * MiB;
constexpr size_t WS_SIDE = 594 * MiB;
constexpr size_t WS_ACT = 640 * MiB;
constexpr size_t WS_O0 = 8 * MiB;
constexpr size_t WS_END = 1376 * MiB;
constexpr int KVLD = 5120;

constexpr int RING_BYTES = 131072, LDSCTL_OFF = RING_BYTES, MISC_OFF = LDSCTL_OFF + 320, LDS_BYTES = 147456;
constexpr int NWAVES = 8;

#define GAS __attribute__((address_space(1)))
#define LAS __attribute__((address_space(3)))
typedef unsigned short bf16;
typedef unsigned v4u __attribute__((ext_vector_type(4)));
typedef unsigned v2u __attribute__((ext_vector_type(2)));
typedef float f32x4 __attribute__((ext_vector_type(4)));
typedef float f32x2 __attribute__((ext_vector_type(2)));
typedef float f32x16 __attribute__((ext_vector_type(16)));
typedef short bf16x8 __attribute__((ext_vector_type(8)));
typedef short s16x4 __attribute__((ext_vector_type(4)));
typedef GAS unsigned gu32;
#define RLX_AGENT __ATOMIC_RELAXED, __HIP_MEMORY_SCOPE_AGENT
#define LDS_WAIT() asm volatile("s_waitcnt lgkmcnt(0)" ::: "memory")
#define VM_WAIT() asm volatile("s_waitcnt vmcnt(0)" ::: "memory")
typedef __bf16 bf16x2_t __attribute__((ext_vector_type(2)));
__device__ __forceinline__ unsigned cvt_pk(float lo, float hi) { const f32x2 v = {lo, hi}; const bf16x2_t b = __builtin_convertvector(v, bf16x2_t); return __builtin_bit_cast(unsigned, b); }
__device__ __forceinline__ float bf_lo(unsigned w) { return __uint_as_float(w << 16); }
__device__ __forceinline__ float bf_hi(unsigned w) { return __uint_as_float(w & 0xffff0000u); }
__device__ __forceinline__ float wave_sum(float v) {
#pragma unroll
    for (int o = 1; o < 64; o <<= 1) v += __shfl_xor(v, o);
    return v;
}
namespace pg8 {
#define PG8_LAS __attribute__((address_space(3)))
typedef unsigned short bf16_t;
typedef short bf16x8 __attribute__((ext_vector_type(8)));
typedef float f32x4 __attribute__((ext_vector_type(4)));
typedef unsigned u32x4 __attribute__((ext_vector_type(4)));
constexpr int BM = 256, BK = 64, HALF = 128, HTB = HALF * BK * 2  , STAGE_BYTES = 8 * HTB, NXCD = 8, WGM = 8;

__host__ __device__ __forceinline__ int lds_byte(int r, int c) { const int st = (r >> 4) * 2 + (c >> 5), rr = r & 15, cc = c & 31, ob = rr * 64 + cc * 2; return st * 1024 + (ob ^ (((ob >> 9) & 1) << 5)); }
__host__ __device__ __forceinline__ void stage_rc(int b, int& R, int& C) { const int st = b / 1024, sb = b % 1024, swz = sb ^ (((sb >> 9) & 1) << 5); R = (st >> 1) * 16 + swz / 64; C = (st & 1) * 32 + (swz % 64) / 2; }
__host__ __device__ __forceinline__ int perm32(int rho) { const int n = rho >> 4, i = rho & 15; return 8 * (i >> 2) + 4 * n + (i & 3); }

struct Unit { int pm, pn; };
struct Gemm { const bf16_t* A; const bf16_t* Bt; int M, N, K, lda, ldb, koff; };

struct StaticOrder {
    int nM, nN, nwg, G, c;
    __host__ __device__ void init(int M, int N, int G_, int c_) { nM = M / BM; nN = N / BM; nwg = nM * nN; G = G_; c = c_; }
    __host__ __device__ bool next(int i, Unit& u) const {
        const long L = (long)i * G + c; if (L >= nwg) return false;
        int wgid = (int)L; { const int q = nwg / NXCD, r = nwg % NXCD, xcd = wgid % NXCD, off = wgid / NXCD; wgid = (xcd < r ? xcd * (q + 1) : r * (q + 1) + (xcd - r) * q) + off; }
        const int nig = WGM * nN, gid = wgid / nig, fm = gid * WGM, gsz = (nM - fm) < WGM ? (nM - fm) : WGM;
        u.pm = fm + ((wgid % nig) % gsz); u.pn = (wgid % nig) / gsz; return true;
    }
    __device__ __forceinline__ void a_ready(const Unit&) const {}
    __device__ __forceinline__ void done(const Unit&) const {}
};

__device__ __forceinline__ unsigned cvt_pk_bf16(float lo, float hi) { return ::cvt_pk(lo, hi); }
typedef float f32x2 __attribute__((ext_vector_type(2)));
__device__ __forceinline__ u32x4 pack8(f32x4 a, f32x4 b) { u32x4 w; w.x = cvt_pk_bf16(a[0], a[1]); w.y = cvt_pk_bf16(a[2], a[3]); w.z = cvt_pk_bf16(b[0], b[1]); w.w = cvt_pk_bf16(b[2], b[3]); return w; }
__device__ __forceinline__ float bflo(unsigned w) { return __uint_as_float(w << 16); }
__device__ __forceinline__ float bfhi(unsigned w) { return __uint_as_float(w & 0xffff0000u); }
__device__ __forceinline__ float sigmoidf_(float x) { return __builtin_amdgcn_rcpf(1.f + __builtin_amdgcn_exp2f(-1.4426950408889634f * x)); }
__device__ __forceinline__ void rope8(f32x4& v0, f32x4& v1, const float* cs  , int i0) {
    const f32x4 c = *(const f32x4*)(cs + i0), s = *(const f32x4*)(cs + 32 + i0);
    const f32x4 a = v0, b = v1;
    v0[0] = a[0] * c[0] - a[1] * s[0]; v0[1] = a[0] * s[0] + a[1] * c[0];
    v0[2] = a[2] * c[1] - a[3] * s[1]; v0[3] = a[2] * s[1] + a[3] * c[1];
    v1[0] = b[0] * c[2] - b[1] * s[2]; v1[1] = b[0] * s[2] + b[1] * c[2];
    v1[2] = b[2] * c[3] - b[3] * s[3]; v1[3] = b[2] * s[3] + b[3] * c[3];
}
#define PG8_ROWLOOP _Pragma("unroll") for (int ai = 0; ai < 2; ++ai) _Pragma("unroll") for (int m = 0; m < 4; ++m)

struct EpiIn {
    static constexpr bool PERM = true, AFTER_DRAIN = false, MID = false;
    bf16_t* qkv; bf16_t* lat; bf16_t* gate; bf16_t* kvb; float* rowss; const float* bgate; const float* rope; float c2a; int Mrows;
    __device__ __forceinline__ void operator()(const f32x4 (&acc)[2][2][4][2], const Unit& u, int wr, int wc, int fr, int fq) const {
        const int row0 = u.pm * BM + wr * 64 + fr, lc0 = wc * 32 + 8 * fq, pn = u.pn;
        if (pn < 24) {
            const float sc = pn < 8 ? c2a : 1.f;
            PG8_ROWLOOP { bf16_t* rowp = qkv + (size_t)(row0 + ai * HALF + m * 16) * 6144 + pn * 256 + lc0;
#pragma unroll
                for (int bj = 0; bj < 2; ++bj) *(u32x4*)(rowp + bj * HALF) = pack8(acc[ai][bj][m][0] * sc, acc[ai][bj][m][1] * sc); }
        } else if (pn < 30) {
            PG8_ROWLOOP { bf16_t* rowp = lat + (size_t)(row0 + ai * HALF + m * 16) * 1536 + (pn - 24) * 256 + lc0;
#pragma unroll
                for (int bj = 0; bj < 2; ++bj) *(u32x4*)(rowp + bj * HALF) = pack8(acc[ai][bj][m][0], acc[ai][bj][m][1]); }
        } else if (pn < 62) {
            const int gc0 = (pn - 30) * 256 + lc0;
            f32x4 bv[2][2];
#pragma unroll
            for (int bj = 0; bj < 2; ++bj)
#pragma unroll
                for (int n = 0; n < 2; ++n) bv[bj][n] = *(const f32x4*)(bgate + gc0 + bj * HALF + 4 * n);
            PG8_ROWLOOP { bf16_t* rowp = gate + (size_t)(row0 + ai * HALF + m * 16) * 8192 + gc0;
#pragma unroll
                for (int bj = 0; bj < 2; ++bj) { f32x4 a = acc[ai][bj][m][0] + bv[bj][0], b = acc[ai][bj][m][1] + bv[bj][1];
#pragma unroll
                    for (int e = 0; e < 4; ++e) { a[e] = sigmoidf_(a[e]); b[e] = sigmoidf_(b[e]); }
                    *(u32x4*)(rowp + bj * HALF) = pack8(a, b); } }
        } else {
            if (wc < 2) {
                PG8_ROWLOOP { const int row = row0 + ai * HALF + m * 16; f32x4 a = acc[ai][0][m][0], b = acc[ai][0][m][1];
                    rope8(a, b, rope + (size_t)row * 64, lc0 >> 1);
                    const u32x4 w = pack8(a, b); bf16_t* rowp = kvb + (size_t)row * 5120 + 128 + lc0;
#pragma unroll
                    for (int h = 0; h < 16; ++h) *(u32x4*)(rowp + h * 320) = w; }
            }
        }
    }
};
struct EpiQb {
    static constexpr bool PERM = true, AFTER_DRAIN = false, MID = false;
    bf16_t* qb; const float* rowss; const float* rope; float c2b;
    __device__ __forceinline__ void operator()(const f32x4 (&acc)[2][2][4][2], const Unit& u, int wr, int wc, int fr, int fq) const {
        const int row0 = u.pm * BM + wr * 64 + fr, lc0 = wc * 32 + 8 * fq;
        int col[2], i0[2]; bool isr[2];
#pragma unroll
        for (int bj = 0; bj < 2; ++bj) { col[bj] = u.pn * 256 + bj * HALF + lc0; const int h = col[bj] / 192, j = col[bj] - h * 192; isr[bj] = j >= 128; i0[bj] = (j - 128) >> 1; }
        PG8_ROWLOOP { const int row = row0 + ai * HALF + m * 16; const float rs = __builtin_amdgcn_rsqf(rowss[row] * (1.f / 1024.f) + 1e-6f) * c2b;
#pragma unroll
            for (int bj = 0; bj < 2; ++bj) { f32x4 a = acc[ai][bj][m][0] * rs, b = acc[ai][bj][m][1] * rs;
                if (isr[bj]) rope8(a, b, rope + (size_t)row * 64, i0[bj]);
                *(u32x4*)(qb + (size_t)row * 3072 + col[bj]) = pack8(a, b); } }
    }
};
struct EpiKv {
    static constexpr bool PERM = true, AFTER_DRAIN = false, MID = false;
    bf16_t* kvb; const float* rowss;
    __device__ __forceinline__ void operator()(const f32x4 (&acc)[2][2][4][2], const Unit& u, int wr, int wc, int fr, int fq) const {
        const int row0 = u.pm * BM + wr * 64 + fr, lc0 = wc * 32 + 8 * fq;
        PG8_ROWLOOP { const int row = row0 + ai * HALF + m * 16; const float rs = __builtin_amdgcn_rsqf(rowss[row] * (1.f / 512.f) + 1e-6f);
            bf16_t* rowp = kvb + (size_t)row * 5120 + u.pn * 320 + lc0;
            *(u32x4*)(rowp) = pack8(acc[ai][0][m][0] * rs, acc[ai][0][m][1] * rs);
            *(u32x4*)(rowp + 192) = pack8(acc[ai][1][m][0] * rs, acc[ai][1][m][1] * rs); }
    }
};
__device__ __forceinline__ void unpack8(const u32x4 w, f32x4& a, f32x4& b) { a[0] = bflo(w.x); a[1] = bfhi(w.x); a[2] = bflo(w.y); a[3] = bfhi(w.y); b[0] = bflo(w.z); b[1] = bfhi(w.z); b[2] = bflo(w.w); b[3] = bfhi(w.w); }
struct EpiMerge {
    static constexpr bool PERM = true, AFTER_DRAIN = false, MID = true;
    const bf16_t* gate; bf16_t* mrg;
    __device__ __forceinline__ void mid(f32x4 (&acc)[2][2][4][2], const Unit& u, int wr, int wc, int fr, int fq) const {
        int fro = fr; asm volatile("" : "+v"(fro));
        const int row0 = u.pm * BM + wr * 64 + fro, c0 = u.pn * 256 + wc * 32 + 8 * fq;
        PG8_ROWLOOP { const bf16_t* gp = gate + (size_t)(row0 + ai * HALF + m * 16) * 8192 + c0;
#pragma unroll
            for (int bj = 0; bj < 2; ++bj) { f32x4 a0, a1, b0, b1; unpack8(*(const u32x4*)(gp + bj * HALF), a0, a1); unpack8(*(const u32x4*)(gp + 4096 + bj * HALF), b0, b1);
#pragma unroll
                for (int e = 0; e < 4; ++e) { acc[ai][bj][m][0][e] *= a0[e] * __builtin_amdgcn_rcpf(fmaxf(b0[e], 1e-30f)); acc[ai][bj][m][1][e] *= a1[e] * __builtin_amdgcn_rcpf(fmaxf(b1[e], 1e-30f)); } }
            asm volatile("" : "+v"(acc[ai][0][m][0]), "+v"(acc[ai][0][m][1]), "+v"(acc[ai][1][m][0]), "+v"(acc[ai][1][m][1]) :: "memory"); }
    }
    __device__ __forceinline__ void operator()(const f32x4 (&acc)[2][2][4][2], const Unit& u, int wr, int wc, int fr, int fq) const {
        const int row0 = u.pm * BM + wr * 64 + fr, c0 = u.pn * 256 + wc * 32 + 8 * fq;
        PG8_ROWLOOP { const int row = row0 + ai * HALF + m * 16;
#pragma unroll
            for (int bj = 0; bj < 2; ++bj) { const int c = c0 + bj * HALF; f32x4 b0, b1; unpack8(*(const u32x4*)(gate + (size_t)row * 8192 + 4096 + c), b0, b1);
#pragma unroll
                for (int e = 0; e < 4; ++e) { b0[e] = fmaxf(b0[e], 1e-30f); b1[e] = fmaxf(b1[e], 1e-30f); }
                *(u32x4*)(mrg + (size_t)row * 4096 + c) = pack8(acc[ai][bj][m][0] * b0, acc[ai][bj][m][1] * b1); } }
    }
};
struct EpiRes {
    static constexpr bool PERM = true, AFTER_DRAIN = false, MID = false;
    const float* base; float* out; float alpha;
    __device__ __forceinline__ void operator()(const f32x4 (&acc)[2][2][4][2], const Unit& u, int wr, int wc, int fr, int fq) const {
        const int row0 = u.pm * BM + wr * 64 + fr, c0 = u.pn * 256 + wc * 32 + 8 * fq;
        PG8_ROWLOOP { const size_t ro = (size_t)(row0 + ai * HALF + m * 16) * 4096;
#pragma unroll
            for (int bj = 0; bj < 2; ++bj) { const size_t off = ro + c0 + bj * HALF; const f32x4 xa = *(const f32x4*)(base + off), xb = *(const f32x4*)(base + off + 4);
                *(f32x4*)(out + off) = xa * alpha + acc[ai][bj][m][0]; *(f32x4*)(out + off + 4) = xb * alpha + acc[ai][bj][m][1]; } }
    }
};
struct EpiDown {
    static constexpr bool PERM = true, AFTER_DRAIN = false, MID = false;
    float* out; const float* stat; const float* g; const float* b; float alpha; int Mrows;
    __device__ __forceinline__ void operator()(const f32x4 (&acc)[2][2][4][2], const Unit& u, int wr, int wc, int fr, int fq) const {
        const int row0 = u.pm * BM + wr * 64 + fr, c0 = u.pn * 256 + wc * 32 + 8 * fq;
        f32x4 gv[2][2], bv[2][2];
#pragma unroll
        for (int bj = 0; bj < 2; ++bj)
#pragma unroll
            for (int n = 0; n < 2; ++n) { gv[bj][n] = *(const f32x4*)(g + c0 + bj * HALF + 4 * n) * alpha; bv[bj][n] = *(const f32x4*)(b + c0 + bj * HALF + 4 * n) * alpha; }
        PG8_ROWLOOP { const int row = row0 + ai * HALF + m * 16; const size_t ro = (size_t)row * 4096; const float mean = stat[row], rstd = stat[Mrows + row];
#pragma unroll
            for (int bj = 0; bj < 2; ++bj) { const size_t off = ro + c0 + bj * HALF; const f32x4 ya = *(const f32x4*)(out + off), yb = *(const f32x4*)(out + off + 4);
                *(f32x4*)(out + off) = (ya - mean) * rstd * gv[bj][0] + bv[bj][0] + acc[ai][bj][m][0]; *(f32x4*)(out + off + 4) = (yb - mean) * rstd * gv[bj][1] + bv[bj][1] + acc[ai][bj][m][1]; } }
    }
};
__device__ __forceinline__ float dpp_prev(float prev_grp, float cur, int k) {
    const int pg = __builtin_bit_cast(int, prev_grp), cu = __builtin_bit_cast(int, cur);
    const int ro = k == 1 ? __builtin_amdgcn_mov_dpp(pg, 0x121, 0xf, 0xf, false) : __builtin_amdgcn_mov_dpp(pg, 0x122, 0xf, 0xf, false);
    const int r = k == 1 ? __builtin_amdgcn_update_dpp(ro, cu, 0x111, 0xf, 0xf, false) : __builtin_amdgcn_update_dpp(ro, cu, 0x112, 0xf, 0xf, false);
    return __builtin_bit_cast(float, r);
}
struct EpiConv {
    static constexpr bool PERM = true, AFTER_DRAIN = false, MID = false;
    bf16_t* act; bf16_t* side; const float* cw; const float* cb; int dff;
    __device__ __forceinline__ void operator()(const f32x4 (&acc)[2][2][4][2], const Unit& u, int wr, int wc, int fr, int fq) const {
        const int ch0 = u.pn * 128 + wc * 32 + 8 * fq;
#pragma unroll
        for (int n = 0; n < 2; ++n) {
            const int ch = ch0 + 4 * n;
            f32x4 wg[3], wv[3];
#pragma unroll
            for (int k = 0; k < 3; ++k) { wg[k] = *(const f32x4*)(cw + (size_t)k * 2 * dff + ch); wv[k] = *(const f32x4*)(cw + (size_t)k * 2 * dff + dff + ch); }
            const f32x4 bg = *(const f32x4*)(cb + ch), bv = *(const f32x4*)(cb + dff + ch);
#pragma unroll
            for (int ai = 0; ai < 2; ++ai) {
                const int rowc = u.pm * BM + ai * HALF + wr * 64;
#pragma unroll
                for (int m = 0; m < 4; ++m) {
                    const f32x4 g0 = acc[ai][0][m][n], v0 = acc[ai][1][m][n];
                    const f32x4 gp = m > 0 ? acc[ai][0][m - 1][n] : (f32x4){0.f, 0.f, 0.f, 0.f}, vp = m > 0 ? acc[ai][1][m - 1][n] : (f32x4){0.f, 0.f, 0.f, 0.f};
                    f32x4 o;
#pragma unroll
                    for (int e = 0; e < 4; ++e) {
                        const float g1 = dpp_prev(gp[e], g0[e], 1), g2 = dpp_prev(gp[e], g0[e], 2), v1 = dpp_prev(vp[e], v0[e], 1), v2 = dpp_prev(vp[e], v0[e], 2);
                        const float cg = bg[e] + wg[0][e] * g2 + wg[1][e] * g1 + wg[2][e] * g0[e];
                        const float cv = bv[e] + wv[0][e] * v2 + wv[1][e] * v1 + wv[2][e] * v0[e];
                        o[e] = cg * sigmoidf_(cg) * cv;
                    }
                    const int row = rowc + m * 16 + fr;
                    typedef unsigned u32x2 __attribute__((ext_vector_type(2)));
                    if (m > 0 || fr >= 2) { u32x2 w; w.x = cvt_pk_bf16(o[0], o[1]); w.y = cvt_pk_bf16(o[2], o[3]); *(u32x2*)(act + (size_t)row * dff + ch) = w; }
                    if ((m == 0 && fr < 2) || (m == 3 && fr >= 14)) {
                        const int j = m == 0 ? fr : fr - 12;
                        bf16_t* sp = side + ((size_t)((rowc >> 6) * 4 + j) * 2) * dff + ch;
                        u32x2 wgt; wgt.x = cvt_pk_bf16(g0[0], g0[1]); wgt.y = cvt_pk_bf16(g0[2], g0[3]); *(u32x2*)sp = wgt;
                        u32x2 wvl; wvl.x = cvt_pk_bf16(v0[0], v0[1]); wvl.y = cvt_pk_bf16(v0[2], v0[3]); *(u32x2*)(sp + dff) = wvl;
                    }
                }
            }
        }
    }
};
template <class Epi, class Sched, bool ALIGN_EPI = false, bool SP2 = false>
__device__ __forceinline__ void gemm_phase(PG8_LAS unsigned char* lds, const Gemm g, const Sched& S, const Epi& E) {
    const int tid = threadIdx.x, wid = __builtin_amdgcn_readfirstlane(tid >> 6), lane = tid & 63, wr = wid >> 2, wc = wid & 3, fr = lane & 15, fq = lane >> 4;
    const int K = g.K, nt = K / BK;
    unsigned voffA[2], voffB[2];
#pragma unroll
    for (int i = 0; i < 2; ++i) { int R, C; stage_rc(tid * 16 + i * 8192, R, C); const int Rb = Epi::PERM ? ((R & ~31) + perm32(R & 31)) : R;
        voffA[i] = (unsigned)(R * g.lda + C) * 2u; voffB[i] = (unsigned)(Rb * g.ldb + C) * 2u; }
    const size_t kstep = (size_t)(BK * 2);
    const int koff = g.koff; const size_t kob = (size_t)koff * kstep;
#define PG8_KP(base, t_) ((base) + (size_t)(((t_) + koff) >= nt ? (t_) + koff - nt : (t_) + koff) * kstep)
    const size_t hstepA = (size_t)HALF * g.lda * 2, hstepB = (size_t)HALF * g.ldb * 2;
    const size_t tstepA = 2 * hstepA, tstepB = 2 * hstepB;
    const unsigned ldsw = (unsigned)wid * 1024u;
    const int aoff = lds_byte(wr * 64 + fr, fq * 8), boff = lds_byte(wc * 32 + fr, fq * 8);
#define PG8_SA(b, h) (((b) * 2 + (h)) * HTB)
#define PG8_SB(b, h) ((4 + (b) * 2 + (h)) * HTB)
#define PG8_STAGE(bufoff, gbase, voff) do { _Pragma("unroll") for (int _i = 0; _i < 2; ++_i) \
        __builtin_amdgcn_global_load_lds((const unsigned*)((const char*)(gbase) + (voff)[_i]), (PG8_LAS unsigned*)(lds + (bufoff) + ldsw + _i * 8192), 16, 0, 0); } while (0)
#define PG8_LDA(dst, b, h) do { _Pragma("unroll") for (int m = 0; m < 4; ++m) _Pragma("unroll") for (int k = 0; k < 2; ++k) dst[m][k] = *(const PG8_LAS bf16x8*)(lds + PG8_SA(b, h) + aoff + m * 2048 + k * 1024); } while (0)
#define PG8_LDB(dst, b, h) do { _Pragma("unroll") for (int n = 0; n < 2; ++n) _Pragma("unroll") for (int k = 0; k < 2; ++k) dst[n][k] = *(const PG8_LAS bf16x8*)(lds + PG8_SB(b, h) + boff + n * 2048 + k * 1024); } while (0)
#define PG8_MMA(ai, bj, At, Bt) do { __builtin_amdgcn_s_setprio(1); _Pragma("unroll") for (int m = 0; m < 4; ++m) _Pragma("unroll") for (int n = 0; n < 2; ++n) _Pragma("unroll") for (int k = 0; k < 2; ++k) \
        acc[ai][bj][m][n] = __builtin_amdgcn_mfma_f32_16x16x32_bf16(Bt[n][k], At[m][k], acc[ai][bj][m][n], 0, 0, 0); __builtin_amdgcn_s_setprio(0); } while (0)
#define PG8_WAIT_V(n) asm volatile("s_waitcnt vmcnt(" #n ")" ::: "memory")
#define PG8_WAIT_L(n) asm volatile("s_waitcnt lgkmcnt(" #n ")" ::: "memory")
#define PG8_BAR __builtin_amdgcn_s_barrier()
#define PG8_SCHED __builtin_amdgcn_sched_barrier(0)
    Unit cur, nxt; int ui = 0;
    if (!S.next(0, cur)) return;
    f32x4 acc[2][2][4][2];
#pragma unroll
    for (int a = 0; a < 2; ++a)
#pragma unroll
        for (int b = 0; b < 2; ++b)
#pragma unroll
            for (int m = 0; m < 4; ++m)
#pragma unroll
                for (int n = 0; n < 2; ++n) acc[a][b][m][n] = (f32x4){0.f, 0.f, 0.f, 0.f};
    bf16x8 At[4][2], B0[2][2], B1[2][2];
    const char* cA = (const char*)g.A + (size_t)cur.pm * tstepA; const char* cB = (const char*)g.Bt + (size_t)cur.pn * tstepB;
    S.a_ready(cur);
    if constexpr (SP2) {
        PG8_STAGE(PG8_SB(0, 0), cB + kob, voffB); PG8_STAGE(PG8_SB(0, 1), cB + kob + hstepB, voffB); PG8_STAGE(PG8_SA(0, 0), cA + kob, voffA); PG8_STAGE(PG8_SA(0, 1), cA + kob + hstepA, voffA);
        if (wr == 1) PG8_BAR;
        PG8_WAIT_V(2); PG8_BAR;
        PG8_STAGE(PG8_SB(1, 0), cB + kob + kstep, voffB); PG8_STAGE(PG8_SA(1, 0), cA + kob + kstep, voffA); PG8_STAGE(PG8_SB(1, 1), cB + kob + hstepB + kstep, voffB);
        PG8_WAIT_V(6); PG8_BAR;
    } else {
        PG8_STAGE(PG8_SB(0, 0), cB + kob, voffB); PG8_STAGE(PG8_SA(0, 0), cA + kob, voffA); PG8_STAGE(PG8_SB(0, 1), cB + kob + hstepB, voffB); PG8_STAGE(PG8_SA(0, 1), cA + kob + hstepA, voffA);
        if (wr == 1) PG8_BAR;
        PG8_WAIT_V(4); PG8_BAR;
        PG8_STAGE(PG8_SB(1, 0), cB + kob + kstep, voffB); PG8_STAGE(PG8_SA(1, 0), cA + kob + kstep, voffA); PG8_STAGE(PG8_SB(1, 1), cB + kob + hstepB + kstep, voffB);
        PG8_WAIT_V(6); PG8_BAR;
    }
    for (;;) {
        const bool has_next = S.next(ui + 1, nxt);
        const char* nA = has_next ? (const char*)g.A + (size_t)nxt.pm * tstepA : cA; const char* nB = has_next ? (const char*)g.Bt + (size_t)nxt.pn * tstepB : cB;
        for (int t = 0; t < nt; t += 2) {
            if constexpr (Epi::MID) { if (t == nt / 2) E.mid(acc, cur, wr, wc, fr, fq); }
            const bool last = (t == nt - 2);
            const char* a1 = PG8_KP(cA, t + 1);
            const char* a2 = last ? nA + kob : PG8_KP(cA, t + 2); const char* b2 = last ? nB + kob : PG8_KP(cB, t + 2);
            const char* a3 = a2 + kstep; const char* b3 = b2 + kstep;
            if (last && has_next) S.a_ready(nxt);
            if constexpr (SP2) {
            PG8_LDB(B0, 0, 0); PG8_LDB(B1, 0, 1); PG8_SCHED; PG8_LDA(At, 0, 0); PG8_STAGE(PG8_SA(1, 1), a1 + hstepA, voffA);
            PG8_WAIT_V(8); PG8_WAIT_L(0); PG8_BAR; PG8_MMA(0, 0, At, B0); PG8_MMA(0, 1, At, B1); PG8_BAR; PG8_SCHED;
            PG8_LDA(At, 0, 1); PG8_STAGE(PG8_SB(0, 0), b2, voffB); PG8_STAGE(PG8_SB(0, 1), b2 + hstepB, voffB); PG8_STAGE(PG8_SA(0, 0), a2, voffA);
            PG8_WAIT_V(8); PG8_WAIT_L(0); PG8_BAR; PG8_MMA(1, 0, At, B0); PG8_MMA(1, 1, At, B1); PG8_BAR; PG8_SCHED;
            PG8_LDB(B0, 1, 0); PG8_LDB(B1, 1, 1); PG8_SCHED; PG8_LDA(At, 1, 0); PG8_STAGE(PG8_SA(0, 1), a2 + hstepA, voffA);
            PG8_WAIT_V(8); PG8_WAIT_L(0); PG8_BAR; PG8_MMA(0, 0, At, B0); PG8_MMA(0, 1, At, B1); PG8_BAR; PG8_SCHED;
            PG8_LDA(At, 1, 1); PG8_STAGE(PG8_SB(1, 0), b3, voffB); PG8_STAGE(PG8_SB(1, 1), b3 + hstepB, voffB); PG8_STAGE(PG8_SA(1, 0), a3, voffA);
            PG8_WAIT_V(8); PG8_WAIT_L(0); PG8_BAR; PG8_MMA(1, 0, At, B0); PG8_MMA(1, 1, At, B1); PG8_BAR; PG8_SCHED;
            } else {
            PG8_LDB(B0, 0, 0); PG8_SCHED; PG8_LDA(At, 0, 0); PG8_STAGE(PG8_SA(1, 1), a1 + hstepA, voffA);
            PG8_WAIT_L(8); PG8_BAR; PG8_WAIT_L(0); PG8_MMA(0, 0, At, B0); PG8_BAR; PG8_SCHED;
            PG8_LDB(B1, 0, 1); PG8_STAGE(PG8_SB(0, 0), b2, voffB);
            PG8_BAR; PG8_WAIT_L(0); PG8_MMA(0, 1, At, B1); PG8_BAR;
            PG8_LDA(At, 0, 1); PG8_STAGE(PG8_SA(0, 0), a2, voffA);
            PG8_BAR; PG8_WAIT_L(0); PG8_MMA(1, 0, At, B0); PG8_BAR; PG8_SCHED;
            PG8_STAGE(PG8_SB(0, 1), b2 + hstepB, voffB);
            PG8_WAIT_V(6); PG8_BAR; PG8_MMA(1, 1, At, B1); PG8_BAR;
            PG8_LDB(B0, 1, 0); PG8_SCHED; PG8_LDA(At, 1, 0); PG8_STAGE(PG8_SA(0, 1), a2 + hstepA, voffA);
            PG8_WAIT_L(8); PG8_BAR; PG8_WAIT_L(0); PG8_MMA(0, 0, At, B0); PG8_BAR; PG8_SCHED;
            PG8_LDB(B1, 1, 1); PG8_STAGE(PG8_SB(1, 0), b3, voffB);
            PG8_BAR; PG8_WAIT_L(0); PG8_MMA(0, 1, At, B1); PG8_BAR;
            PG8_LDA(At, 1, 1); PG8_STAGE(PG8_SA(1, 0), a3, voffA);
            PG8_BAR; PG8_WAIT_L(0); PG8_MMA(1, 0, At, B0); PG8_BAR; PG8_SCHED;
            PG8_STAGE(PG8_SB(1, 1), b3 + hstepB, voffB);
            PG8_WAIT_V(6); PG8_BAR; PG8_MMA(1, 1, At, B1); PG8_BAR;
            }
        }
        if constexpr (ALIGN_EPI) { if (wr == 0) PG8_BAR; }
        if constexpr (!Epi::AFTER_DRAIN) { E(acc, cur, wr, wc, fr, fq); S.done(cur); }
        if (!has_next) break;
#pragma unroll
        for (int a = 0; a < 2; ++a)
#pragma unroll
            for (int b = 0; b < 2; ++b)
#pragma unroll
                for (int m = 0; m < 4; ++m)
#pragma unroll
                    for (int n = 0; n < 2; ++n) acc[a][b][m][n] = (f32x4){0.f, 0.f, 0.f, 0.f};
        cur = nxt; cA = nA; cB = nB; ++ui;
        if constexpr (ALIGN_EPI) { if (wr == 1) PG8_BAR; }
    }
    PG8_WAIT_V(0);
    if constexpr (!ALIGN_EPI) { if (wr == 0) PG8_BAR; }
    PG8_BAR;
    if constexpr (Epi::AFTER_DRAIN) { E.fused(acc, cur, wr, wc, fr, fq, lds, wid, lane); S.done(cur); }
#undef PG8_KP
#undef PG8_SA
#undef PG8_SB
#undef PG8_STAGE
#undef PG8_LDA
#undef PG8_LDB
#undef PG8_MMA
#undef PG8_WAIT_V
#undef PG8_WAIT_L
#undef PG8_BAR
#undef PG8_SCHED
}
}
#define XB_TMO      128
#define XB_XCNT(j)  (256  + 64 * (j))
#define XB_XSUB(j)  (1280 + 64 * (j))
#define XB_XGEN(j)  (2304 + 64 * (j))
#define XB_TOP      3328
#define XB_TOPGEN   3392
#define XCD_BAR_WORDS 3456
#define XB_SPIN_CAP (1u << 18)

__device__ __forceinline__ unsigned xb_ld(unsigned* p)              { return __hip_atomic_load(p, __ATOMIC_RELAXED, __HIP_MEMORY_SCOPE_AGENT); }
__device__ __forceinline__ unsigned xb_add(unsigned* p, unsigned v) { return __hip_atomic_fetch_add(p, v, __ATOMIC_RELAXED, __HIP_MEMORY_SCOPE_AGENT); }
__device__ __forceinline__ unsigned xb_xcc_id() { return (unsigned)__builtin_amdgcn_s_getreg((3 << 11) | 20) & 0xFu; }
#define XB_SPIN(cond, bar) do { unsigned _sp = 0; while (cond) { __builtin_amdgcn_s_sleep(1); \
    if ((++_sp & 255u) == 0u) { if (xb_ld(&(bar)[XB_TMO])) break; if (_sp > XB_SPIN_CAP) { atomicAdd(&(bar)[XB_TMO], 1u); break; } } } } while (0)

struct XcdBarrier {
    unsigned* bar; unsigned x;
    volatile LAS unsigned* st;
};

__device__ __forceinline__ XcdBarrier xcd_barrier_post(unsigned* bar, volatile LAS unsigned* st) {
    XcdBarrier b; b.bar = bar; b.x = xb_xcc_id(); b.st = st;
    if (threadIdx.x == 0) (void)xb_add(&bar[XB_XCNT(b.x)], 1u);
    return b;
}
__device__ __forceinline__ void xcd_barrier_complete(unsigned* bar, unsigned x, unsigned& nloc, unsigned& nx) {
    const unsigned G = gridDim.x * gridDim.y * gridDim.z;
    unsigned sum, cnt, mine, sp = 0u;
    for (;;) {
        sum = 0u; cnt = 0u; mine = 0u;
#pragma unroll
        for (unsigned j = 0; j < 16; ++j) { const unsigned c = xb_ld(&bar[XB_XCNT(j)]); sum += c; cnt += (c > 0u) ? 1u : 0u; mine = (j == x) ? c : mine; }
        if (sum == G) break;
        __builtin_amdgcn_s_sleep(1);
        if ((++sp & 255u) == 0u) { if (xb_ld(&bar[XB_TMO])) break; if (sp > XB_SPIN_CAP) { atomicAdd(&bar[XB_TMO], 1u); break; } }
    }
    nloc = mine > 0u ? mine : 1u; nx = cnt > 0u ? cnt : 1u;
}

__device__ __forceinline__ void xcd_barrier(const XcdBarrier& b) {
    asm volatile("s_waitcnt vmcnt(0)" ::: "memory");
    __syncthreads();
    if (threadIdx.x == 0) {
        unsigned* bar = b.bar;
        __builtin_amdgcn_s_waitcnt(0);
        unsigned nloc = b.st[0], nx = b.st[1];
        if (nloc == 0u) { xcd_barrier_complete(bar, b.x, nloc, nx); b.st[0] = nloc; b.st[1] = nx; }
        const unsigned old = xb_add(&bar[XB_XSUB(b.x)], 1u);
        const unsigned gen = old / nloc;
        if (old + 1u == (gen + 1u) * nloc) {
            __builtin_amdgcn_fence(__ATOMIC_RELEASE, "agent");
            asm volatile("s_waitcnt vmcnt(0)" ::: "memory");
            const unsigned og = xb_add(&bar[XB_TOP], 1u);
            const unsigned tg = og / nx;
            if (og + 1u == (tg + 1u) * nx) xb_add(&bar[XB_TOPGEN], 1u);
            else XB_SPIN(xb_ld(&bar[XB_TOPGEN]) == tg, bar);
            __builtin_amdgcn_fence(__ATOMIC_ACQUIRE, "agent");
            xb_add(&bar[XB_XGEN(b.x)], 1u);
            asm volatile("s_waitcnt vmcnt(0)" ::: "memory");
        } else {
            XB_SPIN(xb_ld(&bar[XB_XGEN(b.x)]) == gen, bar);
            __builtin_amdgcn_fence(__ATOMIC_ACQUIRE, "agent");
            asm volatile("s_waitcnt vmcnt(0)" ::: "memory");
        }
    }
    __syncthreads();
}
template <int MODE> __device__ __forceinline__ int dest_row(int n) {
    if (MODE == 1) { if (n < 7680) return n; if (n < 7744) { const int i = n - 7680; return 15872 + (i < 32 ? 2 * i : 2 * (i - 32) + 1); } return n - 64; }
    if (MODE == 2) { const int h = n / 192, j = n - h * 192; if (j < 128) return n; const int i = j - 128; return h * 192 + 128 + (i < 32 ? 2 * i : 2 * (i - 32) + 1); }
    if (MODE == 3) { const int isv = n >= DFF ? 1 : 0, ch = n - isv * DFF; return (ch >> 7) * 256 + isv * 128 + (ch & 127); }
    return n;
}
template <int MODE>
__device__ __forceinline__ void tr_item(const float* W, int K, int N, const float* gk, bf16* WT, LAS unsigned* scr, int kb, int nb, int lane, int ldk = 0, int kofs = 0) {
    const int k0 = kb * 64, n0 = nb * 64;
    const float* src = W + (size_t)k0 * N + n0 + lane;
#pragma unroll
    for (int i = 0; i < 32; ++i) {
        float a = src[(size_t)(2 * i) * N], b = src[(size_t)(2 * i + 1) * N];
        if (gk) { a *= gk[k0 + 2 * i]; b *= gk[k0 + 2 * i + 1]; }
        scr[i * 65 + lane] = cvt_pk(a, b);
    }
    LDS_WAIT(); asm volatile("" ::: "memory");
    const int c = lane & 7;
#pragma unroll
    for (int j = 0; j < 8; ++j) { const int n = (lane >> 3) + 8 * j; const LAS unsigned* s = scr + (4 * c) * 65 + n;
        v4u o; o.x = s[0]; o.y = s[65]; o.z = s[130]; o.w = s[195];
        *(GAS v4u*)(WT + (size_t)dest_row<MODE>(n0 + n) * (ldk ? ldk : K) + kofs + k0 + 8 * c) = o; }
    LDS_WAIT(); asm volatile("" ::: "memory");
}

struct Ptrs {
    const float* x; const int* pos; const float* w_in; const float* b_gate; const float *lq1, *lk1, *lq2, *lk2; const float* subln_g; const float *qn_g, *kvn_g;
    const float *w_uq, *w_ukv, *w_pa, *w_pb, *w_out, *ln1_g, *ln1_b, *w_up, *conv_w, *conv_b, *w_down, *ln2_g, *ln2_b;
    float* out; unsigned char* ws;
};

__device__ __forceinline__ void p0_prologue(const Ptrs& P, LAS unsigned char* lds, int vcu, int G, int wave, int lane) {
    LAS unsigned* scr = (LAS unsigned*)(lds + wave * 8448);
    const int gw = vcu * NWAVES + wave, NGW = G * NWAVES;
    unsigned char* ws = P.ws;
    constexpr int I_IN = (IN_COLS / 64) * (DM / 64), I_UQ = (3072 / 64) * (1024 / 64), I_UKV = (4096 / 64) * (512 / 64), I_PA = (4096 / 64) * (2048 / 64), I_OUT = (4096 / 64) * (4096 / 64),
                  I_UP = (22016 / 64) * (4096 / 64), I_DN = (4096 / 64) * (DFF / 64);
    constexpr int NITEMS = I_IN + I_UQ + I_UKV + 2 * I_PA + I_OUT + I_UP + I_DN;
    for (int it = gw; it < NITEMS; it += NGW) {
        int r = it;
        if (r < I_IN)  { tr_item<1>(P.w_in, DM, IN_COLS, nullptr, (bf16*)(ws + WS_WIN), scr, r % (DM / 64), r / (DM / 64), lane); continue; } r -= I_IN;
        if (r < I_UQ)  { tr_item<2>(P.w_uq, 1024, 3072, P.qn_g, (bf16*)(ws + WS_WUQ), scr, r % 16, r / 16, lane); continue; } r -= I_UQ;
        if (r < I_UKV) { tr_item<0>(P.w_ukv, 512, 4096, P.kvn_g, (bf16*)(ws + WS_WUKV), scr, r % 8, r / 8, lane); continue; } r -= I_UKV;
        if (r < I_PA)  { tr_item<0>(P.w_pa, 2048, 4096, nullptr, (bf16*)(ws + WS_WPA), scr, r % 32, r / 32, lane, 4096, 0); continue; } r -= I_PA;
        if (r < I_PA)  { tr_item<0>(P.w_pb, 2048, 4096, nullptr, (bf16*)(ws + WS_WPA), scr, r % 32, r / 32, lane, 4096, 2048); continue; } r -= I_PA;
        if (r < I_OUT) { tr_item<0>(P.w_out, 4096, 4096, nullptr, (bf16*)(ws + WS_WOUT), scr, r % 64, r / 64, lane); continue; } r -= I_OUT;
        if (r < I_UP)  { tr_item<3>(P.w_up, 4096, 22016, nullptr, (bf16*)(ws + WS_WUP), scr, r % 64, r / 64, lane); continue; } r -= I_UP;
        tr_item<0>(P.w_down, DFF, 4096, nullptr, (bf16*)(ws + WS_WDN), scr, r % (DFF / 64), r / (DFF / 64), lane);
    }
    { const size_t n8 = (size_t)M * DM / 8; GAS v4u* xb = (GAS v4u*)(ws + WS_XB);
      for (size_t i = (size_t)gw * 64 + lane; i < n8; i += (size_t)NGW * 64) { const f32x4 a = *(const GAS f32x4*)(P.x + i * 8), b = *(const GAS f32x4*)(P.x + i * 8 + 4);
          v4u o; o.x = cvt_pk(a[0], a[1]); o.y = cvt_pk(a[2], a[3]); o.z = cvt_pk(b[0], b[1]); o.w = cvt_pk(b[2], b[3]); xb[i] = o; } }
    { GAS v4u* z = (GAS v4u*)(ws + WS_WIN + (size_t)IN_COLS * DM * 2); const size_t nz = (size_t)(N1 - IN_COLS) * DM * 2 / 16;
      for (size_t i = (size_t)gw * 64 + lane; i < nz; i += (size_t)NGW * 64) z[i] = (v4u){0u, 0u, 0u, 0u};
    }
    { GAS float* rt = (GAS float*)(ws + WS_ROPE);
      for (int i = gw * 64 + lane; i < M * 32; i += NGW * 64) { const int m = i >> 5, k = i & 31;
          const double inv = exp2(-(double)k * (13.287712379549449 / 32.0));
          const double rev = (double)P.pos[m] * inv * 0.15915494309189535;
          const float fr = (float)(rev - rint(rev));
          rt[(size_t)m * 64 + k] = __builtin_amdgcn_cosf(fr); rt[(size_t)m * 64 + 32 + k] = __builtin_amdgcn_sinf(fr); } }
}

namespace att {
__device__ __forceinline__ void glds16(const void* sbase, unsigned voff, unsigned lds_dst) {
    unsigned keep;
    asm volatile("s_mov_b32 %0, m0\n\ts_mov_b32 m0, %3\n\ts_nop 0\n\tglobal_load_lds_dwordx4 %1, %2\n\ts_mov_b32 m0, %0" : "=&s"(keep) : "v"(voff), "s"(sbase), "s"(lds_dst) : "memory");
}
__device__ __forceinline__ int v_rd_base(int lane) { return ((lane & 3) << 3) | (((lane >> 2) & 3) << 6) | (((lane >> 4) & 1) << 5) | (((lane >> 5) & 1) << 8); }
#define ATT_BAR() asm volatile("s_barrier" ::: "memory")

template <int DQK, int DV, bool ALIBI>
__device__ __forceinline__ void attn_block(LAS unsigned char* lds, const unsigned char* wsb, const bf16* Q, int ldq, unsigned kofs, unsigned ldkB, unsigned vofs, unsigned ldvB,
                                           int qb, float slope2, f32x16 (&o)[DV / 32], float& l_out) {
    constexpr int NQF = DQK / 16, NOD = DV / 32, KROW = DQK * 2, KT = 64 * KROW, VT = 64 * DV * 2, KCH = DQK / 8, NKI = KT / 8192, NVI = VT / 8192;
    const int tid = threadIdx.x, wid = __builtin_amdgcn_readfirstlane(tid >> 6), lane = tid & 63, r32 = lane & 31, hi = lane >> 5;
    const unsigned ldsb = (unsigned)(uintptr_t)lds;
    __builtin_assume(qb >= 0); __builtin_assume(qb < 32);
    const int NT = 4 * (qb + 1);
    constexpr bool KEEP = (DV == 128);
#define KSW(cs_, row_) (DQK == 128 ? ((cs_) ^ ((row_) & 15)) : (((cs_) & ~7) | (((cs_) ^ ((row_) >> 1)) & 7)))
    unsigned krel[NKI], vrel[NVI];
    if (KEEP) {
#pragma unroll
        for (int j = 0; j < NKI; ++j) { const int p = (j * 8 + wid) * 64 + lane, row = p / KCH, cs = p - row * KCH, c = KSW(cs, row); krel[j] = kofs + (unsigned)row * ldkB + (unsigned)c * 16u; }
#pragma unroll
        for (int j = 0; j < NVI; ++j) { const int p = (j * 8 + wid) * 64 + lane, s = p >> 5, rr = (p & 31) >> 2, cc = p & 3, kg = s / NOD, d0 = s - kg * NOD, kk = kg * 8 + rr;
            const int key = (kk & ~0xC) | ((kk & 4) << 1) | ((kk & 8) >> 1); vrel[j] = vofs + (unsigned)key * ldvB + (unsigned)(d0 * 32 + cc * 8) * 2u; }
    }
#define ATT_ISSUE(t_, bf_) do { if (KEEP) { const unsigned kb_ = (unsigned)(t_) * 64u; \
        _Pragma("unroll") for (int j = 0; j < NKI; ++j) glds16(wsb, krel[j] + kb_ * ldkB, (unsigned)__builtin_amdgcn_readfirstlane(ldsb + (bf_) * KT + (j * 8 + wid) * 1024)); \
        _Pragma("unroll") for (int j = 0; j < NVI; ++j) glds16(wsb, vrel[j] + kb_ * ldvB, (unsigned)__builtin_amdgcn_readfirstlane(ldsb + 2 * KT + (bf_) * VT + (j * 8 + wid) * 1024)); } else ATT_ISSUE_RC(t_, bf_); } while (0)
#define ATT_ISSUE_RC(t_, bf_) do { const unsigned kb_ = (unsigned)(t_) * 64u; int ln_ = lane; asm volatile("" : "+v"(ln_)); \
        _Pragma("unroll") for (int j = 0; j < NKI; ++j) { const int p = (j * 8 + wid) * 64 + ln_, row = p / KCH, cs = p - row * KCH, c = KSW(cs, row); \
            glds16(wsb, kofs + ((unsigned)row + kb_) * ldkB + (unsigned)c * 16u, (unsigned)__builtin_amdgcn_readfirstlane(ldsb + (bf_) * KT + (j * 8 + wid) * 1024)); } \
        _Pragma("unroll") for (int j = 0; j < NVI; ++j) { const int p = (j * 8 + wid) * 64 + ln_, s = p >> 5, rr = (p & 31) >> 2, cc = p & 3, kg = s / NOD, d0 = s - kg * NOD, kk = kg * 8 + rr; \
            const int key = (kk & ~0xC) | ((kk & 4) << 1) | ((kk & 8) >> 1); \
            glds16(wsb, vofs + ((unsigned)key + kb_) * ldvB + (unsigned)(d0 * 32 + cc * 8) * 2u, (unsigned)__builtin_amdgcn_readfirstlane(ldsb + 2 * KT + (bf_) * VT + (j * 8 + wid) * 1024)); } } while (0)
    ATT_BAR();
    ATT_ISSUE(NT - 1, 0);
    bf16x8 qr[NQF];
#pragma unroll
    for (int d0 = 0; d0 < NQF; ++d0) qr[d0] = *(const bf16x8*)(Q + (size_t)(wid * 32 + r32) * ldq + d0 * 16 + hi * 8);
    float m_reg = -1e30f, l_reg = 0.f;
#pragma unroll
    for (int d0 = 0; d0 < NOD; ++d0)
#pragma unroll
        for (int r = 0; r < 16; ++r) o[d0][r] = 0.f;
    const int qi = qb * 256 + wid * 32 + r32;
#pragma unroll
    for (int d0 = 0; d0 < NQF; ++d0) asm volatile("" : "+v"(qr[d0]));
    for (int i = 0; i < NT; ++i) {
        const int t = NT - 1 - i, bf = i & 1;
        asm volatile("s_waitcnt vmcnt(0)\n\ts_barrier" ::: "memory");
        if (i + 1 < NT) ATT_ISSUE(t - 1, bf ^ 1);
        const int jb = t - 4 * qb;
        if (jb > (wid >> 1)) continue;
        f32x16 p0, p1;
        if (ALIBI) {
            float s2o = slope2; asm volatile("" : "+v"(s2o));
            const float h4 = s2o * (float)(4 * hi);
#pragma unroll
            for (int r = 0; r < 16; ++r) { const float cr = (float)((r & 3) + 8 * (r >> 2)); p0[r] = __builtin_fmaf(s2o, cr, h4); p1[r] = __builtin_fmaf(s2o, cr + 32.f, h4); }
        } else {
#pragma unroll
            for (int r = 0; r < 16; ++r) { p0[r] = 0.f; p1[r] = 0.f; }
        }
        { const LAS unsigned char* kt = lds + bf * KT + r32 * KROW;
          const LAS unsigned char* kb4[4];
          const int key = DQK == 128 ? r32 : (r32 >> 1), hb = DQK == 128 ? ((r32 >> 3) & 1) : 0;
#pragma unroll
          for (int dd = 0; dd < 4; ++dd) kb4[dd] = kt + ((((dd * 2 + hi) ^ key) & 7) << 4) + hb * 128;
#pragma unroll
          for (int d0 = 0; d0 < NQF; ++d0) { const LAS unsigned char* a = DQK == 128 ? kb4[d0 & 3] + ((d0 >> 2) ? 128 - 256 * hb : 0) : kb4[d0 & 3] + (d0 >> 2) * 128;
              const bf16x8 b0 = *(const LAS bf16x8*)a, b1 = *(const LAS bf16x8*)(a + 32 * KROW);
              p0 = __builtin_amdgcn_mfma_f32_32x32x16_bf16(b0, qr[d0], p0, 0, 0, 0);
              p1 = __builtin_amdgcn_mfma_f32_32x32x16_bf16(b1, qr[d0], p1, 0, 0, 0); } }
        __builtin_amdgcn_sched_barrier(0);
        const int kb = t * 64;
        float bq = 0.f;
        if (ALIBI) bq = slope2 * (float)(kb - qi);
        if (jb == (wid >> 1)) { const int dq = qi - kb - 4 * hi; const float NEG = -__builtin_inff();
#pragma unroll
            for (int r = 0; r < 16; ++r) { const int c = (r & 3) + 8 * (r >> 2); if (c > dq) p0[r] = NEG; if (c + 32 > dq) p1[r] = NEG; } }
        float pmax = p0[0];
#pragma unroll
        for (int r = 1; r < 16; ++r) pmax = fmaxf(pmax, p0[r]);
#pragma unroll
        for (int r = 0; r < 16; ++r) pmax = fmaxf(pmax, p1[r]);
        { auto rr = __builtin_amdgcn_permlane32_swap(__float_as_uint(pmax), __float_as_uint(pmax), false, false); pmax = fmaxf(__uint_as_float(rr[0]), __uint_as_float(rr[1])); }
        const float mx = pmax + bq;
        float alpha = 1.f;
        if (!__all(mx - m_reg <= 8.f)) { const float mn = fmaxf(m_reg, mx); alpha = __builtin_amdgcn_exp2f(m_reg - mn); m_reg = mn;
#pragma unroll
            for (int d0 = 0; d0 < NOD; ++d0)
#pragma unroll
                for (int r = 0; r < 16; ++r) o[d0][r] *= alpha; }
        const float ms = m_reg - bq;
        float ps = 0.f;
#pragma unroll
        for (int r = 0; r < 16; ++r) { p0[r] = __builtin_amdgcn_exp2f(p0[r] - ms); ps += p0[r]; }
#pragma unroll
        for (int r = 0; r < 16; ++r) { p1[r] = __builtin_amdgcn_exp2f(p1[r] - ms); ps += p1[r]; }
        { auto rr = __builtin_amdgcn_permlane32_swap(__float_as_uint(ps), __float_as_uint(ps), false, false); ps = __uint_as_float(rr[0]) + __uint_as_float(rr[1]); }
        l_reg = l_reg * alpha + ps;
        bf16x8 pa0, pa1, pa2, pa3;
#define ATT_PK4(P, B_, OUT) do { const unsigned a0 = cvt_pk(P[B_ + 0], P[B_ + 1]), a1 = cvt_pk(P[B_ + 2], P[B_ + 3]), b0 = cvt_pk(P[B_ + 4], P[B_ + 5]), b1 = cvt_pk(P[B_ + 6], P[B_ + 7]); \
        auto r0 = __builtin_amdgcn_permlane32_swap(a0, b0, false, false); auto r1 = __builtin_amdgcn_permlane32_swap(a1, b1, false, false); \
        v4u w = {r0[0], r1[0], r0[1], r1[1]}; OUT = __builtin_bit_cast(bf16x8, w); } while (0)
        ATT_PK4(p0, 0, pa0); ATT_PK4(p0, 8, pa1); ATT_PK4(p1, 0, pa2); ATT_PK4(p1, 8, pa3);
#undef ATT_PK4
        __builtin_amdgcn_sched_barrier(0);
        { const unsigned vb0 = ldsb + 2 * KT + bf * VT + v_rd_base(lane);
#define ATT_TRRD(dst, off) asm volatile("ds_read_b64_tr_b16 %0, %1 offset:%2" : "=&v"(dst) : "v"(vb0), "i"(off) : "memory")
#define ATT_VLOAD(S, d0_) do { ATT_TRRD(S##l0, (0 * NOD + (d0_)) * 512); ATT_TRRD(S##h0, (1 * NOD + (d0_)) * 512); ATT_TRRD(S##l1, (2 * NOD + (d0_)) * 512); ATT_TRRD(S##h1, (3 * NOD + (d0_)) * 512); \
              ATT_TRRD(S##l2, (4 * NOD + (d0_)) * 512); ATT_TRRD(S##h2, (5 * NOD + (d0_)) * 512); ATT_TRRD(S##l3, (6 * NOD + (d0_)) * 512); ATT_TRRD(S##h3, (7 * NOD + (d0_)) * 512); } while (0)
#define ATT_VMMA(S, d0_) do { \
              o[d0_] = __builtin_amdgcn_mfma_f32_32x32x16_bf16((bf16x8){S##l0[0], S##l0[1], S##l0[2], S##l0[3], S##h0[0], S##h0[1], S##h0[2], S##h0[3]}, pa0, o[d0_], 0, 0, 0); \
              o[d0_] = __builtin_amdgcn_mfma_f32_32x32x16_bf16((bf16x8){S##l1[0], S##l1[1], S##l1[2], S##l1[3], S##h1[0], S##h1[1], S##h1[2], S##h1[3]}, pa1, o[d0_], 0, 0, 0); \
              o[d0_] = __builtin_amdgcn_mfma_f32_32x32x16_bf16((bf16x8){S##l2[0], S##l2[1], S##l2[2], S##l2[3], S##h2[0], S##h2[1], S##h2[2], S##h2[3]}, pa2, o[d0_], 0, 0, 0); \
              o[d0_] = __builtin_amdgcn_mfma_f32_32x32x16_bf16((bf16x8){S##l3[0], S##l3[1], S##l3[2], S##l3[3], S##h3[0], S##h3[1], S##h3[2], S##h3[3]}, pa3, o[d0_], 0, 0, 0); } while (0)
          s16x4 Al0, Al1, Al2, Al3, Ah0, Ah1, Ah2, Ah3, Bl0, Bl1, Bl2, Bl3, Bh0, Bh1, Bh2, Bh3;
          ATT_VLOAD(A, 0);
#pragma unroll
          for (int d0 = 0; d0 < NOD; d0 += 2) {
              ATT_VLOAD(B, d0 + 1);
              asm volatile("s_waitcnt lgkmcnt(8)" ::: "memory"); __builtin_amdgcn_sched_barrier(0);
              ATT_VMMA(A, d0);
              if (d0 + 2 < NOD) { ATT_VLOAD(A, d0 + 2); asm volatile("s_waitcnt lgkmcnt(8)" ::: "memory"); }
              else asm volatile("s_waitcnt lgkmcnt(0)" ::: "memory");
              __builtin_amdgcn_sched_barrier(0);
              ATT_VMMA(B, d0 + 1);
          }
#undef ATT_VLOAD
#undef ATT_VMMA
#undef ATT_TRRD
        }
    }
#undef ATT_ISSUE
#undef ATT_ISSUE_RC
#undef KSW
    l_out = l_reg;
}

constexpr int CW_ATTQ = 8192, CW_NMAX = 12288;
__device__ __forceinline__ void attn_phase(const Ptrs& P, LAS unsigned char* lds, volatile LAS unsigned* MISC, gu32* ctl, int qoff) {
    const int tid = threadIdx.x, wid = __builtin_amdgcn_readfirstlane(tid >> 6), lane = tid & 63, r32 = lane & 31, hi = lane >> 5;
    unsigned char* ws = P.ws;
    const bf16* QKV = (const bf16*)(ws + WS_QKV); const bf16* QB = (const bf16*)(ws + WS_QB); bf16* OAB = (bf16*)(ws + WS_OAB);
    float lam;
    { const float s1 = wave_sum(P.lq1[lane] * P.lk1[lane] + P.lq1[lane + 64] * P.lk1[lane + 64]), s2 = wave_sum(P.lq2[lane] * P.lk2[lane] + P.lq2[lane + 64] * P.lk2[lane + 64]);
      lam = expf(s1) - expf(s2) + LAMBDA_INIT; }
    const int q0 = (int)(xb_xcc_id() & 7u);
    if (tid < 64) MISC[64 + tid] = 0u;
    __syncthreads();
    { const int w = tid & 63; unsigned mx = 0u; const GAS unsigned* part = (const GAS unsigned*)(ws + WS_NPART);
      for (int g = tid >> 6; g < (int)gridDim.x; g += 8) { const unsigned v = part[g * 64 + w]; mx = v > mx ? v : mx; }
      __hip_atomic_fetch_max((LAS unsigned*)(MISC + 64 + w), mx, __ATOMIC_RELAXED, __HIP_MEMORY_SCOPE_WORKGROUP); }
    __syncthreads();
    if (tid < 32) { const int b = tid >> 4, h = (tid >> 1) & 7, map = tid & 1;
        const float nq = __uint_as_float(MISC[64 + (b * 16 + h * 2 + map) * 2]), nk = __uint_as_float(MISC[64 + (b * 16 + h * 2 + map) * 2 + 1]);
        const float slope2 = LOG2E * exp2f(-(float)(h + 1));
        const float B = sqrtf(nq * nk) * 1.001f + 0.01f, Wf = (2.f * B + 126.f) / slope2;
        const float wq = ceilf(Wf * (1.0001f / 256.f) + 0.001f);
        MISC[32 + tid] = wq < 1000.f ? (unsigned)wq : 1000u; }
    __syncthreads();
    for (int dq = 0; dq < 8; ++dq) {
        const int q = (q0 + dq) & 7, b = q >> 2, qx = q & 3;
        for (;;) {
            if (tid == 0) MISC[16] = __hip_atomic_fetch_add((unsigned*)(ctl + CW_ATTQ + qoff + 64 * q), 1u, __ATOMIC_RELAXED, __HIP_MEMORY_SCOPE_AGENT);
            __syncthreads();
            const int n = (int)__builtin_amdgcn_readfirstlane(MISC[16]);
            __syncthreads();
            if (n >= 64) break;
            const int h = (n < 32) ? 7 - qx : qx, qb = 31 - (n & 31);
            const float slope2 = LOG2E * exp2f(-(float)(h + 1));
            unsigned char* scrb = ws + WS_O0 + (size_t)blockIdx.x * 262144 + (size_t)wid * 32768;
            const size_t rowq = (size_t)b * SEQ + (size_t)qb * 256;
#pragma unroll 1
            for (int map = 0; map < 2; ++map) {
                int qs = qb - (int)MISC[32 + (b * 8 + h) * 2 + map]; qs = __builtin_amdgcn_readfirstlane(qs > 0 ? qs : 0);
                f32x16 o[8]; float l;
                attn_block<128, 256, true>(lds, ws, QKV + rowq * 6144 + h * 256 + map * 128, 6144,
                                           (unsigned)(WS_QKV + (((size_t)b * SEQ + (size_t)qs * 256) * 6144 + 2048 + h * 256 + map * 128) * 2), 12288u,
                                           (unsigned)(WS_QKV + (((size_t)b * SEQ + (size_t)qs * 256) * 6144 + 4096 + h * 256) * 2), 12288u, qb - qs, slope2, o, l);
                const float inv = 1.f / l;
                unsigned so = (unsigned)lane * 16u; asm volatile("" : "+v"(so));
                f32x4* scr = (f32x4*)(scrb + so);
                if (map == 0) {
#pragma unroll
                    for (int d0 = 0; d0 < 8; ++d0)
#pragma unroll
                        for (int g = 0; g < 4; ++g) scr[(d0 * 4 + g) * 64] = (f32x4){o[d0][4 * g] * inv, o[d0][4 * g + 1] * inv, o[d0][4 * g + 2] * inv, o[d0][4 * g + 3] * inv};
                } else {
                    const float li = lam * inv; float ss = 0.f;
#pragma unroll
                    for (int d0 = 0; d0 < 8; ++d0) {
#pragma unroll
                        for (int g = 0; g < 4; ++g) { const f32x4 a = scr[(d0 * 4 + g) * 64];
#pragma unroll
                            for (int e = 0; e < 4; ++e) { const float v = a[e] - li * o[d0][4 * g + e]; ss += v * v; } }
                        asm volatile("" : "+v"(ss) :: "memory"); }
                    { auto rr = __builtin_amdgcn_permlane32_swap(__float_as_uint(ss), __float_as_uint(ss), false, false); ss = __uint_as_float(rr[0]) + __uint_as_float(rr[1]); }
                    const float rs = __builtin_amdgcn_rsqf(ss * (1.f / 256.f) + RMS_EPS) * (1.f - LAMBDA_INIT);
                    unsigned oo = (unsigned)((wid * 32 + r32) * 4096 + 4 * hi) * 2u; asm volatile("" : "+v"(oo));
                    bf16* orow = (bf16*)((unsigned char*)(OAB + rowq * 4096 + h * 256) + oo);
#pragma unroll
                    for (int d0 = 0; d0 < 8; ++d0) {
#pragma unroll
                        for (int g = 0; g < 4; ++g) { const f32x4 a = scr[(d0 * 4 + g) * 64]; const f32x4 gg = *(const f32x4*)(P.subln_g + d0 * 32 + 8 * g + 4 * hi);
                            float v[4];
#pragma unroll
                            for (int e = 0; e < 4; ++e) v[e] = (a[e] - li * o[d0][4 * g + e]) * rs * gg[e];
                            v2u w; w.x = cvt_pk(v[0], v[1]); w.y = cvt_pk(v[2], v[3]);
                            *(v2u*)(orow + d0 * 32 + 8 * g) = w; }
                        asm volatile("" ::: "memory"); }
                }
            }
        }
    }
    for (int dq = 0; dq < 8; ++dq) {
        const int q = (q0 + dq) & 7, b = q >> 2, qx = q & 3;
        for (;;) {
            if (tid == 0) MISC[16] = __hip_atomic_fetch_add((unsigned*)(ctl + CW_ATTQ + qoff + 64 * (8 + q)), 1u, __ATOMIC_RELAXED, __HIP_MEMORY_SCOPE_AGENT);
            __syncthreads();
            const int n = (int)__builtin_amdgcn_readfirstlane(MISC[16]);
            __syncthreads();
            if (n >= 128) break;
            const int h = 4 * qx + (n & 3), qb = 31 - (n >> 2);
            const size_t rowq = (size_t)b * SEQ + (size_t)qb * 256;
            f32x16 o[4]; float l;
            const unsigned kofs = (unsigned)(WS_KVB + ((size_t)b * SEQ * KVLD + h * 320) * 2);
            attn_block<192, 128, false>(lds, ws, QB + rowq * 3072 + h * 192, 3072, kofs, (unsigned)(KVLD * 2), kofs + 384u, (unsigned)(KVLD * 2), qb, 0.f, o, l);
            const float inv = 1.f / l;
            unsigned oo = (unsigned)((wid * 32 + r32) * 4096 + 4 * hi) * 2u; asm volatile("" : "+v"(oo));
            bf16* orow = (bf16*)((unsigned char*)(OAB + rowq * 4096 + 2048 + h * 128) + oo);
#pragma unroll
            for (int d0 = 0; d0 < 4; ++d0)
#pragma unroll
                for (int g = 0; g < 4; ++g) { v2u w; w.x = cvt_pk(o[d0][4 * g] * inv, o[d0][4 * g + 1] * inv); w.y = cvt_pk(o[d0][4 * g + 2] * inv, o[d0][4 * g + 3] * inv);
                    *(v2u*)(orow + d0 * 32 + 8 * g) = w; }
        }
    }
}
}

__device__ __forceinline__ void rowss_phase(const bf16* LAT, float* rowss, int gw, int NGW, int lane) {
    for (int m = gw; m < M; m += NGW) {
        const GAS v4u* r = (const GAS v4u*)(LAT + (size_t)m * 1536) + lane;
        float sq = 0.f, sk = 0.f;
#pragma unroll
        for (int j = 0; j < 3; ++j) { const v4u w = r[64 * j]; f32x4 a, b; pg8::unpack8(w, a, b);
            const float t = (a[0] * a[0] + a[1] * a[1]) + (a[2] * a[2] + a[3] * a[3]) + (b[0] * b[0] + b[1] * b[1]) + (b[2] * b[2] + b[3] * b[3]);
            if (j < 2) sq += t; else sk += t; }
        sq = wave_sum(sq); sk = wave_sum(sk);
        if (lane == 0) { rowss[m] = sq; rowss[M + m] = sk; }
    }
}
__device__ __forceinline__ void normmax_phase(const bf16* QKV, volatile LAS unsigned* nmax  , int gw, int NGW, int lane) {
    float mq[4] = {0.f, 0.f, 0.f, 0.f}, mk[4] = {0.f, 0.f, 0.f, 0.f}; int cur_b = -1;
    for (int m = gw; ; m += NGW) {
        const int b = m < M ? m / SEQ : -2;
        if (b != cur_b) {
            if (cur_b >= 0 && (lane & 15) == 0) {
#pragma unroll
                for (int j = 0; j < 4; ++j) { const int v = j * 4 + (lane >> 4);
                    __hip_atomic_fetch_max((LAS unsigned*)(nmax + (cur_b * 16 + v) * 2), __float_as_uint(mq[j]), __ATOMIC_RELAXED, __HIP_MEMORY_SCOPE_WORKGROUP);
                    __hip_atomic_fetch_max((LAS unsigned*)(nmax + (cur_b * 16 + v) * 2 + 1), __float_as_uint(mk[j]), __ATOMIC_RELAXED, __HIP_MEMORY_SCOPE_WORKGROUP); } }
#pragma unroll
            for (int j = 0; j < 4; ++j) { mq[j] = 0.f; mk[j] = 0.f; }
            cur_b = b;
        }
        if (m >= M) break;
        const GAS v4u* rq = (const GAS v4u*)(QKV + (size_t)m * 6144) + lane;
#pragma unroll
        for (int j = 0; j < 4; ++j) {
            f32x4 a, c; pg8::unpack8(rq[64 * j], a, c);
            float tq = (a[0] * a[0] + a[1] * a[1]) + (a[2] * a[2] + a[3] * a[3]) + (c[0] * c[0] + c[1] * c[1]) + (c[2] * c[2] + c[3] * c[3]);
            pg8::unpack8(rq[256 + 64 * j], a, c);
            float tk = (a[0] * a[0] + a[1] * a[1]) + (a[2] * a[2] + a[3] * a[3]) + (c[0] * c[0] + c[1] * c[1]) + (c[2] * c[2] + c[3] * c[3]);
#pragma unroll
            for (int o = 1; o < 16; o <<= 1) { tq += __shfl_xor(tq, o); tk += __shfl_xor(tk, o); }
            mq[j] = fmaxf(mq[j], tq); mk[j] = fmaxf(mk[j], tk);
        }
    }
}
__device__ __forceinline__ void ln_phase(float* io, const float* g, const float* bta, bf16* ob, float* stat  , int gw, int NGW, int lane) {
    for (int m = gw; m < M; m += NGW) {
        GAS f32x4* xr = (GAS f32x4*)(io + (size_t)m * DM) + lane;
        f32x4 v[16]; float s = 0.f;
#pragma unroll
        for (int j = 0; j < 16; ++j) { v[j] = xr[64 * j]; s += (v[j][0] + v[j][1]) + (v[j][2] + v[j][3]); }
        const float mean = wave_sum(s) * (1.f / DM); float s2 = 0.f;
#pragma unroll
        for (int j = 0; j < 16; ++j) { v[j] = v[j] - mean; s2 += (v[j][0] * v[j][0] + v[j][1] * v[j][1]) + (v[j][2] * v[j][2] + v[j][3] * v[j][3]); }
        const float rstd = 1.f / sqrtf(wave_sum(s2) * (1.f / DM) + LN_EPS);
        if (stat && lane == 0) { stat[m] = mean; stat[M + m] = rstd; }
#pragma unroll
        for (int j = 0; j < 16; ++j) { const f32x4 gg = *(const f32x4*)(g + 4 * lane + 256 * j), bb = *(const f32x4*)(bta + 4 * lane + 256 * j);
            const f32x4 y = v[j] * rstd * gg + bb; if (!stat) xr[64 * j] = y;
            if (ob) { v2u w; w.x = cvt_pk(y[0], y[1]); w.y = cvt_pk(y[2], y[3]); *((GAS v2u*)(ob + (size_t)m * DM) + lane + 64 * j) = w; } }
    }
}
__device__ __forceinline__ void conv_fix_phase(const bf16* SIDE, const float* cw, const float* cb, bf16* ACT, int gw, int NGW, int lane) {
    constexpr int NCG = (DFF + 511) / 512, NCH = M / 64;
    for (int it = gw; it < NCG * NCH; it += NGW) {
        const int cg = it % NCG, c = it / NCG, ch = cg * 512 + lane * 8;
        if (ch >= DFF) continue;
        const bool first = (c % (SEQ / 64)) == 0;
        f32x4 u[4][2][2];
#pragma unroll
        for (int j = 0; j < 4; ++j)
#pragma unroll
            for (int gv = 0; gv < 2; ++gv) {
                if (j < 2 && first) { u[j][gv][0] = (f32x4){0.f, 0.f, 0.f, 0.f}; u[j][gv][1] = (f32x4){0.f, 0.f, 0.f, 0.f}; }
                else { const int cc = j < 2 ? c - 1 : c, jj = j < 2 ? j + 2 : j - 2;
                    pg8::unpack8(*(const v4u*)(SIDE + ((size_t)(cc * 4 + jj) * 2 + gv) * DFF + ch), u[j][gv][0], u[j][gv][1]); } }
#pragma unroll
        for (int r = 0; r < 2; ++r) {
            float o[8];
#pragma unroll
            for (int e = 0; e < 8; ++e) {
                const int h = e >> 2, q = e & 3;
                const float cgate = cb[ch + e] + cw[ch + e] * u[r][0][h][q] + cw[(size_t)2 * DFF + ch + e] * u[r + 1][0][h][q] + cw[(size_t)4 * DFF + ch + e] * u[r + 2][0][h][q];
                const float cval = cb[DFF + ch + e] + cw[DFF + ch + e] * u[r][1][h][q] + cw[(size_t)3 * DFF + ch + e] * u[r + 1][1][h][q] + cw[(size_t)5 * DFF + ch + e] * u[r + 2][1][h][q];
                o[e] = cgate * pg8::sigmoidf_(cgate) * cval;
            }
            v4u w; w.x = cvt_pk(o[0], o[1]); w.y = cvt_pk(o[2], o[3]); w.z = cvt_pk(o[4], o[5]); w.w = cvt_pk(o[6], o[7]);
            *(v4u*)(ACT + (size_t)(c * 64 + r) * DFF + ch) = w;
        }
    }
}

struct Args { const void* in[24]; float* out; unsigned char* ws; int ph_lo, ph_hi, li, pad; };
constexpr int N_PHASES = 11;
__global__ void __launch_bounds__(NWAVES * 64, 2) mk_fwd(Args args) {
    extern __shared__ __attribute__((aligned(16))) unsigned char lds_raw[];
    LAS unsigned char* lds = (LAS unsigned char*)lds_raw;
    volatile LAS unsigned* MISC = (volatile LAS unsigned*)(lds + MISC_OFF);
    const int tid = threadIdx.x, lane = tid & 63, wave = __builtin_amdgcn_readfirstlane(tid >> 6);
    const int G = gridDim.x; const int bx = blockIdx.x; const int vcu = (G % 8 == 0) ? (bx % 8) * (G / 8) + bx / 8 : bx;
    Ptrs P;
    P.x = (const float*)args.in[0]; P.pos = (const int*)args.in[1]; P.w_in = (const float*)args.in[2]; P.b_gate = (const float*)args.in[3];
    P.lq1 = (const float*)args.in[4]; P.lk1 = (const float*)args.in[5]; P.lq2 = (const float*)args.in[6]; P.lk2 = (const float*)args.in[7];
    P.subln_g = (const float*)args.in[8]; P.qn_g = (const float*)args.in[9]; P.kvn_g = (const float*)args.in[10];
    P.w_uq = (const float*)args.in[11]; P.w_ukv = (const float*)args.in[12]; P.w_pa = (const float*)args.in[13]; P.w_pb = (const float*)args.in[14]; P.w_out = (const float*)args.in[15];
    P.ln1_g = (const float*)args.in[16]; P.ln1_b = (const float*)args.in[17]; P.w_up = (const float*)args.in[18]; P.conv_w = (const float*)args.in[19]; P.conv_b = (const float*)args.in[20];
    P.w_down = (const float*)args.in[21]; P.ln2_g = (const float*)args.in[22]; P.ln2_b = (const float*)args.in[23];
    P.out = args.out; P.ws = args.ws;
    unsigned char* ws = args.ws;
    gu32* ctl = (gu32*)(ws + WS_CTL);
    for (int u = tid; u < (LDS_BYTES - LDSCTL_OFF) / 4; u += NWAVES * 64) ((LAS unsigned*)(lds + LDSCTL_OFF))[u] = 0u;
    __syncthreads();
    XcdBarrier bar = xcd_barrier_post((unsigned*)(ctl + 4096) + args.li * XCD_BAR_WORDS, MISC + 8);
    const int lo = args.ph_lo, hi = args.ph_hi;
#define IN(k) (lo <= (k) && (k) < hi)
#define SEAM(k) do { if (IN(k) && IN((k) + 1)) xcd_barrier(bar); } while (0)
#define SEAM2B() do { if (IN(2)) xcd_barrier(bar); } while (0)
    const int gw = vcu * NWAVES + wave, NGW = G * NWAVES;
    typedef pg8::bf16_t bt;
    const int xcd_rot = bx & 7;
#define KOFF(K_) ((((K_) / 64) * xcd_rot / 8) & ~1)

    if (IN(0)) { p0_prologue(P, lds, vcu, G, wave, lane); } SEAM(0);

    if (IN(1)) {
        pg8::Gemm g{(const bt*)(ws + WS_XB), (const bt*)(ws + WS_WIN), M, N1, DM, DM, DM, KOFF(DM)}; pg8::StaticOrder S; S.init(M, N1, G, bx);
        pg8::EpiIn E{(bt*)(ws + WS_QKV), (bt*)(ws + WS_LAT), (bt*)(ws + WS_G), (bt*)(ws + WS_KVB), (float*)(ws + WS_ROWSS), P.b_gate, (const float*)(ws + WS_ROPE), C2A, M};
        pg8::gemm_phase<pg8::EpiIn, pg8::StaticOrder, true, true>(lds, g, S, E);
    } SEAM(1);

    if (IN(2)) {
        if (tid < 64) MISC[64 + tid] = 0u;
        __syncthreads();
        rowss_phase((const bf16*)(ws + WS_LAT), (float*)(ws + WS_ROWSS), gw, NGW, lane);
        normmax_phase((const bf16*)(ws + WS_QKV), MISC + 64, gw, NGW, lane);
        __syncthreads();
        if (tid < 64) ((GAS unsigned*)(ws + WS_NPART))[bx * 64 + tid] = MISC[64 + tid];
    } SEAM2B();

    if (IN(2)) {
        { pg8::Gemm g{(const bt*)(ws + WS_LAT), (const bt*)(ws + WS_WUQ), M, 3072, 1024, 1536, 1024, KOFF(1024)}; pg8::StaticOrder S; S.init(M, 3072, G, bx);
          pg8::EpiQb E{(bt*)(ws + WS_QB), (const float*)(ws + WS_ROWSS), (const float*)(ws + WS_ROPE), C2B};
          pg8::gemm_phase<pg8::EpiQb, pg8::StaticOrder, true, true>(lds, g, S, E); }
        { pg8::Gemm g{(const bt*)(ws + WS_LAT) + 1024, (const bt*)(ws + WS_WUKV), M, 4096, 512, 1536, 512, KOFF(512)}; pg8::StaticOrder S; S.init(M, 4096, G, bx);
          pg8::EpiKv E{(bt*)(ws + WS_KVB), (const float*)(ws + WS_ROWSS) + M};
          pg8::gemm_phase<pg8::EpiKv, pg8::StaticOrder, true, true>(lds, g, S, E); }
    } SEAM(2);

    if (IN(3)) { att::attn_phase(P, lds, MISC, ctl, 0); } SEAM(3);

    if (IN(4)) {
        pg8::Gemm g{(const bt*)(ws + WS_OAB), (const bt*)(ws + WS_WPA), M, 4096, 4096, 4096, 4096, 0}; pg8::StaticOrder S; S.init(M, 4096, G, bx);
        pg8::EpiMerge E{(const bt*)(ws + WS_G), (bt*)(ws + WS_MRG)};
        pg8::gemm_phase<pg8::EpiMerge, pg8::StaticOrder, true, true>(lds, g, S, E);
    } SEAM(4);

    if (IN(5)) {
        pg8::Gemm g{(const bt*)(ws + WS_MRG), (const bt*)(ws + WS_WOUT), M, 4096, 4096, 4096, 4096, KOFF(4096)}; pg8::StaticOrder S; S.init(M, 4096, G, bx);
        pg8::EpiRes E{P.x, P.out, ALPHA};
        pg8::gemm_phase<pg8::EpiRes, pg8::StaticOrder, true, true>(lds, g, S, E);
    } SEAM(5);

    if (IN(6)) { ln_phase(P.out, P.ln1_g, P.ln1_b, (bf16*)(ws + WS_H1B), (float*)(ws + WS_ROWSS), gw, NGW, lane); } SEAM(6);

    if (IN(7)) {
        pg8::Gemm g{(const bt*)(ws + WS_H1B), (const bt*)(ws + WS_WUP), M, 22016, 4096, 4096, 4096, KOFF(4096)}; pg8::StaticOrder S; S.init(M, 22016, G, bx);
        pg8::EpiConv E{(bt*)(ws + WS_ACT), (bt*)(ws + WS_SIDE), P.conv_w, P.conv_b, DFF};
        pg8::gemm_phase<pg8::EpiConv, pg8::StaticOrder, true, true>(lds, g, S, E);
    } SEAM(7);

    if (IN(8)) { conv_fix_phase((const bf16*)(ws + WS_SIDE), P.conv_w, P.conv_b, (bf16*)(ws + WS_ACT), gw, NGW, lane); } SEAM(8);

    if (IN(9)) {
        pg8::Gemm g{(const bt*)(ws + WS_ACT), (const bt*)(ws + WS_WDN), M, 4096, DFF, DFF, DFF, KOFF(DFF)}; pg8::StaticOrder S; S.init(M, 4096, G, bx);
        pg8::EpiDown E{P.out, (const float*)(ws + WS_ROWSS), P.ln1_g, P.ln1_b, ALPHA, M};
        pg8::gemm_phase<pg8::EpiDown, pg8::StaticOrder, true, true>(lds, g, S, E);
    } SEAM(9);

    if (IN(10)) { ln_phase(P.out, P.ln2_g, P.ln2_b, nullptr, nullptr, gw, NGW, lane); }
#undef IN
#undef SEAM
#undef SEAM2B
}

extern "C" void kernel_launch(void* const* d_in, const int* in_sizes, int n_in, void* d_out, int out_size, void* d_ws, size_t ws_size, hipStream_t stream) {
    static int grid = 0;
    if (grid == 0) {
        if (n_in != 24 || in_sizes[0] != M * DM || out_size != M * DM || ws_size < WS_END) { fprintf(stderr, "kernel_launch: unexpected shapes (n_in %d, x %d, out %d, ws %zu < %zu)\n", n_in, n_in > 0 ? in_sizes[0] : -1, out_size, ws_size, (size_t)WS_END); grid = -1; return; }
        int dev = 0, cus = 0, per_cu = 0;
        if (hipGetDevice(&dev) != hipSuccess || hipDeviceGetAttribute(&cus, hipDeviceAttributeMultiprocessorCount, dev) != hipSuccess) { grid = -1; return; }
        if (hipFuncSetAttribute((const void*)mk_fwd, hipFuncAttributeMaxDynamicSharedMemorySize, LDS_BYTES) != hipSuccess) { fprintf(stderr, "kernel_launch: hipFuncSetAttribute failed\n"); grid = -1; return; }
        if (hipOccupancyMaxActiveBlocksPerMultiprocessor(&per_cu, (const void*)mk_fwd, NWAVES * 64, LDS_BYTES) != hipSuccess || per_cu < 1) fprintf(stderr, "kernel_launch: occupancy query says %d\n", per_cu);
        (void)hipGetLastError();
        grid = cus < 256 ? cus : 256;
    }
    if (grid < 0) return;
    if (hipMemsetAsync((char*)d_ws + WS_CTL, 0, CTL_ZERO_BYTES, stream) != hipSuccess) return;
    Args a{};
    for (int i = 0; i < 24; ++i) a.in[i] = d_in[i];
    a.out = (float*)d_out; a.ws = (unsigned char*)d_ws;
    constexpr int NL = MK_N_LAUNCHES;
    for (int li = 0; li < NL; ++li) {
        constexpr bool ONE = (MK_N_LAUNCHES == 1);
        a.ph_lo = ONE ? 0 : li; a.ph_hi = ONE ? N_PHASES : li + 1; a.li = ONE ? 0 : li; a.pad = 0;
        hipLaunchKernelGGL(mk_fwd, dim3(grid), dim3(NWAVES * 64), LDS_BYTES, stream, a);
        const hipError_t le = hipPeekAtLastError();
        if (le != hipSuccess) { fprintf(stderr, "kernel_launch: launch %d failed: %s\n", li, hipGetErrorName(le)); break; }
    }
}
```

```cpp
#include <hip/hip_runtime.h>
#include <cstdio>
#include <cstdint>

#ifndef MK_N_LAUNCHES
#define MK_N_LAUNCHES 1
#endif

constexpr int BATCH = 2, SEQ = 8192, DM = 4096, M = BATCH * SEQ;
constexpr int DA_H = 8, ML_H = 16, DFF = 11008;
constexpr int IN_COLS = 15936, N1 = 16128;
constexpr float ALPHA = 1.189207115002721f;
constexpr float LN_EPS = 1e-5f, RMS_EPS = 1e-6f;
constexpr float LOG2E = 1.4426950408889634f;
constexpr float C2A = 0.08838834764831845f * LOG2E;
constexpr float C2B = 0.07216878364870323f * LOG2E;
constexpr float LAMBDA_INIT = 0.2f;

constexpr size_t MiB = 1u << 20;
constexpr size_t WS_CTL = 0, CTL_ZERO_BYTES = 65536;
constexpr size_t WS_ROPE = 1 * MiB;
constexpr size_t WS_ROWSS = 5 * MiB;
constexpr size_t WS_NPART = 6 * MiB;
constexpr size_t WS_WIN = 8 * MiB, WS_WUQ = 134 * MiB, WS_WUKV = 140 * MiB, WS_WPA = 144 * MiB, WS_WPB = 160 * MiB, WS_WOUT = 176 * MiB, WS_WUP = 208 * MiB, WS_WDN = 380 * MiB;
constexpr size_t WS_XB = 466 * MiB;
constexpr size_t WS_OAB = WS_XB, WS_H1B = WS_XB;
constexpr size_t WS_QKV = 594 * MiB;
constexpr size_t WS_QB = 786 * MiB;
constexpr size_t WS_KVB = 882 * MiB;
constexpr size_t WS_LAT = 1042 * MiB;
constexpr size_t WS_G = 1090 * MiB;
constexpr size_t WS_TMP = 594 * MiB;
constexpr size_t WS_MRG = 850 * MiB;
constexpr size_t WS_SIDE = 594 * MiB;
constexpr size_t WS_ACT = 640 * MiB;
constexpr size_t WS_O0 = 8 * MiB;
constexpr size_t WS_YB = 1000 * MiB;
constexpr size_t WS_Y2B = 1136 * MiB;
constexpr size_t WS_END = 1376 * MiB;
constexpr int KVLD = 5120;

constexpr int RING_BYTES = 131072, LDSCTL_OFF = RING_BYTES, MISC_OFF = LDSCTL_OFF + 320, LDS_BYTES = 147456;
constexpr int NWAVES = 8;

#define GAS __attribute__((address_space(1)))
#define LAS __attribute__((address_space(3)))
typedef unsigned short bf16;
typedef unsigned v4u __attribute__((ext_vector_type(4)));
typedef unsigned v2u __attribute__((ext_vector_type(2)));
typedef float f32x4 __attribute__((ext_vector_type(4)));
typedef float f32x2 __attribute__((ext_vector_type(2)));
typedef float f32x16 __attribute__((ext_vector_type(16)));
typedef short bf16x8 __attribute__((ext_vector_type(8)));
typedef short s16x4 __attribute__((ext_vector_type(4)));
typedef GAS unsigned gu32;
#define RLX_AGENT __ATOMIC_RELAXED, __HIP_MEMORY_SCOPE_AGENT
#define LDS_WAIT() asm volatile("s_waitcnt lgkmcnt(0)" ::: "memory")
#define VM_WAIT() asm volatile("s_waitcnt vmcnt(0)" ::: "memory")
typedef __bf16 bf16x2_t __attribute__((ext_vector_type(2)));
__device__ __forceinline__ unsigned cvt_pk(float lo, float hi) { const f32x2 v = {lo, hi}; const bf16x2_t b = __builtin_convertvector(v, bf16x2_t); return __builtin_bit_cast(unsigned, b); }
__device__ __forceinline__ float bf_lo(unsigned w) { return __uint_as_float(w << 16); }
__device__ __forceinline__ float bf_hi(unsigned w) { return __uint_as_float(w & 0xffff0000u); }
__device__ __forceinline__ float wave_sum(float v) {
#pragma unroll
    for (int o = 1; o < 64; o <<= 1) v += __shfl_xor(v, o);
    return v;
}
namespace pg8 {
#define PG8_LAS __attribute__((address_space(3)))
typedef unsigned short bf16_t;
typedef short bf16x8 __attribute__((ext_vector_type(8)));
typedef float f32x4 __attribute__((ext_vector_type(4)));
typedef unsigned u32x4 __attribute__((ext_vector_type(4)));
constexpr int BM = 256, BK = 64, HALF = 128, HTB = HALF * BK * 2  , STAGE_BYTES = 8 * HTB, NXCD = 8, WGM = 8;

__host__ __device__ __forceinline__ int lds_byte(int r, int c) { const int st = (r >> 4) * 2 + (c >> 5), rr = r & 15, cc = c & 31, ob = rr * 64 + cc * 2; return st * 1024 + (ob ^ (((ob >> 9) & 1) << 5)); }
__host__ __device__ __forceinline__ void stage_rc(int b, int& R, int& C) { const int st = b / 1024, sb = b % 1024, swz = sb ^ (((sb >> 9) & 1) << 5); R = (st >> 1) * 16 + swz / 64; C = (st & 1) * 32 + (swz % 64) / 2; }
__host__ __device__ __forceinline__ int perm32(int rho) { const int n = rho >> 4, i = rho & 15; return 8 * (i >> 2) + 4 * n + (i & 3); }

struct Unit { int pm, pn; };
struct Gemm { const bf16_t* A; const bf16_t* Bt; int M, N, K, lda, ldb, koff; };

struct StaticOrder {
    int nM, nN, nwg, G, c;
    __host__ __device__ void init(int M, int N, int G_, int c_) { nM = M / BM; nN = N / BM; nwg = nM * nN; G = G_; c = c_; }
    __host__ __device__ bool next(int i, Unit& u) const {
        const long L = (long)i * G + c; if (L >= nwg) return false;
        int wgid = (int)L; { const int q = nwg / NXCD, r = nwg % NXCD, xcd = wgid % NXCD, off = wgid / NXCD; wgid = (xcd < r ? xcd * (q + 1) : r * (q + 1) + (xcd - r) * q) + off; }
        const int nig = WGM * nN, gid = wgid / nig, fm = gid * WGM, gsz = (nM - fm) < WGM ? (nM - fm) : WGM;
        u.pm = fm + ((wgid % nig) % gsz); u.pn = (wgid % nig) / gsz; return true;
    }
    __device__ __forceinline__ void a_ready(const Unit&) const {}
    __device__ __forceinline__ void done(const Unit&) const {}
};

__device__ __forceinline__ unsigned cvt_pk_bf16(float lo, float hi) { return ::cvt_pk(lo, hi); }
typedef float f32x2 __attribute__((ext_vector_type(2)));
__device__ __forceinline__ u32x4 pack8(f32x4 a, f32x4 b) { u32x4 w; w.x = cvt_pk_bf16(a[0], a[1]); w.y = cvt_pk_bf16(a[2], a[3]); w.z = cvt_pk_bf16(b[0], b[1]); w.w = cvt_pk_bf16(b[2], b[3]); return w; }
__device__ __forceinline__ float bflo(unsigned w) { return __uint_as_float(w << 16); }
__device__ __forceinline__ float bfhi(unsigned w) { return __uint_as_float(w & 0xffff0000u); }
__device__ __forceinline__ float sigmoidf_(float x) { return __builtin_amdgcn_rcpf(1.f + __builtin_amdgcn_exp2f(-1.4426950408889634f * x)); }
__device__ __forceinline__ void rope8(f32x4& v0, f32x4& v1, const float* cs  , int i0) {
    const f32x4 c = *(const f32x4*)(cs + i0), s = *(const f32x4*)(cs + 32 + i0);
    const f32x4 a = v0, b = v1;
    v0[0] = a[0] * c[0] - a[1] * s[0]; v0[1] = a[0] * s[0] + a[1] * c[0];
    v0[2] = a[2] * c[1] - a[3] * s[1]; v0[3] = a[2] * s[1] + a[3] * c[1];
    v1[0] = b[0] * c[2] - b[1] * s[2]; v1[1] = b[0] * s[2] + b[1] * c[2];
    v1[2] = b[2] * c[3] - b[3] * s[3]; v1[3] = b[2] * s[3] + b[3] * c[3];
}
#define PG8_ROWLOOP _Pragma("unroll") for (int ai = 0; ai < 2; ++ai) _Pragma("unroll") for (int m = 0; m < 4; ++m)

struct EpiIn {
    static constexpr bool PERM = true, AFTER_DRAIN = false, MID = false;
    bf16_t* qkv; bf16_t* lat; bf16_t* gate; bf16_t* kvb; float* rowss; const float* bgate; const float* rope; float c2a; int Mrows;
    __device__ __forceinline__ void operator()(const f32x4 (&acc)[2][2][4][2], const Unit& u, int wr, int wc, int fr, int fq) const {
        const int row0 = u.pm * BM + wr * 64 + fr, lc0 = wc * 32 + 8 * fq, pn = u.pn;
        if (pn < 24) {
            const float sc = pn < 8 ? c2a : 1.f;
            PG8_ROWLOOP { bf16_t* rowp = qkv + (size_t)(row0 + ai * HALF + m * 16) * 6144 + pn * 256 + lc0;
#pragma unroll
                for (int bj = 0; bj < 2; ++bj) *(u32x4*)(rowp + bj * HALF) = pack8(acc[ai][bj][m][0] * sc, acc[ai][bj][m][1] * sc); }
        } else if (pn < 30) {
            PG8_ROWLOOP { bf16_t* rowp = lat + (size_t)(row0 + ai * HALF + m * 16) * 1536 + (pn - 24) * 256 + lc0;
#pragma unroll
                for (int bj = 0; bj < 2; ++bj) *(u32x4*)(rowp + bj * HALF) = pack8(acc[ai][bj][m][0], acc[ai][bj][m][1]); }
        } else if (pn < 62) {
            const int gc0 = (pn - 30) * 256 + lc0;
            f32x4 bv[2][2];
#pragma unroll
            for (int bj = 0; bj < 2; ++bj)
#pragma unroll
                for (int n = 0; n < 2; ++n) bv[bj][n] = *(const f32x4*)(bgate + gc0 + bj * HALF + 4 * n);
            PG8_ROWLOOP { bf16_t* rowp = gate + (size_t)(row0 + ai * HALF + m * 16) * 8192 + gc0;
#pragma unroll
                for (int bj = 0; bj < 2; ++bj) { f32x4 a = acc[ai][bj][m][0] + bv[bj][0], b = acc[ai][bj][m][1] + bv[bj][1];
#pragma unroll
                    for (int e = 0; e < 4; ++e) { a[e] = sigmoidf_(a[e]); b[e] = sigmoidf_(b[e]); }
                    *(u32x4*)(rowp + bj * HALF) = pack8(a, b); } }
        } else {
            if (wc < 2) {
                PG8_ROWLOOP { const int row = row0 + ai * HALF + m * 16; f32x4 a = acc[ai][0][m][0], b = acc[ai][0][m][1];
                    rope8(a, b, rope + (size_t)row * 64, lc0 >> 1);
                    const u32x4 w = pack8(a, b); bf16_t* rowp = kvb + (size_t)row * 5120 + 128 + lc0;
#pragma unroll
                    for (int h = 0; h < 16; ++h) *(u32x4*)(rowp + h * 320) = w; }
            }
        }
    }
};
struct EpiQb {
    static constexpr bool PERM = true, AFTER_DRAIN = false, MID = false;
    bf16_t* qb; const float* rowss; const float* rope; float c2b;
    __device__ __forceinline__ void operator()(const f32x4 (&acc)[2][2][4][2], const Unit& u, int wr, int wc, int fr, int fq) const {
        const int row0 = u.pm * BM + wr * 64 + fr, lc0 = wc * 32 + 8 * fq;
        int col[2], i0[2]; bool isr[2];
#pragma unroll
        for (int bj = 0; bj < 2; ++bj) { col[bj] = u.pn * 256 + bj * HALF + lc0; const int h = col[bj] / 192, j = col[bj] - h * 192; isr[bj] = j >= 128; i0[bj] = (j - 128) >> 1; }
        PG8_ROWLOOP { const int row = row0 + ai * HALF + m * 16; const float rs = __builtin_amdgcn_rsqf(rowss[row] * (1.f / 1024.f) + 1e-6f) * c2b;
#pragma unroll
            for (int bj = 0; bj < 2; ++bj) { f32x4 a = acc[ai][bj][m][0] * rs, b = acc[ai][bj][m][1] * rs;
                if (isr[bj]) rope8(a, b, rope + (size_t)row * 64, i0[bj]);
                *(u32x4*)(qb + (size_t)row * 3072 + col[bj]) = pack8(a, b); } }
    }
};
struct EpiKv {
    static constexpr bool PERM = true, AFTER_DRAIN = false, MID = false;
    bf16_t* kvb; const float* rowss;
    __device__ __forceinline__ void operator()(const f32x4 (&acc)[2][2][4][2], const Unit& u, int wr, int wc, int fr, int fq) const {
        const int row0 = u.pm * BM + wr * 64 + fr, lc0 = wc * 32 + 8 * fq;
        PG8_ROWLOOP { const int row = row0 + ai * HALF + m * 16; const float rs = __builtin_amdgcn_rsqf(rowss[row] * (1.f / 512.f) + 1e-6f);
            bf16_t* rowp = kvb + (size_t)row * 5120 + u.pn * 320 + lc0;
            *(u32x4*)(rowp) = pack8(acc[ai][0][m][0] * rs, acc[ai][0][m][1] * rs);
            *(u32x4*)(rowp + 192) = pack8(acc[ai][1][m][0] * rs, acc[ai][1][m][1] * rs); }
    }
};
__device__ __forceinline__ void unpack8(const u32x4 w, f32x4& a, f32x4& b) { a[0] = bflo(w.x); a[1] = bfhi(w.x); a[2] = bflo(w.y); a[3] = bfhi(w.y); b[0] = bflo(w.z); b[1] = bfhi(w.z); b[2] = bflo(w.w); b[3] = bfhi(w.w); }
typedef _Float16 h16x2 __attribute__((ext_vector_type(2)));
__device__ __forceinline__ unsigned cvt_pk_h(float a, float b) { const f32x2 v = {a, b}; return __builtin_bit_cast(unsigned, __builtin_convertvector(v, h16x2)); }
__device__ __forceinline__ u32x4 pack8h(f32x4 a, f32x4 b) { u32x4 w; w.x = cvt_pk_h(a[0], a[1]); w.y = cvt_pk_h(a[2], a[3]); w.z = cvt_pk_h(b[0], b[1]); w.w = cvt_pk_h(b[2], b[3]); return w; }
__device__ __forceinline__ f32x2 h2f(unsigned w) { return __builtin_convertvector(__builtin_bit_cast(h16x2, w), f32x2); }
__device__ __forceinline__ void unpack8h(const u32x4 w, f32x4& a, f32x4& b) { const f32x2 p = h2f(w.x), q = h2f(w.y), r = h2f(w.z), t = h2f(w.w); a[0] = p[0]; a[1] = p[1]; a[2] = q[0]; a[3] = q[1]; b[0] = r[0]; b[1] = r[1]; b[2] = t[0]; b[3] = t[1]; }
struct EpiMerge {
    static constexpr bool PERM = true, AFTER_DRAIN = false, MID = true;
    const bf16_t* gate; bf16_t* mrg;
    __device__ __forceinline__ void mid(f32x4 (&acc)[2][2][4][2], const Unit& u, int wr, int wc, int fr, int fq) const {
        int fro = fr; asm volatile("" : "+v"(fro));
        const int row0 = u.pm * BM + wr * 64 + fro, c0 = u.pn * 256 + wc * 32 + 8 * fq;
        PG8_ROWLOOP { const bf16_t* gp = gate + (size_t)(row0 + ai * HALF + m * 16) * 8192 + c0;
#pragma unroll
            for (int bj = 0; bj < 2; ++bj) { f32x4 a0, a1, b0, b1; unpack8(*(const u32x4*)(gp + bj * HALF), a0, a1); unpack8(*(const u32x4*)(gp + 4096 + bj * HALF), b0, b1);
#pragma unroll
                for (int e = 0; e < 4; ++e) { acc[ai][bj][m][0][e] *= a0[e] * __builtin_amdgcn_rcpf(fmaxf(b0[e], 1e-30f)); acc[ai][bj][m][1][e] *= a1[e] * __builtin_amdgcn_rcpf(fmaxf(b1[e], 1e-30f)); } }
            asm volatile("" : "+v"(acc[ai][0][m][0]), "+v"(acc[ai][0][m][1]), "+v"(acc[ai][1][m][0]), "+v"(acc[ai][1][m][1]) :: "memory"); }
    }
    __device__ __forceinline__ void operator()(const f32x4 (&acc)[2][2][4][2], const Unit& u, int wr, int wc, int fr, int fq) const {
        const int row0 = u.pm * BM + wr * 64 + fr, c0 = u.pn * 256 + wc * 32 + 8 * fq;
        PG8_ROWLOOP { const int row = row0 + ai * HALF + m * 16;
#pragma unroll
            for (int bj = 0; bj < 2; ++bj) { const int c = c0 + bj * HALF; f32x4 b0, b1; unpack8(*(const u32x4*)(gate + (size_t)row * 8192 + 4096 + c), b0, b1);
#pragma unroll
                for (int e = 0; e < 4; ++e) { b0[e] = fmaxf(b0[e], 1e-30f); b1[e] = fmaxf(b1[e], 1e-30f); }
                *(u32x4*)(mrg + (size_t)row * 4096 + c) = pack8(acc[ai][bj][m][0] * b0, acc[ai][bj][m][1] * b1); } }
    }
};
struct EpiRes {
    static constexpr bool PERM = true, AFTER_DRAIN = false, MID = false;
    const float* base; bf16_t* out; float alpha;
    __device__ __forceinline__ void operator()(const f32x4 (&acc)[2][2][4][2], const Unit& u, int wr, int wc, int fr, int fq) const {
        const int row0 = u.pm * BM + wr * 64 + fr, c0 = u.pn * 256 + wc * 32 + 8 * fq;
        PG8_ROWLOOP { const size_t ro = (size_t)(row0 + ai * HALF + m * 16) * 4096;
#pragma unroll
            for (int bj = 0; bj < 2; ++bj) { const size_t off = ro + c0 + bj * HALF; const f32x4 xa = *(const f32x4*)(base + off), xb = *(const f32x4*)(base + off + 4);
                *(u32x4*)(out + off) = pack8h(xa * alpha + acc[ai][bj][m][0], xb * alpha + acc[ai][bj][m][1]); } }
    }
};
struct EpiDown {
    static constexpr bool PERM = true, AFTER_DRAIN = false, MID = false;
    const bf16_t* yb; bf16_t* out; const float* stat; const float* g; const float* b; float alpha; int Mrows;
    __device__ __forceinline__ void operator()(const f32x4 (&acc)[2][2][4][2], const Unit& u, int wr, int wc, int fr, int fq) const {
        const int row0 = u.pm * BM + wr * 64 + fr, c0 = u.pn * 256 + wc * 32 + 8 * fq;
        f32x4 gv[2][2], bv[2][2];
#pragma unroll
        for (int bj = 0; bj < 2; ++bj)
#pragma unroll
            for (int n = 0; n < 2; ++n) { gv[bj][n] = *(const f32x4*)(g + c0 + bj * HALF + 4 * n) * alpha; bv[bj][n] = *(const f32x4*)(b + c0 + bj * HALF + 4 * n) * alpha; }
        PG8_ROWLOOP { const int row = row0 + ai * HALF + m * 16; const size_t ro = (size_t)row * 4096; const float mean = stat[row], rstd = stat[Mrows + row];
#pragma unroll
            for (int bj = 0; bj < 2; ++bj) { const size_t off = ro + c0 + bj * HALF; f32x4 ya, yc; unpack8h(*(const u32x4*)(yb + off), ya, yc);
                *(u32x4*)(out + off) = pack8h((ya - mean) * rstd * gv[bj][0] + bv[bj][0] + acc[ai][bj][m][0], (yc - mean) * rstd * gv[bj][1] + bv[bj][1] + acc[ai][bj][m][1]); } }
    }
};
__device__ __forceinline__ float dpp_prev(float prev_grp, float cur, int k) {
    const int pg = __builtin_bit_cast(int, prev_grp), cu = __builtin_bit_cast(int, cur);
    const int ro = k == 1 ? __builtin_amdgcn_mov_dpp(pg, 0x121, 0xf, 0xf, false) : __builtin_amdgcn_mov_dpp(pg, 0x122, 0xf, 0xf, false);
    const int r = k == 1 ? __builtin_amdgcn_update_dpp(ro, cu, 0x111, 0xf, 0xf, false) : __builtin_amdgcn_update_dpp(ro, cu, 0x112, 0xf, 0xf, false);
    return __builtin_bit_cast(float, r);
}
struct EpiConv {
    static constexpr bool PERM = true, AFTER_DRAIN = false, MID = false;
    bf16_t* act; bf16_t* side; const float* cw; const float* cb; int dff;
    __device__ __forceinline__ void operator()(const f32x4 (&acc)[2][2][4][2], const Unit& u, int wr, int wc, int fr, int fq) const {
        const int ch0 = u.pn * 128 + wc * 32 + 8 * fq;
#pragma unroll
        for (int n = 0; n < 2; ++n) {
            const int ch = ch0 + 4 * n;
            f32x4 wg[3], wv[3];
#pragma unroll
            for (int k = 0; k < 3; ++k) { wg[k] = *(const f32x4*)(cw + (size_t)k * 2 * dff + ch); wv[k] = *(const f32x4*)(cw + (size_t)k * 2 * dff + dff + ch); }
            const f32x4 bg = *(const f32x4*)(cb + ch), bv = *(const f32x4*)(cb + dff + ch);
#pragma unroll
            for (int ai = 0; ai < 2; ++ai) {
                const int rowc = u.pm * BM + ai * HALF + wr * 64;
#pragma unroll
                for (int m = 0; m < 4; ++m) {
                    const f32x4 g0 = acc[ai][0][m][n], v0 = acc[ai][1][m][n];
                    const f32x4 gp = m > 0 ? acc[ai][0][m - 1][n] : (f32x4){0.f, 0.f, 0.f, 0.f}, vp = m > 0 ? acc[ai][1][m - 1][n] : (f32x4){0.f, 0.f, 0.f, 0.f};
                    f32x4 o;
#pragma unroll
                    for (int e = 0; e < 4; ++e) {
                        const float g1 = dpp_prev(gp[e], g0[e], 1), g2 = dpp_prev(gp[e], g0[e], 2), v1 = dpp_prev(vp[e], v0[e], 1), v2 = dpp_prev(vp[e], v0[e], 2);
                        const float cg = bg[e] + wg[0][e] * g2 + wg[1][e] * g1 + wg[2][e] * g0[e];
                        const float cv = bv[e] + wv[0][e] * v2 + wv[1][e] * v1 + wv[2][e] * v0[e];
                        o[e] = cg * sigmoidf_(cg) * cv;
                    }
                    const int row = rowc + m * 16 + fr;
                    typedef unsigned u32x2 __attribute__((ext_vector_type(2)));
                    if (m > 0 || fr >= 2) { u32x2 w; w.x = cvt_pk_bf16(o[0], o[1]); w.y = cvt_pk_bf16(o[2], o[3]); *(u32x2*)(act + (size_t)row * dff + ch) = w; }
                    if ((m == 0 && fr < 2) || (m == 3 && fr >= 14)) {
                        const int j = m == 0 ? fr : fr - 12;
                        bf16_t* sp = side + ((size_t)((rowc >> 6) * 4 + j) * 2) * dff + ch;
                        u32x2 wgt; wgt.x = cvt_pk_bf16(g0[0], g0[1]); wgt.y = cvt_pk_bf16(g0[2], g0[3]); *(u32x2*)sp = wgt;
                        u32x2 wvl; wvl.x = cvt_pk_bf16(v0[0], v0[1]); wvl.y = cvt_pk_bf16(v0[2], v0[3]); *(u32x2*)(sp + dff) = wvl;
                    }
                }
            }
        }
    }
};
template <class Epi, class Sched, bool ALIGN_EPI = false, bool SP2 = false>
__device__ __forceinline__ void gemm_phase(PG8_LAS unsigned char* lds, const Gemm g, const Sched& S, const Epi& E) {
    const int tid = threadIdx.x, wid = __builtin_amdgcn_readfirstlane(tid >> 6), lane = tid & 63, wr = wid >> 2, wc = wid & 3, fr = lane & 15, fq = lane >> 4;
    const int K = g.K, nt = K / BK;
    unsigned voffA[2], voffB[2];
#pragma unroll
    for (int i = 0; i < 2; ++i) { int R, C; stage_rc(tid * 16 + i * 8192, R, C); const int Rb = Epi::PERM ? ((R & ~31) + perm32(R & 31)) : R;
        voffA[i] = (unsigned)(R * g.lda + C) * 2u; voffB[i] = (unsigned)(Rb * g.ldb + C) * 2u; }
    const size_t kstep = (size_t)(BK * 2);
    const int koff = g.koff; const size_t kob = (size_t)koff * kstep;
#define PG8_KP(base, t_) ((base) + (size_t)(((t_) + koff) >= nt ? (t_) + koff - nt : (t_) + koff) * kstep)
    const size_t hstepA = (size_t)HALF * g.lda * 2, hstepB = (size_t)HALF * g.ldb * 2;
    const size_t tstepA = 2 * hstepA, tstepB = 2 * hstepB;
    const unsigned ldsw = (unsigned)wid * 1024u;
    const int aoff = lds_byte(wr * 64 + fr, fq * 8), boff = lds_byte(wc * 32 + fr, fq * 8);
#define PG8_SA(b, h) (((b) * 2 + (h)) * HTB)
#define PG8_SB(b, h) ((4 + (b) * 2 + (h)) * HTB)
#define PG8_STAGE(bufoff, gbase, voff) do { _Pragma("unroll") for (int _i = 0; _i < 2; ++_i) \
        __builtin_amdgcn_global_load_lds((const unsigned*)((const char*)(gbase) + (voff)[_i]), (PG8_LAS unsigned*)(lds + (bufoff) + ldsw + _i * 8192), 16, 0, 0); } while (0)
#define PG8_LDA(dst, b, h) do { _Pragma("unroll") for (int m = 0; m < 4; ++m) _Pragma("unroll") for (int k = 0; k < 2; ++k) dst[m][k] = *(const PG8_LAS bf16x8*)(lds + PG8_SA(b, h) + aoff + m * 2048 + k * 1024); } while (0)
#define PG8_LDB(dst, b, h) do { _Pragma("unroll") for (int n = 0; n < 2; ++n) _Pragma("unroll") for (int k = 0; k < 2; ++k) dst[n][k] = *(const PG8_LAS bf16x8*)(lds + PG8_SB(b, h) + boff + n * 2048 + k * 1024); } while (0)
#define PG8_MMA(ai, bj, At, Bt) do { __builtin_amdgcn_s_setprio(1); _Pragma("unroll") for (int m = 0; m < 4; ++m) _Pragma("unroll") for (int n = 0; n < 2; ++n) _Pragma("unroll") for (int k = 0; k < 2; ++k) \
        acc[ai][bj][m][n] = __builtin_amdgcn_mfma_f32_16x16x32_bf16(Bt[n][k], At[m][k], acc[ai][bj][m][n], 0, 0, 0); __builtin_amdgcn_s_setprio(0); } while (0)
#define PG8_WAIT_V(n) asm volatile("s_waitcnt vmcnt(" #n ")" ::: "memory")
#define PG8_WAIT_L(n) asm volatile("s_waitcnt lgkmcnt(" #n ")" ::: "memory")
#define PG8_BAR __builtin_amdgcn_s_barrier()
#define PG8_SCHED __builtin_amdgcn_sched_barrier(0)
    Unit cur, nxt; int ui = 0;
    if (!S.next(0, cur)) return;
    f32x4 acc[2][2][4][2];
#pragma unroll
    for (int a = 0; a < 2; ++a)
#pragma unroll
        for (int b = 0; b < 2; ++b)
#pragma unroll
            for (int m = 0; m < 4; ++m)
#pragma unroll
                for (int n = 0; n < 2; ++n) acc[a][b][m][n] = (f32x4){0.f, 0.f, 0.f, 0.f};
    bf16x8 At[4][2], B0[2][2], B1[2][2];
    const char* cA = (const char*)g.A + (size_t)cur.pm * tstepA; const char* cB = (const char*)g.Bt + (size_t)cur.pn * tstepB;
    S.a_ready(cur);
    if constexpr (SP2) {
        PG8_STAGE(PG8_SB(0, 0), cB + kob, voffB); PG8_STAGE(PG8_SB(0, 1), cB + kob + hstepB, voffB); PG8_STAGE(PG8_SA(0, 0), cA + kob, voffA); PG8_STAGE(PG8_SA(0, 1), cA + kob + hstepA, voffA);
        if (wr == 1) PG8_BAR;
        PG8_WAIT_V(2); PG8_BAR;
        PG8_STAGE(PG8_SB(1, 0), cB + kob + kstep, voffB); PG8_STAGE(PG8_SA(1, 0), cA + kob + kstep, voffA); PG8_STAGE(PG8_SB(1, 1), cB + kob + hstepB + kstep, voffB);
        PG8_WAIT_V(6); PG8_BAR;
    } else {
        PG8_STAGE(PG8_SB(0, 0), cB + kob, voffB); PG8_STAGE(PG8_SA(0, 0), cA + kob, voffA); PG8_STAGE(PG8_SB(0, 1), cB + kob + hstepB, voffB); PG8_STAGE(PG8_SA(0, 1), cA + kob + hstepA, voffA);
        if (wr == 1) PG8_BAR;
        PG8_WAIT_V(4); PG8_BAR;
        PG8_STAGE(PG8_SB(1, 0), cB + kob + kstep, voffB); PG8_STAGE(PG8_SA(1, 0), cA + kob + kstep, voffA); PG8_STAGE(PG8_SB(1, 1), cB + kob + hstepB + kstep, voffB);
        PG8_WAIT_V(6); PG8_BAR;
    }
    for (;;) {
        const bool has_next = S.next(ui + 1, nxt);
        const char* nA = has_next ? (const char*)g.A + (size_t)nxt.pm * tstepA : cA; const char* nB = has_next ? (const char*)g.Bt + (size_t)nxt.pn * tstepB : cB;
        for (int t = 0; t < nt; t += 2) {
            if constexpr (Epi::MID) { if (t == nt / 2) E.mid(acc, cur, wr, wc, fr, fq); }
            const bool last = (t == nt - 2);
            const char* a1 = PG8_KP(cA, t + 1);
            const char* a2 = last ? nA + kob : PG8_KP(cA, t + 2); const char* b2 = last ? nB + kob : PG8_KP(cB, t + 2);
            const char* a3 = a2 + kstep; const char* b3 = b2 + kstep;
            if (last && has_next) S.a_ready(nxt);
            if constexpr (SP2) {
            PG8_LDB(B0, 0, 0); PG8_LDB(B1, 0, 1); PG8_SCHED; PG8_LDA(At, 0, 0); PG8_STAGE(PG8_SA(1, 1), a1 + hstepA, voffA);
            PG8_WAIT_V(8); PG8_WAIT_L(0); PG8_BAR; PG8_MMA(0, 0, At, B0); PG8_MMA(0, 1, At, B1); PG8_BAR; PG8_SCHED;
            PG8_LDA(At, 0, 1); PG8_STAGE(PG8_SB(0, 0), b2, voffB); PG8_STAGE(PG8_SB(0, 1), b2 + hstepB, voffB); PG8_STAGE(PG8_SA(0, 0), a2, voffA);
            PG8_WAIT_V(8); PG8_WAIT_L(0); PG8_BAR; PG8_MMA(1, 0, At, B0); PG8_MMA(1, 1, At, B1); PG8_BAR; PG8_SCHED;
            PG8_LDB(B0, 1, 0); PG8_LDB(B1, 1, 1); PG8_SCHED; PG8_LDA(At, 1, 0); PG8_STAGE(PG8_SA(0, 1), a2 + hstepA, voffA);
            PG8_WAIT_V(8); PG8_WAIT_L(0); PG8_BAR; PG8_MMA(0, 0, At, B0); PG8_MMA(0, 1, At, B1); PG8_BAR; PG8_SCHED;
            PG8_LDA(At, 1, 1); PG8_STAGE(PG8_SB(1, 0), b3, voffB); PG8_STAGE(PG8_SB(1, 1), b3 + hstepB, voffB); PG8_STAGE(PG8_SA(1, 0), a3, voffA);
            PG8_WAIT_V(8); PG8_WAIT_L(0); PG8_BAR; PG8_MMA(1, 0, At, B0); PG8_MMA(1, 1, At, B1); PG8_BAR; PG8_SCHED;
            } else {
            PG8_LDB(B0, 0, 0); PG8_SCHED; PG8_LDA(At, 0, 0); PG8_STAGE(PG8_SA(1, 1), a1 + hstepA, voffA);
            PG8_WAIT_L(8); PG8_BAR; PG8_WAIT_L(0); PG8_MMA(0, 0, At, B0); PG8_BAR; PG8_SCHED;
            PG8_LDB(B1, 0, 1); PG8_STAGE(PG8_SB(0, 0), b2, voffB);
            PG8_BAR; PG8_WAIT_L(0); PG8_MMA(0, 1, At, B1); PG8_BAR;
            PG8_LDA(At, 0, 1); PG8_STAGE(PG8_SA(0, 0), a2, voffA);
            PG8_BAR; PG8_WAIT_L(0); PG8_MMA(1, 0, At, B0); PG8_BAR; PG8_SCHED;
            PG8_STAGE(PG8_SB(0, 1), b2 + hstepB, voffB);
            PG8_WAIT_V(6); PG8_BAR; PG8_MMA(1, 1, At, B1); PG8_BAR;
            PG8_LDB(B0, 1, 0); PG8_SCHED; PG8_LDA(At, 1, 0); PG8_STAGE(PG8_SA(0, 1), a2 + hstepA, voffA);
            PG8_WAIT_L(8); PG8_BAR; PG8_WAIT_L(0); PG8_MMA(0, 0, At, B0); PG8_BAR; PG8_SCHED;
            PG8_LDB(B1, 1, 1); PG8_STAGE(PG8_SB(1, 0), b3, voffB);
            PG8_BAR; PG8_WAIT_L(0); PG8_MMA(0, 1, At, B1); PG8_BAR;
            PG8_LDA(At, 1, 1); PG8_STAGE(PG8_SA(1, 0), a3, voffA);
            PG8_BAR; PG8_WAIT_L(0); PG8_MMA(1, 0, At, B0); PG8_BAR; PG8_SCHED;
            PG8_STAGE(PG8_SB(1, 1), b3 + hstepB, voffB);
            PG8_WAIT_V(6); PG8_BAR; PG8_MMA(1, 1, At, B1); PG8_BAR;
            }
        }
        if constexpr (ALIGN_EPI) { if (wr == 0) PG8_BAR; }
        if constexpr (!Epi::AFTER_DRAIN) { E(acc, cur, wr, wc, fr, fq); S.done(cur); }
        if (!has_next) break;
#pragma unroll
        for (int a = 0; a < 2; ++a)
#pragma unroll
            for (int b = 0; b < 2; ++b)
#pragma unroll
                for (int m = 0; m < 4; ++m)
#pragma unroll
                    for (int n = 0; n < 2; ++n) acc[a][b][m][n] = (f32x4){0.f, 0.f, 0.f, 0.f};
        cur = nxt; cA = nA; cB = nB; ++ui;
        if constexpr (ALIGN_EPI) { if (wr == 1) PG8_BAR; }
    }
    PG8_WAIT_V(0);
    if constexpr (!ALIGN_EPI) { if (wr == 0) PG8_BAR; }
    PG8_BAR;
    if constexpr (Epi::AFTER_DRAIN) { E.fused(acc, cur, wr, wc, fr, fq, lds, wid, lane); S.done(cur); }
#undef PG8_KP
#undef PG8_SA
#undef PG8_SB
#undef PG8_STAGE
#undef PG8_LDA
#undef PG8_LDB
#undef PG8_MMA
#undef PG8_WAIT_V
#undef PG8_WAIT_L
#undef PG8_BAR
#undef PG8_SCHED
}
}
#define XB_TMO      128
#define XB_XCNT(j)  (256  + 64 * (j))
#define XB_XSUB(j)  (1280 + 64 * (j))
#define XB_XGEN(j)  (2304 + 64 * (j))
#define XB_TOP      3328
#define XB_TOPGEN   3392
#define XCD_BAR_WORDS 3456
#define XB_SPIN_CAP (1u << 18)

__device__ __forceinline__ unsigned xb_ld(unsigned* p)              { return __hip_atomic_load(p, __ATOMIC_RELAXED, __HIP_MEMORY_SCOPE_AGENT); }
__device__ __forceinline__ unsigned xb_add(unsigned* p, unsigned v) { return __hip_atomic_fetch_add(p, v, __ATOMIC_RELAXED, __HIP_MEMORY_SCOPE_AGENT); }
__device__ __forceinline__ unsigned xb_xcc_id() { return (unsigned)__builtin_amdgcn_s_getreg((3 << 11) | 20) & 0xFu; }
#define XB_SPIN(cond, bar) do { unsigned _sp = 0; while (cond) { __builtin_amdgcn_s_sleep(1); \
    if ((++_sp & 255u) == 0u) { if (xb_ld(&(bar)[XB_TMO])) break; if (_sp > XB_SPIN_CAP) { atomicAdd(&(bar)[XB_TMO], 1u); break; } } } } while (0)

struct XcdBarrier {
    unsigned* bar; unsigned x;
    volatile LAS unsigned* st;
};

__device__ __forceinline__ XcdBarrier xcd_barrier_post(unsigned* bar, volatile LAS unsigned* st) {
    XcdBarrier b; b.bar = bar; b.x = xb_xcc_id(); b.st = st;
    if (threadIdx.x == 0) (void)xb_add(&bar[XB_XCNT(b.x)], 1u);
    return b;
}
__device__ __forceinline__ void xcd_barrier_complete(unsigned* bar, unsigned x, unsigned& nloc, unsigned& nx) {
    const unsigned G = gridDim.x * gridDim.y * gridDim.z;
    unsigned sum, cnt, mine, sp = 0u;
    for (;;) {
        sum = 0u; cnt = 0u; mine = 0u;
#pragma unroll
        for (unsigned j = 0; j < 16; ++j) { const unsigned c = xb_ld(&bar[XB_XCNT(j)]); sum += c; cnt += (c > 0u) ? 1u : 0u; mine = (j == x) ? c : mine; }
        if (sum == G) break;
        __builtin_amdgcn_s_sleep(1);
        if ((++sp & 255u) == 0u) { if (xb_ld(&bar[XB_TMO])) break; if (sp > XB_SPIN_CAP) { atomicAdd(&bar[XB_TMO], 1u); break; } }
    }
    nloc = mine > 0u ? mine : 1u; nx = cnt > 0u ? cnt : 1u;
}

__device__ __forceinline__ void xcd_barrier(const XcdBarrier& b) {
    asm volatile("s_waitcnt vmcnt(0)" ::: "memory");
    __syncthreads();
    if (threadIdx.x == 0) {
        unsigned* bar = b.bar;
        __builtin_amdgcn_s_waitcnt(0);
        unsigned nloc = b.st[0], nx = b.st[1];
        if (nloc == 0u) { xcd_barrier_complete(bar, b.x, nloc, nx); b.st[0] = nloc; b.st[1] = nx; }
        const unsigned old = xb_add(&bar[XB_XSUB(b.x)], 1u);
        const unsigned gen = old / nloc;
        if (old + 1u == (gen + 1u) * nloc) {
            __builtin_amdgcn_fence(__ATOMIC_RELEASE, "agent");
            asm volatile("s_waitcnt vmcnt(0)" ::: "memory");
            const unsigned og = xb_add(&bar[XB_TOP], 1u);
            const unsigned tg = og / nx;
            if (og + 1u == (tg + 1u) * nx) xb_add(&bar[XB_TOPGEN], 1u);
            else XB_SPIN(xb_ld(&bar[XB_TOPGEN]) == tg, bar);
            __builtin_amdgcn_fence(__ATOMIC_ACQUIRE, "agent");
            xb_add(&bar[XB_XGEN(b.x)], 1u);
            asm volatile("s_waitcnt vmcnt(0)" ::: "memory");
        } else {
            XB_SPIN(xb_ld(&bar[XB_XGEN(b.x)]) == gen, bar);
            __builtin_amdgcn_fence(__ATOMIC_ACQUIRE, "agent");
            asm volatile("s_waitcnt vmcnt(0)" ::: "memory");
        }
    }
    __syncthreads();
}
template <int MODE> __device__ __forceinline__ int dest_row(int n) {
    if (MODE == 1) { if (n < 7680) return n; if (n < 7744) { const int i = n - 7680; return 15872 + (i < 32 ? 2 * i : 2 * (i - 32) + 1); } return n - 64; }
    if (MODE == 2) { const int h = n / 192, j = n - h * 192; if (j < 128) return n; const int i = j - 128; return h * 192 + 128 + (i < 32 ? 2 * i : 2 * (i - 32) + 1); }
    if (MODE == 3) { const int isv = n >= DFF ? 1 : 0, ch = n - isv * DFF; return (ch >> 7) * 256 + isv * 128 + (ch & 127); }
    return n;
}
template <int MODE>
__device__ __forceinline__ void tr_item(const float* W, int K, int N, const float* gk, bf16* WT, LAS unsigned* scr, int kb, int nb, int lane, int ldk = 0, int kofs = 0) {
    const int k0 = kb * 64, n0 = nb * 64;
    const float* src = W + (size_t)k0 * N + n0 + lane;
#pragma unroll
    for (int i = 0; i < 32; ++i) {
        float a = src[(size_t)(2 * i) * N], b = src[(size_t)(2 * i + 1) * N];
        if (gk) { a *= gk[k0 + 2 * i]; b *= gk[k0 + 2 * i + 1]; }
        scr[i * 65 + lane] = cvt_pk(a, b);
    }
    LDS_WAIT(); asm volatile("" ::: "memory");
    const int c = lane & 7;
#pragma unroll
    for (int j = 0; j < 8; ++j) { const int n = (lane >> 3) + 8 * j; const LAS unsigned* s = scr + (4 * c) * 65 + n;
        v4u o; o.x = s[0]; o.y = s[65]; o.z = s[130]; o.w = s[195];
        *(GAS v4u*)(WT + (size_t)dest_row<MODE>(n0 + n) * (ldk ? ldk : K) + kofs + k0 + 8 * c) = o; }
    LDS_WAIT(); asm volatile("" ::: "memory");
}

struct Ptrs {
    const float* x; const int* pos; const float* w_in; const float* b_gate; const float *lq1, *lk1, *lq2, *lk2; const float* subln_g; const float *qn_g, *kvn_g;
    const float *w_uq, *w_ukv, *w_pa, *w_pb, *w_out, *ln1_g, *ln1_b, *w_up, *conv_w, *conv_b, *w_down, *ln2_g, *ln2_b;
    float* out; unsigned char* ws;
};

__device__ __forceinline__ void p0_prologue(const Ptrs& P, LAS unsigned char* lds, int vcu, int G, int wave, int lane) {
    LAS unsigned* scr = (LAS unsigned*)(lds + wave * 8448);
    const int gw = vcu * NWAVES + wave, NGW = G * NWAVES;
    unsigned char* ws = P.ws;
    constexpr int I_IN = (IN_COLS / 64) * (DM / 64), I_UQ = (3072 / 64) * (1024 / 64), I_UKV = (4096 / 64) * (512 / 64), I_PA = (4096 / 64) * (2048 / 64), I_OUT = (4096 / 64) * (4096 / 64),
                  I_UP = (22016 / 64) * (4096 / 64), I_DN = (4096 / 64) * (DFF / 64);
    constexpr int NITEMS = I_IN + I_UQ + I_UKV + 2 * I_PA + I_OUT + I_UP + I_DN;
    for (int it = gw; it < NITEMS; it += NGW) {
        int r = it;
        if (r < I_IN)  { tr_item<1>(P.w_in, DM, IN_COLS, nullptr, (bf16*)(ws + WS_WIN), scr, r % (DM / 64), r / (DM / 64), lane); continue; } r -= I_IN;
        if (r < I_UQ)  { tr_item<2>(P.w_uq, 1024, 3072, P.qn_g, (bf16*)(ws + WS_WUQ), scr, r % 16, r / 16, lane); continue; } r -= I_UQ;
        if (r < I_UKV) { tr_item<0>(P.w_ukv, 512, 4096, P.kvn_g, (bf16*)(ws + WS_WUKV), scr, r % 8, r / 8, lane); continue; } r -= I_UKV;
        if (r < I_PA)  { tr_item<0>(P.w_pa, 2048, 4096, nullptr, (bf16*)(ws + WS_WPA), scr, r % 32, r / 32, lane, 4096, 0); continue; } r -= I_PA;
        if (r < I_PA)  { tr_item<0>(P.w_pb, 2048, 4096, nullptr, (bf16*)(ws + WS_WPA), scr, r % 32, r / 32, lane, 4096, 2048); continue; } r -= I_PA;
        if (r < I_OUT) { tr_item<0>(P.w_out, 4096, 4096, nullptr, (bf16*)(ws + WS_WOUT), scr, r % 64, r / 64, lane); continue; } r -= I_OUT;
        if (r < I_UP)  { tr_item<3>(P.w_up, 4096, 22016, nullptr, (bf16*)(ws + WS_WUP), scr, r % 64, r / 64, lane); continue; } r -= I_UP;
        tr_item<0>(P.w_down, DFF, 4096, nullptr, (bf16*)(ws + WS_WDN), scr, r % (DFF / 64), r / (DFF / 64), lane);
    }
    { const size_t n8 = (size_t)M * DM / 8; GAS v4u* xb = (GAS v4u*)(ws + WS_XB);
      for (size_t i = (size_t)gw * 64 + lane; i < n8; i += (size_t)NGW * 64) { const f32x4 a = *(const GAS f32x4*)(P.x + i * 8), b = *(const GAS f32x4*)(P.x + i * 8 + 4);
          v4u o; o.x = cvt_pk(a[0], a[1]); o.y = cvt_pk(a[2], a[3]); o.z = cvt_pk(b[0], b[1]); o.w = cvt_pk(b[2], b[3]); xb[i] = o; } }
    { GAS v4u* z = (GAS v4u*)(ws + WS_WIN + (size_t)IN_COLS * DM * 2); const size_t nz = (size_t)(N1 - IN_COLS) * DM * 2 / 16;
      for (size_t i = (size_t)gw * 64 + lane; i < nz; i += (size_t)NGW * 64) z[i] = (v4u){0u, 0u, 0u, 0u};
    }
    { GAS float* rt = (GAS float*)(ws + WS_ROPE);
      for (int i = gw * 64 + lane; i < M * 32; i += NGW * 64) { const int m = i >> 5, k = i & 31;
          const double inv = exp2(-(double)k * (13.287712379549449 / 32.0));
          const double rev = (double)P.pos[m] * inv * 0.15915494309189535;
          const float fr = (float)(rev - rint(rev));
          rt[(size_t)m * 64 + k] = __builtin_amdgcn_cosf(fr); rt[(size_t)m * 64 + 32 + k] = __builtin_amdgcn_sinf(fr); } }
}

namespace att {
__device__ __forceinline__ void glds16(const void* sbase, unsigned voff, unsigned lds_dst) {
    unsigned keep;
    asm volatile("s_mov_b32 %0, m0\n\ts_mov_b32 m0, %3\n\ts_nop 0\n\tglobal_load_lds_dwordx4 %1, %2\n\ts_mov_b32 m0, %0" : "=&s"(keep) : "v"(voff), "s"(sbase), "s"(lds_dst) : "memory");
}
__device__ __forceinline__ int v_rd_base(int lane) { return ((lane & 3) << 3) | (((lane >> 2) & 3) << 6) | (((lane >> 4) & 1) << 5) | (((lane >> 5) & 1) << 8); }
#define ATT_BAR() asm volatile("s_barrier" ::: "memory")

template <int DQK, int DV, bool ALIBI>
__device__ __forceinline__ void attn_block(LAS unsigned char* lds, const unsigned char* wsb, const bf16* Q, int ldq, unsigned kofs, unsigned ldkB, unsigned vofs, unsigned ldvB,
                                           int qb, float slope2, f32x16 (&o)[DV / 32], float& l_out) {
    constexpr int NQF = DQK / 16, NOD = DV / 32, KROW = DQK * 2, KT = 64 * KROW, VT = 64 * DV * 2, KCH = DQK / 8, NKI = KT / 8192, NVI = VT / 8192;
    const int tid = threadIdx.x, wid = __builtin_amdgcn_readfirstlane(tid >> 6), lane = tid & 63, r32 = lane & 31, hi = lane >> 5;
    const unsigned ldsb = (unsigned)(uintptr_t)lds;
    __builtin_assume(qb >= 0); __builtin_assume(qb < 32);
    const int NT = 4 * (qb + 1);
    constexpr bool KEEP = (DV == 128);
#define KSW(cs_, row_) (DQK == 128 ? ((cs_) ^ ((row_) & 15)) : (((cs_) & ~7) | (((cs_) ^ ((row_) >> 1)) & 7)))
    unsigned krel[NKI], vrel[NVI];
    if (KEEP) {
#pragma unroll
        for (int j = 0; j < NKI; ++j) { const int p = (j * 8 + wid) * 64 + lane, row = p / KCH, cs = p - row * KCH, c = KSW(cs, row); krel[j] = kofs + (unsigned)row * ldkB + (unsigned)c * 16u; }
#pragma unroll
        for (int j = 0; j < NVI; ++j) { const int p = (j * 8 + wid) * 64 + lane, s = p >> 5, rr = (p & 31) >> 2, cc = p & 3, kg = s / NOD, d0 = s - kg * NOD, kk = kg * 8 + rr;
            const int key = (kk & ~0xC) | ((kk & 4) << 1) | ((kk & 8) >> 1); vrel[j] = vofs + (unsigned)key * ldvB + (unsigned)(d0 * 32 + cc * 8) * 2u; }
    }
#define ATT_ISSUE(t_, bf_) do { if (KEEP) { const unsigned kb_ = (unsigned)(t_) * 64u; \
        _Pragma("unroll") for (int j = 0; j < NKI; ++j) glds16(wsb, krel[j] + kb_ * ldkB, (unsigned)__builtin_amdgcn_readfirstlane(ldsb + (bf_) * KT + (j * 8 + wid) * 1024)); \
        _Pragma("unroll") for (int j = 0; j < NVI; ++j) glds16(wsb, vrel[j] + kb_ * ldvB, (unsigned)__builtin_amdgcn_readfirstlane(ldsb + 2 * KT + (bf_) * VT + (j * 8 + wid) * 1024)); } else ATT_ISSUE_RC(t_, bf_); } while (0)
#define ATT_ISSUE_RC(t_, bf_) do { const unsigned kb_ = (unsigned)(t_) * 64u; int ln_ = lane; asm volatile("" : "+v"(ln_)); \
        _Pragma("unroll") for (int j = 0; j < NKI; ++j) { const int p = (j * 8 + wid) * 64 + ln_, row = p / KCH, cs = p - row * KCH, c = KSW(cs, row); \
            glds16(wsb, kofs + ((unsigned)row + kb_) * ldkB + (unsigned)c * 16u, (unsigned)__builtin_amdgcn_readfirstlane(ldsb + (bf_) * KT + (j * 8 + wid) * 1024)); } \
        _Pragma("unroll") for (int j = 0; j < NVI; ++j) { const int p = (j * 8 + wid) * 64 + ln_, s = p >> 5, rr = (p & 31) >> 2, cc = p & 3, kg = s / NOD, d0 = s - kg * NOD, kk = kg * 8 + rr; \
            const int key = (kk & ~0xC) | ((kk & 4) << 1) | ((kk & 8) >> 1); \
            glds16(wsb, vofs + ((unsigned)key + kb_) * ldvB + (unsigned)(d0 * 32 + cc * 8) * 2u, (unsigned)__builtin_amdgcn_readfirstlane(ldsb + 2 * KT + (bf_) * VT + (j * 8 + wid) * 1024)); } } while (0)
    ATT_BAR();
    ATT_ISSUE(NT - 1, 0);
    bf16x8 qr[NQF];
#pragma unroll
    for (int d0 = 0; d0 < NQF; ++d0) qr[d0] = *(const bf16x8*)(Q + (size_t)(wid * 32 + r32) * ldq + d0 * 16 + hi * 8);
    float m_reg = -1e30f, l_reg = 0.f;
#pragma unroll
    for (int d0 = 0; d0 < NOD; ++d0)
#pragma unroll
        for (int r = 0; r < 16; ++r) o[d0][r] = 0.f;
    const int qi = qb * 256 + wid * 32 + r32;
    for (int i = 0; i < NT; ++i) {
        const int t = NT - 1 - i, bf = i & 1;
        asm volatile("s_waitcnt vmcnt(0)\n\ts_barrier" ::: "memory");
        if (i + 1 < NT) ATT_ISSUE(t - 1, bf ^ 1);
        const int jb = t - 4 * qb;
        if (jb > (wid >> 1)) continue;
        f32x16 p0, p1;
        if (ALIBI) {
            float s2o = slope2; asm volatile("" : "+v"(s2o));
            const float h4 = s2o * (float)(4 * hi);
#pragma unroll
            for (int r = 0; r < 16; ++r) { const float cr = (float)((r & 3) + 8 * (r >> 2)); p0[r] = __builtin_fmaf(s2o, cr, h4); p1[r] = __builtin_fmaf(s2o, cr + 32.f, h4); }
        } else {
#pragma unroll
            for (int r = 0; r < 16; ++r) { p0[r] = 0.f; p1[r] = 0.f; }
        }
        { const LAS unsigned char* kt = lds + bf * KT + r32 * KROW;
          const LAS unsigned char* kb4[4];
          const int key = DQK == 128 ? r32 : (r32 >> 1), hb = DQK == 128 ? ((r32 >> 3) & 1) : 0;
#pragma unroll
          for (int dd = 0; dd < 4; ++dd) kb4[dd] = kt + ((((dd * 2 + hi) ^ key) & 7) << 4) + hb * 128;
#pragma unroll
          for (int d0 = 0; d0 < NQF; ++d0) { const LAS unsigned char* a = DQK == 128 ? kb4[d0 & 3] + ((d0 >> 2) ? 128 - 256 * hb : 0) : kb4[d0 & 3] + (d0 >> 2) * 128;
              const bf16x8 b0 = *(const LAS bf16x8*)a, b1 = *(const LAS bf16x8*)(a + 32 * KROW);
              p0 = __builtin_amdgcn_mfma_f32_32x32x16_bf16(b0, qr[d0], p0, 0, 0, 0);
              p1 = __builtin_amdgcn_mfma_f32_32x32x16_bf16(b1, qr[d0], p1, 0, 0, 0); } }
        __builtin_amdgcn_sched_barrier(0);
        const int kb = t * 64;
        float bq = 0.f;
        if (ALIBI) bq = slope2 * (float)(kb - qi);
        if (jb == (wid >> 1)) { const int dq = qi - kb - 4 * hi; const float NEG = -__builtin_inff();
#pragma unroll
            for (int r = 0; r < 16; ++r) { const int c = (r & 3) + 8 * (r >> 2); if (c > dq) p0[r] = NEG; if (c + 32 > dq) p1[r] = NEG; } }
        float pmax = p0[0];
#pragma unroll
        for (int r = 1; r < 16; ++r) pmax = fmaxf(pmax, p0[r]);
#pragma unroll
        for (int r = 0; r < 16; ++r) pmax = fmaxf(pmax, p1[r]);
        { auto rr = __builtin_amdgcn_permlane32_swap(__float_as_uint(pmax), __float_as_uint(pmax), false, false); pmax = fmaxf(__uint_as_float(rr[0]), __uint_as_float(rr[1])); }
        const float mx = pmax + bq;
        float alpha = 1.f;
        if (!__all(mx - m_reg <= 8.f)) { const float mn = fmaxf(m_reg, mx); alpha = __builtin_amdgcn_exp2f(m_reg - mn); m_reg = mn;
#pragma unroll
            for (int d0 = 0; d0 < NOD; ++d0)
#pragma unroll
                for (int r = 0; r < 16; ++r) o[d0][r] *= alpha; }
        const float ms = m_reg - bq;
        float ps = 0.f;
#pragma unroll
        for (int r = 0; r < 16; ++r) { p0[r] = __builtin_amdgcn_exp2f(p0[r] - ms); ps += p0[r]; }
#pragma unroll
        for (int r = 0; r < 16; ++r) { p1[r] = __builtin_amdgcn_exp2f(p1[r] - ms); ps += p1[r]; }
        { auto rr = __builtin_amdgcn_permlane32_swap(__float_as_uint(ps), __float_as_uint(ps), false, false); ps = __uint_as_float(rr[0]) + __uint_as_float(rr[1]); }
        l_reg = l_reg * alpha + ps;
        bf16x8 pa0, pa1, pa2, pa3;
#define ATT_PK4(P, B_, OUT) do { const unsigned a0 = cvt_pk(P[B_ + 0], P[B_ + 1]), a1 = cvt_pk(P[B_ + 2], P[B_ + 3]), b0 = cvt_pk(P[B_ + 4], P[B_ + 5]), b1 = cvt_pk(P[B_ + 6], P[B_ + 7]); \
        auto r0 = __builtin_amdgcn_permlane32_swap(a0, b0, false, false); auto r1 = __builtin_amdgcn_permlane32_swap(a1, b1, false, false); \
        v4u w = {r0[0], r1[0], r0[1], r1[1]}; OUT = __builtin_bit_cast(bf16x8, w); } while (0)
        ATT_PK4(p0, 0, pa0); ATT_PK4(p0, 8, pa1); ATT_PK4(p1, 0, pa2); ATT_PK4(p1, 8, pa3);
#undef ATT_PK4
        __builtin_amdgcn_sched_barrier(0);
        { const unsigned vb0 = ldsb + 2 * KT + bf * VT + v_rd_base(lane);
#define ATT_TRRD(dst, off) asm volatile("ds_read_b64_tr_b16 %0, %1 offset:%2" : "=&v"(dst) : "v"(vb0), "i"(off) : "memory")
#pragma unroll
          for (int d0 = 0; d0 < NOD; ++d0) { s16x4 l0, l1, l2, l3, h0, h1, h2, h3;
              ATT_TRRD(l0, (0 * NOD + d0) * 512); ATT_TRRD(h0, (1 * NOD + d0) * 512); ATT_TRRD(l1, (2 * NOD + d0) * 512); ATT_TRRD(h1, (3 * NOD + d0) * 512);
              ATT_TRRD(l2, (4 * NOD + d0) * 512); ATT_TRRD(h2, (5 * NOD + d0) * 512); ATT_TRRD(l3, (6 * NOD + d0) * 512); ATT_TRRD(h3, (7 * NOD + d0) * 512);
              asm volatile("s_waitcnt lgkmcnt(0)" ::: "memory"); __builtin_amdgcn_sched_barrier(0);
              o[d0] = __builtin_amdgcn_mfma_f32_32x32x16_bf16((bf16x8){l0[0], l0[1], l0[2], l0[3], h0[0], h0[1], h0[2], h0[3]}, pa0, o[d0], 0, 0, 0);
              o[d0] = __builtin_amdgcn_mfma_f32_32x32x16_bf16((bf16x8){l1[0], l1[1], l1[2], l1[3], h1[0], h1[1], h1[2], h1[3]}, pa1, o[d0], 0, 0, 0);
              o[d0] = __builtin_amdgcn_mfma_f32_32x32x16_bf16((bf16x8){l2[0], l2[1], l2[2], l2[3], h2[0], h2[1], h2[2], h2[3]}, pa2, o[d0], 0, 0, 0);
              o[d0] = __builtin_amdgcn_mfma_f32_32x32x16_bf16((bf16x8){l3[0], l3[1], l3[2], l3[3], h3[0], h3[1], h3[2], h3[3]}, pa3, o[d0], 0, 0, 0); }
#undef ATT_TRRD
        }
    }
#undef ATT_ISSUE
#undef ATT_ISSUE_RC
#undef KSW
    l_out = l_reg;
}

constexpr int CW_ATTQ = 8192, CW_NMAX = 12288;
__device__ __forceinline__ void attn_phase(const Ptrs& P, LAS unsigned char* lds, volatile LAS unsigned* MISC, gu32* ctl, int qoff) {
    const int tid = threadIdx.x, wid = __builtin_amdgcn_readfirstlane(tid >> 6), lane = tid & 63, r32 = lane & 31, hi = lane >> 5;
    unsigned char* ws = P.ws;
    const bf16* QKV = (const bf16*)(ws + WS_QKV); const bf16* QB = (const bf16*)(ws + WS_QB); bf16* OAB = (bf16*)(ws + WS_OAB);
    float lam;
    { const float s1 = wave_sum(P.lq1[lane] * P.lk1[lane] + P.lq1[lane + 64] * P.lk1[lane + 64]), s2 = wave_sum(P.lq2[lane] * P.lk2[lane] + P.lq2[lane + 64] * P.lk2[lane + 64]);
      lam = expf(s1) - expf(s2) + LAMBDA_INIT; }
    const int q0 = (int)(xb_xcc_id() & 7u);
    if (tid < 64) MISC[64 + tid] = 0u;
    __syncthreads();
    { const int w = tid & 63; unsigned mx = 0u; const GAS unsigned* part = (const GAS unsigned*)(ws + WS_NPART);
      for (int g = tid >> 6; g < (int)gridDim.x; g += 8) { const unsigned v = part[g * 64 + w]; mx = v > mx ? v : mx; }
      __hip_atomic_fetch_max((LAS unsigned*)(MISC + 64 + w), mx, __ATOMIC_RELAXED, __HIP_MEMORY_SCOPE_WORKGROUP); }
    __syncthreads();
    if (tid < 32) { const int b = tid >> 4, h = (tid >> 1) & 7, map = tid & 1;
        const float nq = __uint_as_float(MISC[64 + (b * 16 + h * 2 + map) * 2]), nk = __uint_as_float(MISC[64 + (b * 16 + h * 2 + map) * 2 + 1]);
        const float slope2 = LOG2E * exp2f(-(float)(h + 1));
        const float B = sqrtf(nq * nk) * 1.001f + 0.01f, Wf = (2.f * B + 126.f) / slope2;
        const float wq = ceilf(Wf * (1.0001f / 256.f) + 0.001f);
        MISC[32 + tid] = wq < 1000.f ? (unsigned)wq : 1000u; }
    __syncthreads();
    for (int dq = 0; dq < 8; ++dq) {
        const int q = (q0 + dq) & 7, b = q >> 2, qx = q & 3;
        for (;;) {
            if (tid == 0) MISC[16] = __hip_atomic_fetch_add((unsigned*)(ctl + CW_ATTQ + qoff + 64 * q), 1u, __ATOMIC_RELAXED, __HIP_MEMORY_SCOPE_AGENT);
            __syncthreads();
            const int n = (int)__builtin_amdgcn_readfirstlane(MISC[16]);
            __syncthreads();
            if (n >= 64) break;
            const int h = (n < 32) ? 7 - qx : qx, qb = 31 - (n & 31);
            const float slope2 = LOG2E * exp2f(-(float)(h + 1));
            unsigned char* scrb = ws + WS_O0 + (size_t)blockIdx.x * 262144 + (size_t)wid * 32768;
            const size_t rowq = (size_t)b * SEQ + (size_t)qb * 256;
#pragma unroll 1
            for (int map = 0; map < 2; ++map) {
                int qs = qb - (int)MISC[32 + (b * 8 + h) * 2 + map]; qs = __builtin_amdgcn_readfirstlane(qs > 0 ? qs : 0);
                f32x16 o[8]; float l;
                attn_block<128, 256, true>(lds, ws, QKV + rowq * 6144 + h * 256 + map * 128, 6144,
                                           (unsigned)(WS_QKV + (((size_t)b * SEQ + (size_t)qs * 256) * 6144 + 2048 + h * 256 + map * 128) * 2), 12288u,
                                           (unsigned)(WS_QKV + (((size_t)b * SEQ + (size_t)qs * 256) * 6144 + 4096 + h * 256) * 2), 12288u, qb - qs, slope2, o, l);
                const float inv = 1.f / l;
                unsigned so = (unsigned)lane * 16u; asm volatile("" : "+v"(so));
                f32x4* scr = (f32x4*)(scrb + so);
                if (map == 0) {
#pragma unroll
                    for (int d0 = 0; d0 < 8; ++d0)
#pragma unroll
                        for (int g = 0; g < 4; ++g) scr[(d0 * 4 + g) * 64] = (f32x4){o[d0][4 * g] * inv, o[d0][4 * g + 1] * inv, o[d0][4 * g + 2] * inv, o[d0][4 * g + 3] * inv};
                } else {
                    const float li = lam * inv; float ss = 0.f;
#pragma unroll
                    for (int d0 = 0; d0 < 8; ++d0) {
#pragma unroll
                        for (int g = 0; g < 4; ++g) { const f32x4 a = scr[(d0 * 4 + g) * 64];
#pragma unroll
                            for (int e = 0; e < 4; ++e) { const float v = a[e] - li * o[d0][4 * g + e]; ss += v * v; } }
                        asm volatile("" : "+v"(ss) :: "memory"); }
                    { auto rr = __builtin_amdgcn_permlane32_swap(__float_as_uint(ss), __float_as_uint(ss), false, false); ss = __uint_as_float(rr[0]) + __uint_as_float(rr[1]); }
                    const float rs = __builtin_amdgcn_rsqf(ss * (1.f / 256.f) + RMS_EPS) * (1.f - LAMBDA_INIT);
                    unsigned oo = (unsigned)((wid * 32 + r32) * 4096 + 4 * hi) * 2u; asm volatile("" : "+v"(oo));
                    bf16* orow = (bf16*)((unsigned char*)(OAB + rowq * 4096 + h * 256) + oo);
#pragma unroll
                    for (int d0 = 0; d0 < 8; ++d0) {
#pragma unroll
                        for (int g = 0; g < 4; ++g) { const f32x4 a = scr[(d0 * 4 + g) * 64]; const f32x4 gg = *(const f32x4*)(P.subln_g + d0 * 32 + 8 * g + 4 * hi);
                            float v[4];
#pragma unroll
                            for (int e = 0; e < 4; ++e) v[e] = (a[e] - li * o[d0][4 * g + e]) * rs * gg[e];
                            v2u w; w.x = cvt_pk(v[0], v[1]); w.y = cvt_pk(v[2], v[3]);
                            *(v2u*)(orow + d0 * 32 + 8 * g) = w; }
                        asm volatile("" ::: "memory"); }
                }
            }
        }
    }
    for (int dq = 0; dq < 8; ++dq) {
        const int q = (q0 + dq) & 7, b = q >> 2, qx = q & 3;
        for (;;) {
            if (tid == 0) MISC[16] = __hip_atomic_fetch_add((unsigned*)(ctl + CW_ATTQ + qoff + 64 * (8 + q)), 1u, __ATOMIC_RELAXED, __HIP_MEMORY_SCOPE_AGENT);
            __syncthreads();
            const int n = (int)__builtin_amdgcn_readfirstlane(MISC[16]);
            __syncthreads();
            if (n >= 128) break;
            const int h = 4 * qx + (n & 3), qb = 31 - (n >> 2);
            const size_t rowq = (size_t)b * SEQ + (size_t)qb * 256;
            f32x16 o[4]; float l;
            const unsigned kofs = (unsigned)(WS_KVB + ((size_t)b * SEQ * KVLD + h * 320) * 2);
            attn_block<192, 128, false>(lds, ws, QB + rowq * 3072 + h * 192, 3072, kofs, (unsigned)(KVLD * 2), kofs + 384u, (unsigned)(KVLD * 2), qb, 0.f, o, l);
            const float inv = 1.f / l;
            unsigned oo = (unsigned)((wid * 32 + r32) * 4096 + 4 * hi) * 2u; asm volatile("" : "+v"(oo));
            bf16* orow = (bf16*)((unsigned char*)(OAB + rowq * 4096 + 2048 + h * 128) + oo);
#pragma unroll
            for (int d0 = 0; d0 < 4; ++d0)
#pragma unroll
                for (int g = 0; g < 4; ++g) { v2u w; w.x = cvt_pk(o[d0][4 * g] * inv, o[d0][4 * g + 1] * inv); w.y = cvt_pk(o[d0][4 * g + 2] * inv, o[d0][4 * g + 3] * inv);
                    *(v2u*)(orow + d0 * 32 + 8 * g) = w; }
        }
    }
}
}

__device__ __forceinline__ void rowss_phase(const bf16* LAT, float* rowss, int gw, int NGW, int lane) {
    for (int m = gw; m < M; m += NGW) {
        const GAS v4u* r = (const GAS v4u*)(LAT + (size_t)m * 1536) + lane;
        float sq = 0.f, sk = 0.f;
#pragma unroll
        for (int j = 0; j < 3; ++j) { const v4u w = r[64 * j]; f32x4 a, b; pg8::unpack8(w, a, b);
            const float t = (a[0] * a[0] + a[1] * a[1]) + (a[2] * a[2] + a[3] * a[3]) + (b[0] * b[0] + b[1] * b[1]) + (b[2] * b[2] + b[3] * b[3]);
            if (j < 2) sq += t; else sk += t; }
        sq = wave_sum(sq); sk = wave_sum(sk);
        if (lane == 0) { rowss[m] = sq; rowss[M + m] = sk; }
    }
}
__device__ __forceinline__ void normmax_phase(const bf16* QKV, volatile LAS unsigned* nmax  , int gw, int NGW, int lane) {
    float mq[4] = {0.f, 0.f, 0.f, 0.f}, mk[4] = {0.f, 0.f, 0.f, 0.f}; int cur_b = -1;
    for (int m = gw; ; m += NGW) {
        const int b = m < M ? m / SEQ : -2;
        if (b != cur_b) {
            if (cur_b >= 0 && (lane & 15) == 0) {
#pragma unroll
                for (int j = 0; j < 4; ++j) { const int v = j * 4 + (lane >> 4);
                    __hip_atomic_fetch_max((LAS unsigned*)(nmax + (cur_b * 16 + v) * 2), __float_as_uint(mq[j]), __ATOMIC_RELAXED, __HIP_MEMORY_SCOPE_WORKGROUP);
                    __hip_atomic_fetch_max((LAS unsigned*)(nmax + (cur_b * 16 + v) * 2 + 1), __float_as_uint(mk[j]), __ATOMIC_RELAXED, __HIP_MEMORY_SCOPE_WORKGROUP); } }
#pragma unroll
            for (int j = 0; j < 4; ++j) { mq[j] = 0.f; mk[j] = 0.f; }
            cur_b = b;
        }
        if (m >= M) break;
        const GAS v4u* rq = (const GAS v4u*)(QKV + (size_t)m * 6144) + lane;
#pragma unroll
        for (int j = 0; j < 4; ++j) {
            f32x4 a, c; pg8::unpack8(rq[64 * j], a, c);
            float tq = (a[0] * a[0] + a[1] * a[1]) + (a[2] * a[2] + a[3] * a[3]) + (c[0] * c[0] + c[1] * c[1]) + (c[2] * c[2] + c[3] * c[3]);
            pg8::unpack8(rq[256 + 64 * j], a, c);
            float tk = (a[0] * a[0] + a[1] * a[1]) + (a[2] * a[2] + a[3] * a[3]) + (c[0] * c[0] + c[1] * c[1]) + (c[2] * c[2] + c[3] * c[3]);
#pragma unroll
            for (int o = 1; o < 16; o <<= 1) { tq += __shfl_xor(tq, o); tk += __shfl_xor(tk, o); }
            mq[j] = fmaxf(mq[j], tq); mk[j] = fmaxf(mk[j], tk);
        }
    }
}
__device__ __forceinline__ void ln_phase(const bf16* in, const float* g, const float* bta, float* of, bf16* ob, float* stat  , int gw, int NGW, int lane) {
    for (int m = gw; m < M; m += NGW) {
        GAS const v4u* xr = (GAS const v4u*)(in + (size_t)m * DM) + lane;
        f32x4 v[8][2]; float s = 0.f;
#pragma unroll
        for (int j = 0; j < 8; ++j) { const v4u w = xr[64 * j]; pg8::unpack8h(w, v[j][0], v[j][1]);
            s += ((v[j][0][0] + v[j][0][1]) + (v[j][0][2] + v[j][0][3])) + ((v[j][1][0] + v[j][1][1]) + (v[j][1][2] + v[j][1][3])); }
        const float mean = wave_sum(s) * (1.f / DM); float s2 = 0.f;
#pragma unroll
        for (int j = 0; j < 8; ++j)
#pragma unroll
            for (int h = 0; h < 2; ++h) { v[j][h] = v[j][h] - mean; s2 += (v[j][h][0] * v[j][h][0] + v[j][h][1] * v[j][h][1]) + (v[j][h][2] * v[j][h][2] + v[j][h][3] * v[j][h][3]); }
        const float rstd = 1.f / sqrtf(wave_sum(s2) * (1.f / DM) + LN_EPS);
        if (stat && lane == 0) { stat[m] = mean; stat[M + m] = rstd; }
#pragma unroll
        for (int j = 0; j < 8; ++j) { const int c = 8 * lane + 512 * j;
            const f32x4 y0 = v[j][0] * rstd * *(const f32x4*)(g + c) + *(const f32x4*)(bta + c), y1 = v[j][1] * rstd * *(const f32x4*)(g + c + 4) + *(const f32x4*)(bta + c + 4);
            if (of) { GAS f32x4* o = (GAS f32x4*)(of + (size_t)m * DM + c); o[0] = y0; o[1] = y1; }
            if (ob) *((GAS v4u*)(ob + (size_t)m * DM + c)) = pg8::pack8(y0, y1); }
    }
}
__device__ __forceinline__ void conv_fix_phase(const bf16* SIDE, const float* cw, const float* cb, bf16* ACT, int gw, int NGW, int lane) {
    constexpr int NCG = (DFF + 511) / 512, NCH = M / 64;
    for (int it = gw; it < NCG * NCH; it += NGW) {
        const int cg = it % NCG, c = it / NCG, ch = cg * 512 + lane * 8;
        if (ch >= DFF) continue;
        const bool first = (c % (SEQ / 64)) == 0;
        f32x4 u[4][2][2];
#pragma unroll
        for (int j = 0; j < 4; ++j)
#pragma unroll
            for (int gv = 0; gv < 2; ++gv) {
                if (j < 2 && first) { u[j][gv][0] = (f32x4){0.f, 0.f, 0.f, 0.f}; u[j][gv][1] = (f32x4){0.f, 0.f, 0.f, 0.f}; }
                else { const int cc = j < 2 ? c - 1 : c, jj = j < 2 ? j + 2 : j - 2;
                    pg8::unpack8(*(const v4u*)(SIDE + ((size_t)(cc * 4 + jj) * 2 + gv) * DFF + ch), u[j][gv][0], u[j][gv][1]); } }
#pragma unroll
        for (int r = 0; r < 2; ++r) {
            float o[8];
#pragma unroll
            for (int e = 0; e < 8; ++e) {
                const int h = e >> 2, q = e & 3;
                const float cgate = cb[ch + e] + cw[ch + e] * u[r][0][h][q] + cw[(size_t)2 * DFF + ch + e] * u[r + 1][0][h][q] + cw[(size_t)4 * DFF + ch + e] * u[r + 2][0][h][q];
                const float cval = cb[DFF + ch + e] + cw[DFF + ch + e] * u[r][1][h][q] + cw[(size_t)3 * DFF + ch + e] * u[r + 1][1][h][q] + cw[(size_t)5 * DFF + ch + e] * u[r + 2][1][h][q];
                o[e] = cgate * pg8::sigmoidf_(cgate) * cval;
            }
            v4u w; w.x = cvt_pk(o[0], o[1]); w.y = cvt_pk(o[2], o[3]); w.z = cvt_pk(o[4], o[5]); w.w = cvt_pk(o[6], o[7]);
            *(v4u*)(ACT + (size_t)(c * 64 + r) * DFF + ch) = w;
        }
    }
}

struct Args { const void* in[24]; float* out; unsigned char* ws; int ph_lo, ph_hi, li, pad; };
constexpr int N_PHASES = 11;
__global__ void __launch_bounds__(NWAVES * 64, 2) mk_fwd(Args args) {
    extern __shared__ __attribute__((aligned(16))) unsigned char lds_raw[];
    LAS unsigned char* lds = (LAS unsigned char*)lds_raw;
    volatile LAS unsigned* MISC = (volatile LAS unsigned*)(lds + MISC_OFF);
    const int tid = threadIdx.x, lane = tid & 63, wave = __builtin_amdgcn_readfirstlane(tid >> 6);
    const int G = gridDim.x; const int bx = blockIdx.x; const int vcu = (G % 8 == 0) ? (bx % 8) * (G / 8) + bx / 8 : bx;
    Ptrs P;
    P.x = (const float*)args.in[0]; P.pos = (const int*)args.in[1]; P.w_in = (const float*)args.in[2]; P.b_gate = (const float*)args.in[3];
    P.lq1 = (const float*)args.in[4]; P.lk1 = (const float*)args.in[5]; P.lq2 = (const float*)args.in[6]; P.lk2 = (const float*)args.in[7];
    P.subln_g = (const float*)args.in[8]; P.qn_g = (const float*)args.in[9]; P.kvn_g = (const float*)args.in[10];
    P.w_uq = (const float*)args.in[11]; P.w_ukv = (const float*)args.in[12]; P.w_pa = (const float*)args.in[13]; P.w_pb = (const float*)args.in[14]; P.w_out = (const float*)args.in[15];
    P.ln1_g = (const float*)args.in[16]; P.ln1_b = (const float*)args.in[17]; P.w_up = (const float*)args.in[18]; P.conv_w = (const float*)args.in[19]; P.conv_b = (const float*)args.in[20];
    P.w_down = (const float*)args.in[21]; P.ln2_g = (const float*)args.in[22]; P.ln2_b = (const float*)args.in[23];
    P.out = args.out; P.ws = args.ws;
    unsigned char* ws = args.ws;
    gu32* ctl = (gu32*)(ws + WS_CTL);
    for (int u = tid; u < (LDS_BYTES - LDSCTL_OFF) / 4; u += NWAVES * 64) ((LAS unsigned*)(lds + LDSCTL_OFF))[u] = 0u;
    __syncthreads();
    XcdBarrier bar = xcd_barrier_post((unsigned*)(ctl + 4096) + args.li * XCD_BAR_WORDS, MISC + 8);
    const int lo = args.ph_lo, hi = args.ph_hi;
#define IN(k) (lo <= (k) && (k) < hi)
#define SEAM(k) do { if (IN(k) && IN((k) + 1)) xcd_barrier(bar); } while (0)
#define SEAM2B() do { if (IN(2)) xcd_barrier(bar); } while (0)
    const int gw = vcu * NWAVES + wave, NGW = G * NWAVES;
    typedef pg8::bf16_t bt;
    const int xcd_rot = bx & 7;
#define KOFF(K_) ((((K_) / 64) * xcd_rot / 8) & ~1)

    if (IN(0)) { p0_prologue(P, lds, vcu, G, wave, lane); } SEAM(0);

    if (IN(1)) {
        pg8::Gemm g{(const bt*)(ws + WS_XB), (const bt*)(ws + WS_WIN), M, N1, DM, DM, DM, KOFF(DM)}; pg8::StaticOrder S; S.init(M, N1, G, bx);
        pg8::EpiIn E{(bt*)(ws + WS_QKV), (bt*)(ws + WS_LAT), (bt*)(ws + WS_G), (bt*)(ws + WS_KVB), (float*)(ws + WS_ROWSS), P.b_gate, (const float*)(ws + WS_ROPE), C2A, M};
        pg8::gemm_phase<pg8::EpiIn, pg8::StaticOrder, true, true>(lds, g, S, E);
    } SEAM(1);

    if (IN(2)) {
        if (tid < 64) MISC[64 + tid] = 0u;
        __syncthreads();
        rowss_phase((const bf16*)(ws + WS_LAT), (float*)(ws + WS_ROWSS), gw, NGW, lane);
        normmax_phase((const bf16*)(ws + WS_QKV), MISC + 64, gw, NGW, lane);
        __syncthreads();
        if (tid < 64) ((GAS unsigned*)(ws + WS_NPART))[bx * 64 + tid] = MISC[64 + tid];
    } SEAM2B();

    if (IN(2)) {
        { pg8::Gemm g{(const bt*)(ws + WS_LAT), (const bt*)(ws + WS_WUQ), M, 3072, 1024, 1536, 1024, KOFF(1024)}; pg8::StaticOrder S; S.init(M, 3072, G, bx);
          pg8::EpiQb E{(bt*)(ws + WS_QB), (const float*)(ws + WS_ROWSS), (const float*)(ws + WS_ROPE), C2B};
          pg8::gemm_phase<pg8::EpiQb, pg8::StaticOrder, true, true>(lds, g, S, E); }
        { pg8::Gemm g{(const bt*)(ws + WS_LAT) + 1024, (const bt*)(ws + WS_WUKV), M, 4096, 512, 1536, 512, KOFF(512)}; pg8::StaticOrder S; S.init(M, 4096, G, bx);
          pg8::EpiKv E{(bt*)(ws + WS_KVB), (const float*)(ws + WS_ROWSS) + M};
          pg8::gemm_phase<pg8::EpiKv, pg8::StaticOrder, true, true>(lds, g, S, E); }
    } SEAM(2);

    if (IN(3)) { att::attn_phase(P, lds, MISC, ctl, 0); } SEAM(3);

    if (IN(4)) {
        pg8::Gemm g{(const bt*)(ws + WS_OAB), (const bt*)(ws + WS_WPA), M, 4096, 4096, 4096, 4096, 0}; pg8::StaticOrder S; S.init(M, 4096, G, bx);
        pg8::EpiMerge E{(const bt*)(ws + WS_G), (bt*)(ws + WS_MRG)};
        pg8::gemm_phase<pg8::EpiMerge, pg8::StaticOrder, true, true>(lds, g, S, E);
    } SEAM(4);

    if (IN(5)) {
        pg8::Gemm g{(const bt*)(ws + WS_MRG), (const bt*)(ws + WS_WOUT), M, 4096, 4096, 4096, 4096, KOFF(4096)}; pg8::StaticOrder S; S.init(M, 4096, G, bx);
        pg8::EpiRes E{P.x, (bt*)(ws + WS_YB), ALPHA};
        pg8::gemm_phase<pg8::EpiRes, pg8::StaticOrder, true, true>(lds, g, S, E);
    } SEAM(5);

    if (IN(6)) { ln_phase((const bf16*)(ws + WS_YB), P.ln1_g, P.ln1_b, nullptr, (bf16*)(ws + WS_H1B), (float*)(ws + WS_ROWSS), gw, NGW, lane); } SEAM(6);

    if (IN(7)) {
        pg8::Gemm g{(const bt*)(ws + WS_H1B), (const bt*)(ws + WS_WUP), M, 22016, 4096, 4096, 4096, KOFF(4096)}; pg8::StaticOrder S; S.init(M, 22016, G, bx);
        pg8::EpiConv E{(bt*)(ws + WS_ACT), (bt*)(ws + WS_SIDE), P.conv_w, P.conv_b, DFF};
        pg8::gemm_phase<pg8::EpiConv, pg8::StaticOrder, true, true>(lds, g, S, E);
    } SEAM(7);

    if (IN(8)) { conv_fix_phase((const bf16*)(ws + WS_SIDE), P.conv_w, P.conv_b, (bf16*)(ws + WS_ACT), gw, NGW, lane); } SEAM(8);

    if (IN(9)) {
        pg8::Gemm g{(const bt*)(ws + WS_ACT), (const bt*)(ws + WS_WDN), M, 4096, DFF, DFF, DFF, KOFF(DFF)}; pg8::StaticOrder S; S.init(M, 4096, G, bx);
        pg8::EpiDown E{(const bt*)(ws + WS_YB), (bt*)(ws + WS_Y2B), (const float*)(ws + WS_ROWSS), P.ln1_g, P.ln1_b, ALPHA, M};
        pg8::gemm_phase<pg8::EpiDown, pg8::StaticOrder, true, true>(lds, g, S, E);
    } SEAM(9);

    if (IN(10)) { ln_phase((const bf16*)(ws + WS_Y2B), P.ln2_g, P.ln2_b, P.out, nullptr, nullptr, gw, NGW, lane); }
#undef IN
#undef SEAM
#undef SEAM2B
}

extern "C" void kernel_launch(void* const* d_in, const int* in_sizes, int n_in, void* d_out, int out_size, void* d_ws, size_t ws_size, hipStream_t stream) {
    static int grid = 0;
    if (grid == 0) {
        if (n_in != 24 || in_sizes[0] != M * DM || out_size != M * DM || ws_size < WS_END) { fprintf(stderr, "kernel_launch: unexpected shapes (n_in %d, x %d, out %d, ws %zu < %zu)\n", n_in, n_in > 0 ? in_sizes[0] : -1, out_size, ws_size, (size_t)WS_END); grid = -1; return; }
        int dev = 0, cus = 0, per_cu = 0;
        if (hipGetDevice(&dev) != hipSuccess || hipDeviceGetAttribute(&cus, hipDeviceAttributeMultiprocessorCount, dev) != hipSuccess) { grid = -1; return; }
        if (hipFuncSetAttribute((const void*)mk_fwd, hipFuncAttributeMaxDynamicSharedMemorySize, LDS_BYTES) != hipSuccess) { fprintf(stderr, "kernel_launch: hipFuncSetAttribute failed\n"); grid = -1; return; }
        if (hipOccupancyMaxActiveBlocksPerMultiprocessor(&per_cu, (const void*)mk_fwd, NWAVES * 64, LDS_BYTES) != hipSuccess || per_cu < 1) fprintf(stderr, "kernel_launch: occupancy query says %d\n", per_cu);
        (void)hipGetLastError();
        grid = cus < 256 ? cus : 256;
    }
    if (grid < 0) return;
    if (hipMemsetAsync((char*)d_ws + WS_CTL, 0, CTL_ZERO_BYTES, stream) != hipSuccess) return;
    Args a{};
    for (int i = 0; i < 24; ++i) a.in[i] = d_in[i];
    a.out = (float*)d_out; a.ws = (unsigned char*)d_ws;
    constexpr int NL = MK_N_LAUNCHES;
    for (int li = 0; li < NL; ++li) {
        constexpr bool ONE = (MK_N_LAUNCHES == 1);
        a.ph_lo = ONE ? 0 : li; a.ph_hi = ONE ? N_PHASES : li + 1; a.li = ONE ? 0 : li; a.pad = 0;
        hipLaunchKernelGGL(mk_fwd, dim3(grid), dim3(NWAVES * 64), LDS_BYTES, stream, a);
        const hipError_t le = hipPeekAtLastError();
        if (le != hipSuccess) { fprintf(stderr, "kernel_launch: launch %d failed: %s\n", li, hipGetErrorName(le)); break; }
    }
}
```

```cpp
#include <hip/hip_runtime.h>
#include <cstdio>
#include <cstdint>

#ifndef MK_N_LAUNCHES
#define MK_N_LAUNCHES 1
#endif

constexpr int BATCH = 2, SEQ = 8192, DM = 4096, M = BATCH * SEQ;
constexpr int DA_H = 8, ML_H = 16, DFF = 11008;
constexpr int IN_COLS = 15936, N1 = 16128;
constexpr float ALPHA = 1.189207115002721f;
constexpr float LN_EPS = 1e-5f, RMS_EPS = 1e-6f;
constexpr float LOG2E = 1.4426950408889634f;
constexpr float C2A = 0.08838834764831845f * LOG2E;
constexpr float C2B = 0.07216878364870323f * LOG2E;
constexpr float LAMBDA_INIT = 0.2f;

constexpr size_t MiB = 1u << 20;
constexpr size_t WS_CTL = 0, CTL_ZERO_BYTES = 65536;
constexpr size_t WS_ROPE = 1 * MiB;
constexpr size_t WS_ROWSS = 5 * MiB;
constexpr size_t WS_NPART = 6 * MiB;
constexpr size_t WS_WIN = 8 * MiB, WS_WUQ = 134 * MiB, WS_WUKV = 140 * MiB, WS_WPA = 144 * MiB, WS_WPB = 160 * MiB, WS_WOUT = 176 * MiB, WS_WUP = 208 * MiB, WS_WDN = 380 * MiB;
constexpr size_t WS_XB = 466 * MiB;
constexpr size_t WS_OAB = WS_XB, WS_H1B = WS_XB;
constexpr size_t WS_QKV = 594 * MiB;
constexpr size_t WS_QB = 786 * MiB;
constexpr size_t WS_KVB = 882 * MiB;
constexpr size_t WS_LAT = 1042 * MiB;
constexpr size_t WS_G = 1090 * MiB;
constexpr size_t WS_TMP = 594 * MiB;
constexpr size_t WS_MRG = 850 * MiB;
constexpr size_t WS_SIDE = 594 * MiB;
constexpr size_t WS_ACT = 640 * MiB;
constexpr size_t WS_O0 = 8 * MiB;
constexpr size_t WS_YB = 1000 * MiB;
constexpr size_t WS_Y2B = 1136 * MiB;
constexpr size_t WS_END = 1376 * MiB;
constexpr int KVLD = 5120;

constexpr int RING_BYTES = 131072, LDSCTL_OFF = RING_BYTES, MISC_OFF = LDSCTL_OFF + 320, LDS_BYTES = 147456;
constexpr int NWAVES = 8;

#define GAS __attribute__((address_space(1)))
#define LAS __attribute__((address_space(3)))
typedef unsigned short bf16;
typedef unsigned v4u __attribute__((ext_vector_type(4)));
typedef unsigned v2u __attribute__((ext_vector_type(2)));
typedef float f32x4 __attribute__((ext_vector_type(4)));
typedef float f32x2 __attribute__((ext_vector_type(2)));
typedef float f32x16 __attribute__((ext_vector_type(16)));
typedef short bf16x8 __attribute__((ext_vector_type(8)));
typedef short s16x4 __attribute__((ext_vector_type(4)));
typedef GAS unsigned gu32;
#define RLX_AGENT __ATOMIC_RELAXED, __HIP_MEMORY_SCOPE_AGENT
#define LDS_WAIT() asm volatile("s_waitcnt lgkmcnt(0)" ::: "memory")
#define VM_WAIT() asm volatile("s_waitcnt vmcnt(0)" ::: "memory")
typedef __bf16 bf16x2_t __attribute__((ext_vector_type(2)));
__device__ __forceinline__ unsigned cvt_pk(float lo, float hi) { const f32x2 v = {lo, hi}; const bf16x2_t b = __builtin_convertvector(v, bf16x2_t); return __builtin_bit_cast(unsigned, b); }
__device__ __forceinline__ float bf_lo(unsigned w) { return __uint_as_float(w << 16); }
__device__ __forceinline__ float bf_hi(unsigned w) { return __uint_as_float(w & 0xffff0000u); }
__device__ __forceinline__ float wave_sum(float v) {
#pragma unroll
    for (int o = 1; o < 64; o <<= 1) v += __shfl_xor(v, o);
    return v;
}
namespace pg8 {
#define PG8_LAS __attribute__((address_space(3)))
typedef unsigned short bf16_t;
typedef short bf16x8 __attribute__((ext_vector_type(8)));
typedef float f32x4 __attribute__((ext_vector_type(4)));
typedef unsigned u32x4 __attribute__((ext_vector_type(4)));
constexpr int BM = 256, BK = 64, HALF = 128, HTB = HALF * BK * 2  , STAGE_BYTES = 8 * HTB, NXCD = 8, WGM = 8;

__host__ __device__ __forceinline__ int lds_byte(int r, int c) { const int st = (r >> 4) * 2 + (c >> 5), rr = r & 15, cc = c & 31, ob = rr * 64 + cc * 2; return st * 1024 + (ob ^ (((ob >> 9) & 1) << 5)); }
__host__ __device__ __forceinline__ void stage_rc(int b, int& R, int& C) { const int st = b / 1024, sb = b % 1024, swz = sb ^ (((sb >> 9) & 1) << 5); R = (st >> 1) * 16 + swz / 64; C = (st & 1) * 32 + (swz % 64) / 2; }
__host__ __device__ __forceinline__ int perm32(int rho) { const int n = rho >> 4, i = rho & 15; return 8 * (i >> 2) + 4 * n + (i & 3); }

struct Unit { int pm, pn; };
struct Gemm { const bf16_t* A; const bf16_t* Bt; int M, N, K, lda, ldb, koff; };

struct StaticOrder {
    int nM, nN, nwg, G, c;
    __host__ __device__ void init(int M, int N, int G_, int c_) { nM = M / BM; nN = N / BM; nwg = nM * nN; G = G_; c = c_; }
    __host__ __device__ bool next(int i, Unit& u) const {
        const long L = (long)i * G + c; if (L >= nwg) return false;
        int wgid = (int)L; { const int q = nwg / NXCD, r = nwg % NXCD, xcd = wgid % NXCD, off = wgid / NXCD; wgid = (xcd < r ? xcd * (q + 1) : r * (q + 1) + (xcd - r) * q) + off; }
        const int nig = WGM * nN, gid = wgid / nig, fm = gid * WGM, gsz = (nM - fm) < WGM ? (nM - fm) : WGM;
        u.pm = fm + ((wgid % nig) % gsz); u.pn = (wgid % nig) / gsz; return true;
    }
    __device__ __forceinline__ void a_ready(const Unit&) const {}
    __device__ __forceinline__ void done(const Unit&) const {}
};

__device__ __forceinline__ unsigned cvt_pk_bf16(float lo, float hi) { return ::cvt_pk(lo, hi); }
typedef float f32x2 __attribute__((ext_vector_type(2)));
__device__ __forceinline__ u32x4 pack8(f32x4 a, f32x4 b) { u32x4 w; w.x = cvt_pk_bf16(a[0], a[1]); w.y = cvt_pk_bf16(a[2], a[3]); w.z = cvt_pk_bf16(b[0], b[1]); w.w = cvt_pk_bf16(b[2], b[3]); return w; }
__device__ __forceinline__ float bflo(unsigned w) { return __uint_as_float(w << 16); }
__device__ __forceinline__ float bfhi(unsigned w) { return __uint_as_float(w & 0xffff0000u); }
__device__ __forceinline__ float sigmoidf_(float x) { return __builtin_amdgcn_rcpf(1.f + __builtin_amdgcn_exp2f(-1.4426950408889634f * x)); }
__device__ __forceinline__ void rope8(f32x4& v0, f32x4& v1, const float* cs  , int i0) {
    const f32x4 c = *(const f32x4*)(cs + i0), s = *(const f32x4*)(cs + 32 + i0);
    const f32x4 a = v0, b = v1;
    v0[0] = a[0] * c[0] - a[1] * s[0]; v0[1] = a[0] * s[0] + a[1] * c[0];
    v0[2] = a[2] * c[1] - a[3] * s[1]; v0[3] = a[2] * s[1] + a[3] * c[1];
    v1[0] = b[0] * c[2] - b[1] * s[2]; v1[1] = b[0] * s[2] + b[1] * c[2];
    v1[2] = b[2] * c[3] - b[3] * s[3]; v1[3] = b[2] * s[3] + b[3] * c[3];
}
#define PG8_ROWLOOP _Pragma("unroll") for (int ai = 0; ai < 2; ++ai) _Pragma("unroll") for (int m = 0; m < 4; ++m)

struct EpiIn {
    static constexpr bool PERM = true, AFTER_DRAIN = false, MID = false;
    bf16_t* qkv; bf16_t* lat; bf16_t* gate; bf16_t* kvb; float* rowss; const float* bgate; const float* rope; float c2a; int Mrows;
    __device__ __forceinline__ void operator()(const f32x4 (&acc)[2][2][4][2], const Unit& u, int wr, int wc, int fr, int fq) const {
        const int row0 = u.pm * BM + wr * 64 + fr, lc0 = wc * 32 + 8 * fq, pn = u.pn;
        if (pn < 24) {
            const float sc = pn < 8 ? c2a : 1.f;
            PG8_ROWLOOP { bf16_t* rowp = qkv + (size_t)(row0 + ai * HALF + m * 16) * 6144 + pn * 256 + lc0;
#pragma unroll
                for (int bj = 0; bj < 2; ++bj) *(u32x4*)(rowp + bj * HALF) = pack8(acc[ai][bj][m][0] * sc, acc[ai][bj][m][1] * sc); }
        } else if (pn < 30) {
            PG8_ROWLOOP { bf16_t* rowp = lat + (size_t)(row0 + ai * HALF + m * 16) * 1536 + (pn - 24) * 256 + lc0;
#pragma unroll
                for (int bj = 0; bj < 2; ++bj) *(u32x4*)(rowp + bj * HALF) = pack8(acc[ai][bj][m][0], acc[ai][bj][m][1]); }
        } else if (pn < 62) {
            const int gc0 = (pn - 30) * 256 + lc0;
            f32x4 bv[2][2];
#pragma unroll
            for (int bj = 0; bj < 2; ++bj)
#pragma unroll
                for (int n = 0; n < 2; ++n) bv[bj][n] = *(const f32x4*)(bgate + gc0 + bj * HALF + 4 * n);
            PG8_ROWLOOP { bf16_t* rowp = gate + (size_t)(row0 + ai * HALF + m * 16) * 8192 + gc0;
#pragma unroll
                for (int bj = 0; bj < 2; ++bj) { f32x4 a = acc[ai][bj][m][0] + bv[bj][0], b = acc[ai][bj][m][1] + bv[bj][1];
#pragma unroll
                    for (int e = 0; e < 4; ++e) { a[e] = sigmoidf_(a[e]); b[e] = sigmoidf_(b[e]); }
                    *(u32x4*)(rowp + bj * HALF) = pack8(a, b); } }
        } else {
            if (wc < 2) {
                PG8_ROWLOOP { const int row = row0 + ai * HALF + m * 16; f32x4 a = acc[ai][0][m][0], b = acc[ai][0][m][1];
                    rope8(a, b, rope + (size_t)row * 64, lc0 >> 1);
                    const u32x4 w = pack8(a, b); bf16_t* rowp = kvb + (size_t)row * 5120 + 128 + lc0;
#pragma unroll
                    for (int h = 0; h < 16; ++h) *(u32x4*)(rowp + h * 320) = w; }
            }
        }
    }
};
struct EpiQb {
    static constexpr bool PERM = true, AFTER_DRAIN = false, MID = false;
    bf16_t* qb; const float* rowss; const float* rope; float c2b;
    __device__ __forceinline__ void operator()(const f32x4 (&acc)[2][2][4][2], const Unit& u, int wr, int wc, int fr, int fq) const {
        const int row0 = u.pm * BM + wr * 64 + fr, lc0 = wc * 32 + 8 * fq;
        int col[2], i0[2]; bool isr[2];
#pragma unroll
        for (int bj = 0; bj < 2; ++bj) { col[bj] = u.pn * 256 + bj * HALF + lc0; const int h = col[bj] / 192, j = col[bj] - h * 192; isr[bj] = j >= 128; i0[bj] = (j - 128) >> 1; }
        PG8_ROWLOOP { const int row = row0 + ai * HALF + m * 16; const float rs = __builtin_amdgcn_rsqf(rowss[row] * (1.f / 1024.f) + 1e-6f) * c2b;
#pragma unroll
            for (int bj = 0; bj < 2; ++bj) { f32x4 a = acc[ai][bj][m][0] * rs, b = acc[ai][bj][m][1] * rs;
                if (isr[bj]) rope8(a, b, rope + (size_t)row * 64, i0[bj]);
                *(u32x4*)(qb + (size_t)row * 3072 + col[bj]) = pack8(a, b); } }
    }
};
struct EpiKv {
    static constexpr bool PERM = true, AFTER_DRAIN = false, MID = false;
    bf16_t* kvb; const float* rowss;
    __device__ __forceinline__ void operator()(const f32x4 (&acc)[2][2][4][2], const Unit& u, int wr, int wc, int fr, int fq) const {
        const int row0 = u.pm * BM + wr * 64 + fr, lc0 = wc * 32 + 8 * fq;
        PG8_ROWLOOP { const int row = row0 + ai * HALF + m * 16; const float rs = __builtin_amdgcn_rsqf(rowss[row] * (1.f / 512.f) + 1e-6f);
            bf16_t* rowp = kvb + (size_t)row * 5120 + u.pn * 320 + lc0;
            *(u32x4*)(rowp) = pack8(acc[ai][0][m][0] * rs, acc[ai][0][m][1] * rs);
            *(u32x4*)(rowp + 192) = pack8(acc[ai][1][m][0] * rs, acc[ai][1][m][1] * rs); }
    }
};
__device__ __forceinline__ void unpack8(const u32x4 w, f32x4& a, f32x4& b) { a[0] = bflo(w.x); a[1] = bfhi(w.x); a[2] = bflo(w.y); a[3] = bfhi(w.y); b[0] = bflo(w.z); b[1] = bfhi(w.z); b[2] = bflo(w.w); b[3] = bfhi(w.w); }
typedef _Float16 h16x2 __attribute__((ext_vector_type(2)));
__device__ __forceinline__ unsigned cvt_pk_h(float a, float b) { const f32x2 v = {a, b}; return __builtin_bit_cast(unsigned, __builtin_convertvector(v, h16x2)); }
__device__ __forceinline__ u32x4 pack8h(f32x4 a, f32x4 b) { u32x4 w; w.x = cvt_pk_h(a[0], a[1]); w.y = cvt_pk_h(a[2], a[3]); w.z = cvt_pk_h(b[0], b[1]); w.w = cvt_pk_h(b[2], b[3]); return w; }
__device__ __forceinline__ f32x2 h2f(unsigned w) { return __builtin_convertvector(__builtin_bit_cast(h16x2, w), f32x2); }
__device__ __forceinline__ void unpack8h(const u32x4 w, f32x4& a, f32x4& b) { const f32x2 p = h2f(w.x), q = h2f(w.y), r = h2f(w.z), t = h2f(w.w); a[0] = p[0]; a[1] = p[1]; a[2] = q[0]; a[3] = q[1]; b[0] = r[0]; b[1] = r[1]; b[2] = t[0]; b[3] = t[1]; }
struct EpiMerge {
    static constexpr bool PERM = true, AFTER_DRAIN = false, MID = true;
    const bf16_t* gate; bf16_t* mrg;
    __device__ __forceinline__ void mid(f32x4 (&acc)[2][2][4][2], const Unit& u, int wr, int wc, int fr, int fq) const {
        int fro = fr; asm volatile("" : "+v"(fro));
        const int row0 = u.pm * BM + wr * 64 + fro, c0 = u.pn * 256 + wc * 32 + 8 * fq;
        PG8_ROWLOOP { const bf16_t* gp = gate + (size_t)(row0 + ai * HALF + m * 16) * 8192 + c0;
#pragma unroll
            for (int bj = 0; bj < 2; ++bj) { f32x4 a0, a1, b0, b1; unpack8(*(const u32x4*)(gp + bj * HALF), a0, a1); unpack8(*(const u32x4*)(gp + 4096 + bj * HALF), b0, b1);
#pragma unroll
                for (int e = 0; e < 4; ++e) { acc[ai][bj][m][0][e] *= a0[e] * __builtin_amdgcn_rcpf(fmaxf(b0[e], 1e-30f)); acc[ai][bj][m][1][e] *= a1[e] * __builtin_amdgcn_rcpf(fmaxf(b1[e], 1e-30f)); } }
            asm volatile("" : "+v"(acc[ai][0][m][0]), "+v"(acc[ai][0][m][1]), "+v"(acc[ai][1][m][0]), "+v"(acc[ai][1][m][1]) :: "memory"); }
    }
    __device__ __forceinline__ void operator()(const f32x4 (&acc)[2][2][4][2], const Unit& u, int wr, int wc, int fr, int fq) const {
        const int row0 = u.pm * BM + wr * 64 + fr, c0 = u.pn * 256 + wc * 32 + 8 * fq;
        PG8_ROWLOOP { const int row = row0 + ai * HALF + m * 16;
#pragma unroll
            for (int bj = 0; bj < 2; ++bj) { const int c = c0 + bj * HALF; f32x4 b0, b1; unpack8(*(const u32x4*)(gate + (size_t)row * 8192 + 4096 + c), b0, b1);
#pragma unroll
                for (int e = 0; e < 4; ++e) { b0[e] = fmaxf(b0[e], 1e-30f); b1[e] = fmaxf(b1[e], 1e-30f); }
                *(u32x4*)(mrg + (size_t)row * 4096 + c) = pack8(acc[ai][bj][m][0] * b0, acc[ai][bj][m][1] * b1); } }
    }
};
struct EpiRes {
    static constexpr bool PERM = true, AFTER_DRAIN = false, MID = false;
    const float* base; bf16_t* out; float alpha;
    __device__ __forceinline__ void operator()(const f32x4 (&acc)[2][2][4][2], const Unit& u, int wr, int wc, int fr, int fq) const {
        const int row0 = u.pm * BM + wr * 64 + fr, c0 = u.pn * 256 + wc * 32 + 8 * fq;
        PG8_ROWLOOP { const size_t ro = (size_t)(row0 + ai * HALF + m * 16) * 4096;
#pragma unroll
            for (int bj = 0; bj < 2; ++bj) { const size_t off = ro + c0 + bj * HALF; const f32x4 xa = *(const f32x4*)(base + off), xb = *(const f32x4*)(base + off + 4);
                *(u32x4*)(out + off) = pack8h(xa * alpha + acc[ai][bj][m][0], xb * alpha + acc[ai][bj][m][1]); } }
    }
};
struct EpiDown {
    static constexpr bool PERM = true, AFTER_DRAIN = false, MID = false;
    const bf16_t* yb; bf16_t* out; const float* stat; const float* g; const float* b; float alpha; int Mrows;
    __device__ __forceinline__ void operator()(const f32x4 (&acc)[2][2][4][2], const Unit& u, int wr, int wc, int fr, int fq) const {
        const int row0 = u.pm * BM + wr * 64 + fr, c0 = u.pn * 256 + wc * 32 + 8 * fq;
        f32x4 gv[2][2], bv[2][2];
#pragma unroll
        for (int bj = 0; bj < 2; ++bj)
#pragma unroll
            for (int n = 0; n < 2; ++n) { gv[bj][n] = *(const f32x4*)(g + c0 + bj * HALF + 4 * n) * alpha; bv[bj][n] = *(const f32x4*)(b + c0 + bj * HALF + 4 * n) * alpha; }
        PG8_ROWLOOP { const int row = row0 + ai * HALF + m * 16; const size_t ro = (size_t)row * 4096; const float mean = stat[row], rstd = stat[Mrows + row];
#pragma unroll
            for (int bj = 0; bj < 2; ++bj) { const size_t off = ro + c0 + bj * HALF; f32x4 ya, yc; unpack8h(*(const u32x4*)(yb + off), ya, yc);
                *(u32x4*)(out + off) = pack8h((ya - mean) * rstd * gv[bj][0] + bv[bj][0] + acc[ai][bj][m][0], (yc - mean) * rstd * gv[bj][1] + bv[bj][1] + acc[ai][bj][m][1]); } }
    }
};
__device__ __forceinline__ float dpp_prev(float prev_grp, float cur, int k) {
    const int pg = __builtin_bit_cast(int, prev_grp), cu = __builtin_bit_cast(int, cur);
    const int ro = k == 1 ? __builtin_amdgcn_mov_dpp(pg, 0x121, 0xf, 0xf, false) : __builtin_amdgcn_mov_dpp(pg, 0x122, 0xf, 0xf, false);
    const int r = k == 1 ? __builtin_amdgcn_update_dpp(ro, cu, 0x111, 0xf, 0xf, false) : __builtin_amdgcn_update_dpp(ro, cu, 0x112, 0xf, 0xf, false);
    return __builtin_bit_cast(float, r);
}
struct EpiConv {
    static constexpr bool PERM = true, AFTER_DRAIN = false, MID = false;
    bf16_t* act; bf16_t* side; const float* cw; const float* cb; int dff;
    __device__ __forceinline__ void operator()(const f32x4 (&acc)[2][2][4][2], const Unit& u, int wr, int wc, int fr, int fq) const {
        const int ch0 = u.pn * 128 + wc * 32 + 8 * fq;
#pragma unroll
        for (int n = 0; n < 2; ++n) {
            const int ch = ch0 + 4 * n;
            f32x4 wg[3], wv[3];
#pragma unroll
            for (int k = 0; k < 3; ++k) { wg[k] = *(const f32x4*)(cw + (size_t)k * 2 * dff + ch); wv[k] = *(const f32x4*)(cw + (size_t)k * 2 * dff + dff + ch); }
            const f32x4 bg = *(const f32x4*)(cb + ch), bv = *(const f32x4*)(cb + dff + ch);
#pragma unroll
            for (int ai = 0; ai < 2; ++ai) {
                const int rowc = u.pm * BM + ai * HALF + wr * 64;
#pragma unroll
                for (int m = 0; m < 4; ++m) {
                    const f32x4 g0 = acc[ai][0][m][n], v0 = acc[ai][1][m][n];
                    const f32x4 gp = m > 0 ? acc[ai][0][m - 1][n] : (f32x4){0.f, 0.f, 0.f, 0.f}, vp = m > 0 ? acc[ai][1][m - 1][n] : (f32x4){0.f, 0.f, 0.f, 0.f};
                    f32x4 o;
#pragma unroll
                    for (int e = 0; e < 4; ++e) {
                        const float g1 = dpp_prev(gp[e], g0[e], 1), g2 = dpp_prev(gp[e], g0[e], 2), v1 = dpp_prev(vp[e], v0[e], 1), v2 = dpp_prev(vp[e], v0[e], 2);
                        const float cg = bg[e] + wg[0][e] * g2 + wg[1][e] * g1 + wg[2][e] * g0[e];
                        const float cv = bv[e] + wv[0][e] * v2 + wv[1][e] * v1 + wv[2][e] * v0[e];
                        o[e] = cg * sigmoidf_(cg) * cv;
                    }
                    const int row = rowc + m * 16 + fr;
                    typedef unsigned u32x2 __attribute__((ext_vector_type(2)));
                    if (m > 0 || fr >= 2) { u32x2 w; w.x = cvt_pk_bf16(o[0], o[1]); w.y = cvt_pk_bf16(o[2], o[3]); *(u32x2*)(act + (size_t)row * dff + ch) = w; }
                    if ((m == 0 && fr < 2) || (m == 3 && fr >= 14)) {
                        const int j = m == 0 ? fr : fr - 12;
                        bf16_t* sp = side + ((size_t)((rowc >> 6) * 4 + j) * 2) * dff + ch;
                        u32x2 wgt; wgt.x = cvt_pk_bf16(g0[0], g0[1]); wgt.y = cvt_pk_bf16(g0[2], g0[3]); *(u32x2*)sp = wgt;
                        u32x2 wvl; wvl.x = cvt_pk_bf16(v0[0], v0[1]); wvl.y = cvt_pk_bf16(v0[2], v0[3]); *(u32x2*)(sp + dff) = wvl;
                    }
                }
            }
        }
    }
};
template <class Epi, class Sched, bool ALIGN_EPI = false, bool SP2 = false>
__device__ __forceinline__ void gemm_phase(PG8_LAS unsigned char* lds, const Gemm g, const Sched& S, const Epi& E) {
    const int tid = threadIdx.x, wid = __builtin_amdgcn_readfirstlane(tid >> 6), lane = tid & 63, wr = wid >> 2, wc = wid & 3, fr = lane & 15, fq = lane >> 4;
    const int K = g.K, nt = K / BK;
    unsigned voffA[2], voffB[2];
#pragma unroll
    for (int i = 0; i < 2; ++i) { int R, C; stage_rc(tid * 16 + i * 8192, R, C); const int Rb = Epi::PERM ? ((R & ~31) + perm32(R & 31)) : R;
        voffA[i] = (unsigned)(R * g.lda + C) * 2u; voffB[i] = (unsigned)(Rb * g.ldb + C) * 2u; }
    const size_t kstep = (size_t)(BK * 2);
    const int koff = g.koff; const size_t kob = (size_t)koff * kstep;
#define PG8_KP(base, t_) ((base) + (size_t)(((t_) + koff) >= nt ? (t_) + koff - nt : (t_) + koff) * kstep)
    const size_t hstepA = (size_t)HALF * g.lda * 2, hstepB = (size_t)HALF * g.ldb * 2;
    const size_t tstepA = 2 * hstepA, tstepB = 2 * hstepB;
    const unsigned ldsw = (unsigned)wid * 1024u;
    const int aoff = lds_byte(wr * 64 + fr, fq * 8), boff = lds_byte(wc * 32 + fr, fq * 8);
#define PG8_SA(b, h) (((b) * 2 + (h)) * HTB)
#define PG8_SB(b, h) ((4 + (b) * 2 + (h)) * HTB)
    const __amdgpu_buffer_rsrc_t rsrc_voffA = __builtin_amdgcn_make_buffer_rsrc((void*)g.A, (short)0, 0x7ffffff0, 0x00020000);
    const __amdgpu_buffer_rsrc_t rsrc_voffB = __builtin_amdgcn_make_buffer_rsrc((void*)g.Bt, (short)0, 0x7ffffff0, 0x00020000);
    const char* const base_voffA = (const char*)g.A; const char* const base_voffB = (const char*)g.Bt;
#define PG8_STAGE(bufoff, gbase, voff) do { const int so_ = (int)((const char*)(gbase) - base_##voff); _Pragma("unroll") for (int _i = 0; _i < 2; ++_i) \
        __builtin_amdgcn_raw_ptr_buffer_load_lds(rsrc_##voff, (PG8_LAS void*)(lds + (bufoff) + ldsw + _i * 8192), 16, (int)(voff)[_i], so_, 0, 0); } while (0)
#define PG8_LDA(dst, b, h) do { _Pragma("unroll") for (int m = 0; m < 4; ++m) _Pragma("unroll") for (int k = 0; k < 2; ++k) dst[m][k] = *(const PG8_LAS bf16x8*)(lds + PG8_SA(b, h) + aoff + m * 2048 + k * 1024); } while (0)
#define PG8_LDB(dst, b, h) do { _Pragma("unroll") for (int n = 0; n < 2; ++n) _Pragma("unroll") for (int k = 0; k < 2; ++k) dst[n][k] = *(const PG8_LAS bf16x8*)(lds + PG8_SB(b, h) + boff + n * 2048 + k * 1024); } while (0)
#define PG8_MMA(ai, bj, At, Bt) do { __builtin_amdgcn_s_setprio(1); _Pragma("unroll") for (int m = 0; m < 4; ++m) _Pragma("unroll") for (int n = 0; n < 2; ++n) _Pragma("unroll") for (int k = 0; k < 2; ++k) \
        acc[ai][bj][m][n] = __builtin_amdgcn_mfma_f32_16x16x32_bf16(Bt[n][k], At[m][k], acc[ai][bj][m][n], 0, 0, 0); __builtin_amdgcn_s_setprio(0); } while (0)
#define PG8_WAIT_V(n) asm volatile("s_waitcnt vmcnt(" #n ")" ::: "memory")
#define PG8_WAIT_L(n) asm volatile("s_waitcnt lgkmcnt(" #n ")" ::: "memory")
#define PG8_BAR __builtin_amdgcn_s_barrier()
#define PG8_SCHED __builtin_amdgcn_sched_barrier(0)
    Unit cur, nxt; int ui = 0;
    if (!S.next(0, cur)) return;
    f32x4 acc[2][2][4][2];
#pragma unroll
    for (int a = 0; a < 2; ++a)
#pragma unroll
        for (int b = 0; b < 2; ++b)
#pragma unroll
            for (int m = 0; m < 4; ++m)
#pragma unroll
                for (int n = 0; n < 2; ++n) acc[a][b][m][n] = (f32x4){0.f, 0.f, 0.f, 0.f};
    bf16x8 At[4][2], B0[2][2], B1[2][2];
    const char* cA = (const char*)g.A + (size_t)cur.pm * tstepA; const char* cB = (const char*)g.Bt + (size_t)cur.pn * tstepB;
    S.a_ready(cur);
    if constexpr (SP2) {
        PG8_STAGE(PG8_SB(0, 0), cB + kob, voffB); PG8_STAGE(PG8_SB(0, 1), cB + kob + hstepB, voffB); PG8_STAGE(PG8_SA(0, 0), cA + kob, voffA); PG8_STAGE(PG8_SA(0, 1), cA + kob + hstepA, voffA);
        if (wr == 1) PG8_BAR;
        PG8_WAIT_V(2); PG8_BAR;
        PG8_STAGE(PG8_SB(1, 0), cB + kob + kstep, voffB); PG8_STAGE(PG8_SA(1, 0), cA + kob + kstep, voffA); PG8_STAGE(PG8_SB(1, 1), cB + kob + hstepB + kstep, voffB);
        PG8_WAIT_V(6); PG8_BAR;
    } else {
        PG8_STAGE(PG8_SB(0, 0), cB + kob, voffB); PG8_STAGE(PG8_SA(0, 0), cA + kob, voffA); PG8_STAGE(PG8_SB(0, 1), cB + kob + hstepB, voffB); PG8_STAGE(PG8_SA(0, 1), cA + kob + hstepA, voffA);
        if (wr == 1) PG8_BAR;
        PG8_WAIT_V(4); PG8_BAR;
        PG8_STAGE(PG8_SB(1, 0), cB + kob + kstep, voffB); PG8_STAGE(PG8_SA(1, 0), cA + kob + kstep, voffA); PG8_STAGE(PG8_SB(1, 1), cB + kob + hstepB + kstep, voffB);
        PG8_WAIT_V(6); PG8_BAR;
    }
    for (;;) {
        const bool has_next = S.next(ui + 1, nxt);
        const char* nA = has_next ? (const char*)g.A + (size_t)nxt.pm * tstepA : cA; const char* nB = has_next ? (const char*)g.Bt + (size_t)nxt.pn * tstepB : cB;
        asm volatile(".p2align 6");
        for (int t = 0; t < nt; t += 2) {
            if constexpr (Epi::MID) { if (t == nt / 2) E.mid(acc, cur, wr, wc, fr, fq); }
            const bool last = (t == nt - 2);
            const char* a1 = PG8_KP(cA, t + 1);
            const char* a2 = last ? nA + kob : PG8_KP(cA, t + 2); const char* b2 = last ? nB + kob : PG8_KP(cB, t + 2);
            const char* a3 = a2 + kstep; const char* b3 = b2 + kstep;
            if (last && has_next) S.a_ready(nxt);
            if constexpr (SP2) {
            PG8_LDB(B0, 0, 0); PG8_LDB(B1, 0, 1); PG8_SCHED; PG8_LDA(At, 0, 0); PG8_STAGE(PG8_SA(1, 1), a1 + hstepA, voffA);
            PG8_WAIT_V(8); PG8_WAIT_L(0); PG8_BAR; PG8_MMA(0, 0, At, B0); PG8_MMA(0, 1, At, B1); PG8_BAR; PG8_SCHED;
            PG8_LDA(At, 0, 1); PG8_STAGE(PG8_SB(0, 0), b2, voffB); PG8_STAGE(PG8_SB(0, 1), b2 + hstepB, voffB); PG8_STAGE(PG8_SA(0, 0), a2, voffA);
            PG8_WAIT_V(8); PG8_WAIT_L(0); PG8_BAR; PG8_MMA(1, 0, At, B0); PG8_MMA(1, 1, At, B1); PG8_BAR; PG8_SCHED;
            PG8_LDB(B0, 1, 0); PG8_LDB(B1, 1, 1); PG8_SCHED; PG8_LDA(At, 1, 0); PG8_STAGE(PG8_SA(0, 1), a2 + hstepA, voffA);
            PG8_WAIT_V(8); PG8_WAIT_L(0); PG8_BAR; PG8_MMA(0, 0, At, B0); PG8_MMA(0, 1, At, B1); PG8_BAR; PG8_SCHED;
            PG8_LDA(At, 1, 1); PG8_STAGE(PG8_SB(1, 0), b3, voffB); PG8_STAGE(PG8_SB(1, 1), b3 + hstepB, voffB); PG8_STAGE(PG8_SA(1, 0), a3, voffA);
            PG8_WAIT_V(8); PG8_WAIT_L(0); PG8_BAR; PG8_MMA(1, 0, At, B0); PG8_MMA(1, 1, At, B1); PG8_BAR; PG8_SCHED;
            } else {
            PG8_LDB(B0, 0, 0); PG8_SCHED; PG8_LDA(At, 0, 0); PG8_STAGE(PG8_SA(1, 1), a1 + hstepA, voffA);
            PG8_WAIT_L(8); PG8_BAR; PG8_WAIT_L(0); PG8_MMA(0, 0, At, B0); PG8_BAR; PG8_SCHED;
            PG8_LDB(B1, 0, 1); PG8_STAGE(PG8_SB(0, 0), b2, voffB);
            PG8_BAR; PG8_WAIT_L(0); PG8_MMA(0, 1, At, B1); PG8_BAR;
            PG8_LDA(At, 0, 1); PG8_STAGE(PG8_SA(0, 0), a2, voffA);
            PG8_BAR; PG8_WAIT_L(0); PG8_MMA(1, 0, At, B0); PG8_BAR; PG8_SCHED;
            PG8_STAGE(PG8_SB(0, 1), b2 + hstepB, voffB);
            PG8_WAIT_V(6); PG8_BAR; PG8_MMA(1, 1, At, B1); PG8_BAR;
            PG8_LDB(B0, 1, 0); PG8_SCHED; PG8_LDA(At, 1, 0); PG8_STAGE(PG8_SA(0, 1), a2 + hstepA, voffA);
            PG8_WAIT_L(8); PG8_BAR; PG8_WAIT_L(0); PG8_MMA(0, 0, At, B0); PG8_BAR; PG8_SCHED;
            PG8_LDB(B1, 1, 1); PG8_STAGE(PG8_SB(1, 0), b3, voffB);
            PG8_BAR; PG8_WAIT_L(0); PG8_MMA(0, 1, At, B1); PG8_BAR;
            PG8_LDA(At, 1, 1); PG8_STAGE(PG8_SA(1, 0), a3, voffA);
            PG8_BAR; PG8_WAIT_L(0); PG8_MMA(1, 0, At, B0); PG8_BAR; PG8_SCHED;
            PG8_STAGE(PG8_SB(1, 1), b3 + hstepB, voffB);
            PG8_WAIT_V(6); PG8_BAR; PG8_MMA(1, 1, At, B1); PG8_BAR;
            }
        }
        if constexpr (ALIGN_EPI) { if (wr == 0) PG8_BAR; }
        if constexpr (!Epi::AFTER_DRAIN) { E(acc, cur, wr, wc, fr, fq); S.done(cur); }
        if (!has_next) break;
#pragma unroll
        for (int a = 0; a < 2; ++a)
#pragma unroll
            for (int b = 0; b < 2; ++b)
#pragma unroll
                for (int m = 0; m < 4; ++m)
#pragma unroll
                    for (int n = 0; n < 2; ++n) acc[a][b][m][n] = (f32x4){0.f, 0.f, 0.f, 0.f};
        cur = nxt; cA = nA; cB = nB; ++ui;
        if constexpr (ALIGN_EPI) { if (wr == 1) PG8_BAR; }
    }
    PG8_WAIT_V(0);
    if constexpr (!ALIGN_EPI) { if (wr == 0) PG8_BAR; }
    PG8_BAR;
    if constexpr (Epi::AFTER_DRAIN) { E.fused(acc, cur, wr, wc, fr, fq, lds, wid, lane); S.done(cur); }
#undef PG8_KP
#undef PG8_SA
#undef PG8_SB
#undef PG8_STAGE
#undef PG8_LDA
#undef PG8_LDB
#undef PG8_MMA
#undef PG8_WAIT_V
#undef PG8_WAIT_L
#undef PG8_BAR
#undef PG8_SCHED
}
}
#define XB_TMO      128
#define XB_XCNT(j)  (256  + 64 * (j))
#define XB_XSUB(j)  (1280 + 64 * (j))
#define XB_XGEN(j)  (2304 + 64 * (j))
#define XB_TOP      3328
#define XB_TOPGEN   3392
#define XCD_BAR_WORDS 3456
#define XB_SPIN_CAP (1u << 18)

__device__ __forceinline__ unsigned xb_ld(unsigned* p)              { return __hip_atomic_load(p, __ATOMIC_RELAXED, __HIP_MEMORY_SCOPE_AGENT); }
__device__ __forceinline__ unsigned xb_add(unsigned* p, unsigned v) { return __hip_atomic_fetch_add(p, v, __ATOMIC_RELAXED, __HIP_MEMORY_SCOPE_AGENT); }
__device__ __forceinline__ unsigned xb_xcc_id() { return (unsigned)__builtin_amdgcn_s_getreg((3 << 11) | 20) & 0xFu; }
#define XB_SPIN(cond, bar) do { unsigned _sp = 0; while (cond) { __builtin_amdgcn_s_sleep(1); \
    if ((++_sp & 255u) == 0u) { if (xb_ld(&(bar)[XB_TMO])) break; if (_sp > XB_SPIN_CAP) { atomicAdd(&(bar)[XB_TMO], 1u); break; } } } } while (0)

struct XcdBarrier {
    unsigned* bar; unsigned x;
    volatile LAS unsigned* st;
};

__device__ __forceinline__ XcdBarrier xcd_barrier_post(unsigned* bar, volatile LAS unsigned* st) {
    XcdBarrier b; b.bar = bar; b.x = xb_xcc_id(); b.st = st;
    if (threadIdx.x == 0) (void)xb_add(&bar[XB_XCNT(b.x)], 1u);
    return b;
}
__device__ __forceinline__ void xcd_barrier_complete(unsigned* bar, unsigned x, unsigned& nloc, unsigned& nx) {
    const unsigned G = gridDim.x * gridDim.y * gridDim.z;
    unsigned sum, cnt, mine, sp = 0u;
    for (;;) {
        sum = 0u; cnt = 0u; mine = 0u;
#pragma unroll
        for (unsigned j = 0; j < 16; ++j) { const unsigned c = xb_ld(&bar[XB_XCNT(j)]); sum += c; cnt += (c > 0u) ? 1u : 0u; mine = (j == x) ? c : mine; }
        if (sum == G) break;
        __builtin_amdgcn_s_sleep(1);
        if ((++sp & 255u) == 0u) { if (xb_ld(&bar[XB_TMO])) break; if (sp > XB_SPIN_CAP) { atomicAdd(&bar[XB_TMO], 1u); break; } }
    }
    nloc = mine > 0u ? mine : 1u; nx = cnt > 0u ? cnt : 1u;
}

__device__ __forceinline__ void xcd_barrier(const XcdBarrier& b) {
    asm volatile("s_waitcnt vmcnt(0)" ::: "memory");
    __syncthreads();
    if (threadIdx.x == 0) {
        unsigned* bar = b.bar;
        __builtin_amdgcn_s_waitcnt(0);
        unsigned nloc = b.st[0], nx = b.st[1];
        if (nloc == 0u) { xcd_barrier_complete(bar, b.x, nloc, nx); b.st[0] = nloc; b.st[1] = nx; }
        const unsigned old = xb_add(&bar[XB_XSUB(b.x)], 1u);
        const unsigned gen = old / nloc;
        if (old + 1u == (gen + 1u) * nloc) {
            __builtin_amdgcn_fence(__ATOMIC_RELEASE, "agent");
            asm volatile("s_waitcnt vmcnt(0)" ::: "memory");
            const unsigned og = xb_add(&bar[XB_TOP], 1u);
            const unsigned tg = og / nx;
            if (og + 1u == (tg + 1u) * nx) xb_add(&bar[XB_TOPGEN], 1u);
            else XB_SPIN(xb_ld(&bar[XB_TOPGEN]) == tg, bar);
            __builtin_amdgcn_fence(__ATOMIC_ACQUIRE, "agent");
            xb_add(&bar[XB_XGEN(b.x)], 1u);
            asm volatile("s_waitcnt vmcnt(0)" ::: "memory");
        } else {
            XB_SPIN(xb_ld(&bar[XB_XGEN(b.x)]) == gen, bar);
            __builtin_amdgcn_fence(__ATOMIC_ACQUIRE, "agent");
            asm volatile("s_waitcnt vmcnt(0)" ::: "memory");
        }
    }
    __syncthreads();
}
template <int MODE> __device__ __forceinline__ int dest_row(int n) {
    if (MODE == 1) { if (n < 7680) return n; if (n < 7744) { const int i = n - 7680; return 15872 + (i < 32 ? 2 * i : 2 * (i - 32) + 1); } return n - 64; }
    if (MODE == 2) { const int h = n / 192, j = n - h * 192; if (j < 128) return n; const int i = j - 128; return h * 192 + 128 + (i < 32 ? 2 * i : 2 * (i - 32) + 1); }
    if (MODE == 3) { const int isv = n >= DFF ? 1 : 0, ch = n - isv * DFF; return (ch >> 7) * 256 + isv * 128 + (ch & 127); }
    return n;
}
template <int MODE>
__device__ __forceinline__ void tr_item(const float* W, int K, int N, const float* gk, bf16* WT, LAS unsigned* scr, int kb, int nb, int lane, int ldk = 0, int kofs = 0) {
    const int k0 = kb * 64, n0 = nb * 64;
    const float* src = W + (size_t)k0 * N + n0 + lane;
#pragma unroll
    for (int i = 0; i < 32; ++i) {
        float a = src[(size_t)(2 * i) * N], b = src[(size_t)(2 * i + 1) * N];
        if (gk) { a *= gk[k0 + 2 * i]; b *= gk[k0 + 2 * i + 1]; }
        scr[i * 65 + lane] = cvt_pk(a, b);
    }
    LDS_WAIT(); asm volatile("" ::: "memory");
    const int c = lane & 7;
#pragma unroll
    for (int j = 0; j < 8; ++j) { const int n = (lane >> 3) + 8 * j; const LAS unsigned* s = scr + (4 * c) * 65 + n;
        v4u o; o.x = s[0]; o.y = s[65]; o.z = s[130]; o.w = s[195];
        *(GAS v4u*)(WT + (size_t)dest_row<MODE>(n0 + n) * (ldk ? ldk : K) + kofs + k0 + 8 * c) = o; }
    LDS_WAIT(); asm volatile("" ::: "memory");
}

struct Ptrs {
    const float* x; const int* pos; const float* w_in; const float* b_gate; const float *lq1, *lk1, *lq2, *lk2; const float* subln_g; const float *qn_g, *kvn_g;
    const float *w_uq, *w_ukv, *w_pa, *w_pb, *w_out, *ln1_g, *ln1_b, *w_up, *conv_w, *conv_b, *w_down, *ln2_g, *ln2_b;
    float* out; unsigned char* ws;
};

__device__ __forceinline__ void p0_prologue(const Ptrs& P, LAS unsigned char* lds, int vcu, int G, int wave, int lane) {
    LAS unsigned* scr = (LAS unsigned*)(lds + wave * 8448);
    const int gw = vcu * NWAVES + wave, NGW = G * NWAVES;
    unsigned char* ws = P.ws;
    constexpr int I_IN = (IN_COLS / 64) * (DM / 64), I_UQ = (3072 / 64) * (1024 / 64), I_UKV = (4096 / 64) * (512 / 64), I_PA = (4096 / 64) * (2048 / 64), I_OUT = (4096 / 64) * (4096 / 64),
                  I_UP = (22016 / 64) * (4096 / 64), I_DN = (4096 / 64) * (DFF / 64);
    constexpr int NITEMS = I_IN + I_UQ + I_UKV + 2 * I_PA + I_OUT + I_UP + I_DN;
    for (int it = gw; it < NITEMS; it += NGW) {
        int r = it;
        if (r < I_IN)  { tr_item<1>(P.w_in, DM, IN_COLS, nullptr, (bf16*)(ws + WS_WIN), scr, r % (DM / 64), r / (DM / 64), lane); continue; } r -= I_IN;
        if (r < I_UQ)  { tr_item<2>(P.w_uq, 1024, 3072, P.qn_g, (bf16*)(ws + WS_WUQ), scr, r % 16, r / 16, lane); continue; } r -= I_UQ;
        if (r < I_UKV) { tr_item<0>(P.w_ukv, 512, 4096, P.kvn_g, (bf16*)(ws + WS_WUKV), scr, r % 8, r / 8, lane); continue; } r -= I_UKV;
        if (r < I_PA)  { tr_item<0>(P.w_pa, 2048, 4096, nullptr, (bf16*)(ws + WS_WPA), scr, r % 32, r / 32, lane, 4096, 0); continue; } r -= I_PA;
        if (r < I_PA)  { tr_item<0>(P.w_pb, 2048, 4096, nullptr, (bf16*)(ws + WS_WPA), scr, r % 32, r / 32, lane, 4096, 2048); continue; } r -= I_PA;
        if (r < I_OUT) { tr_item<0>(P.w_out, 4096, 4096, nullptr, (bf16*)(ws + WS_WOUT), scr, r % 64, r / 64, lane); continue; } r -= I_OUT;
        if (r < I_UP)  { tr_item<3>(P.w_up, 4096, 22016, nullptr, (bf16*)(ws + WS_WUP), scr, r % 64, r / 64, lane); continue; } r -= I_UP;
        tr_item<0>(P.w_down, DFF, 4096, nullptr, (bf16*)(ws + WS_WDN), scr, r % (DFF / 64), r / (DFF / 64), lane);
    }
    { const size_t n8 = (size_t)M * DM / 8; GAS v4u* xb = (GAS v4u*)(ws + WS_XB);
      for (size_t i = (size_t)gw * 64 + lane; i < n8; i += (size_t)NGW * 64) { const f32x4 a = *(const GAS f32x4*)(P.x + i * 8), b = *(const GAS f32x4*)(P.x + i * 8 + 4);
          v4u o; o.x = cvt_pk(a[0], a[1]); o.y = cvt_pk(a[2], a[3]); o.z = cvt_pk(b[0], b[1]); o.w = cvt_pk(b[2], b[3]); xb[i] = o; } }
    { GAS v4u* z = (GAS v4u*)(ws + WS_WIN + (size_t)IN_COLS * DM * 2); const size_t nz = (size_t)(N1 - IN_COLS) * DM * 2 / 16;
      for (size_t i = (size_t)gw * 64 + lane; i < nz; i += (size_t)NGW * 64) z[i] = (v4u){0u, 0u, 0u, 0u};
    }
    { GAS float* rt = (GAS float*)(ws + WS_ROPE);
      for (int i = gw * 64 + lane; i < M * 32; i += NGW * 64) { const int m = i >> 5, k = i & 31;
          const double inv = exp2(-(double)k * (13.287712379549449 / 32.0));
          const double rev = (double)P.pos[m] * inv * 0.15915494309189535;
          const float fr = (float)(rev - rint(rev));
          rt[(size_t)m * 64 + k] = __builtin_amdgcn_cosf(fr); rt[(size_t)m * 64 + 32 + k] = __builtin_amdgcn_sinf(fr); } }
}

namespace att {
__device__ __forceinline__ void glds16(const void* sbase, unsigned voff, unsigned lds_dst) {
    unsigned keep;
    asm volatile("s_mov_b32 %0, m0\n\ts_mov_b32 m0, %3\n\ts_nop 0\n\tglobal_load_lds_dwordx4 %1, %2\n\ts_mov_b32 m0, %0" : "=&s"(keep) : "v"(voff), "s"(sbase), "s"(lds_dst) : "memory");
}
__device__ __forceinline__ int v_rd_base(int lane) { return ((lane & 3) << 3) | (((lane >> 2) & 3) << 6) | (((lane >> 4) & 1) << 5) | (((lane >> 5) & 1) << 8); }
#define ATT_BAR() asm volatile("s_barrier" ::: "memory")

template <int DQK, int DV, bool ALIBI>
__device__ __forceinline__ void attn_block(LAS unsigned char* lds, const unsigned char* wsb, const bf16* Q, int ldq, unsigned kofs, unsigned ldkB, unsigned vofs, unsigned ldvB,
                                           int qb, float slope2, f32x16 (&o)[DV / 32], float& l_out) {
    constexpr int NQF = DQK / 16, NOD = DV / 32, KROW = DQK * 2, KT = 64 * KROW, VT = 64 * DV * 2, KCH = DQK / 8, NKI = KT / 8192, NVI = VT / 8192;
    const int tid = threadIdx.x, wid = __builtin_amdgcn_readfirstlane(tid >> 6), lane = tid & 63, r32 = lane & 31, hi = lane >> 5;
    const unsigned ldsb = (unsigned)(uintptr_t)lds;
    __builtin_assume(qb >= 0); __builtin_assume(qb < 32);
    const int NT = 4 * (qb + 1);
    constexpr bool KEEP = (DV == 128);
#define KSW(cs_, row_) (DQK == 128 ? ((cs_) ^ ((row_) & 15)) : (((cs_) & ~7) | (((cs_) ^ ((row_) >> 1)) & 7)))
    unsigned krel[NKI], vrel[NVI];
    if (KEEP) {
#pragma unroll
        for (int j = 0; j < NKI; ++j) { const int p = (j * 8 + wid) * 64 + lane, row = p / KCH, cs = p - row * KCH, c = KSW(cs, row); krel[j] = kofs + (unsigned)row * ldkB + (unsigned)c * 16u; }
#pragma unroll
        for (int j = 0; j < NVI; ++j) { const int p = (j * 8 + wid) * 64 + lane, s = p >> 5, rr = (p & 31) >> 2, cc = p & 3, kg = s / NOD, d0 = s - kg * NOD, kk = kg * 8 + rr;
            const int key = (kk & ~0xC) | ((kk & 4) << 1) | ((kk & 8) >> 1); vrel[j] = vofs + (unsigned)key * ldvB + (unsigned)(d0 * 32 + cc * 8) * 2u; }
    }
#define ATT_ISSUE(t_, bf_) do { if (KEEP) { const unsigned kb_ = (unsigned)(t_) * 64u; \
        _Pragma("unroll") for (int j = 0; j < NKI; ++j) glds16(wsb, krel[j] + kb_ * ldkB, (unsigned)__builtin_amdgcn_readfirstlane(ldsb + (bf_) * KT + (j * 8 + wid) * 1024)); \
        _Pragma("unroll") for (int j = 0; j < NVI; ++j) glds16(wsb, vrel[j] + kb_ * ldvB, (unsigned)__builtin_amdgcn_readfirstlane(ldsb + 2 * KT + (bf_) * VT + (j * 8 + wid) * 1024)); } else ATT_ISSUE_RC(t_, bf_); } while (0)
#define ATT_ISSUE_RC(t_, bf_) do { const unsigned kb_ = (unsigned)(t_) * 64u; int ln_ = lane; asm volatile("" : "+v"(ln_)); \
        _Pragma("unroll") for (int j = 0; j < NKI; ++j) { const int p = (j * 8 + wid) * 64 + ln_, row = p / KCH, cs = p - row * KCH, c = KSW(cs, row); \
            glds16(wsb, kofs + ((unsigned)row + kb_) * ldkB + (unsigned)c * 16u, (unsigned)__builtin_amdgcn_readfirstlane(ldsb + (bf_) * KT + (j * 8 + wid) * 1024)); } \
        _Pragma("unroll") for (int j = 0; j < NVI; ++j) { const int p = (j * 8 + wid) * 64 + ln_, s = p >> 5, rr = (p & 31) >> 2, cc = p & 3, kg = s / NOD, d0 = s - kg * NOD, kk = kg * 8 + rr; \
            const int key = (kk & ~0xC) | ((kk & 4) << 1) | ((kk & 8) >> 1); \
            glds16(wsb, vofs + ((unsigned)key + kb_) * ldvB + (unsigned)(d0 * 32 + cc * 8) * 2u, (unsigned)__builtin_amdgcn_readfirstlane(ldsb + 2 * KT + (bf_) * VT + (j * 8 + wid) * 1024)); } } while (0)
    ATT_BAR();
    ATT_ISSUE(NT - 1, 0);
    bf16x8 qr[NQF];
#pragma unroll
    for (int d0 = 0; d0 < NQF; ++d0) qr[d0] = *(const bf16x8*)(Q + (size_t)(wid * 32 + r32) * ldq + d0 * 16 + hi * 8);
    float m_reg = -1e30f, l_reg = 0.f;
#pragma unroll
    for (int d0 = 0; d0 < NOD; ++d0)
#pragma unroll
        for (int r = 0; r < 16; ++r) o[d0][r] = 0.f;
    const int qi = qb * 256 + wid * 32 + r32;
    asm volatile(".p2align 6");
    for (int i = 0; i < NT; ++i) {
        const int t = NT - 1 - i, bf = i & 1;
        asm volatile("s_waitcnt vmcnt(0)\n\ts_barrier" ::: "memory");
        if (i + 1 < NT) ATT_ISSUE(t - 1, bf ^ 1);
        const int jb = t - 4 * qb;
        if (jb > (wid >> 1)) continue;
        f32x16 p0, p1;
        if (ALIBI) {
            float s2o = slope2; asm volatile("" : "+v"(s2o));
            const float h4 = s2o * (float)(4 * hi);
#pragma unroll
            for (int r = 0; r < 16; ++r) { const float cr = (float)((r & 3) + 8 * (r >> 2)); p0[r] = __builtin_fmaf(s2o, cr, h4); p1[r] = __builtin_fmaf(s2o, cr + 32.f, h4); }
        } else {
#pragma unroll
            for (int r = 0; r < 16; ++r) { p0[r] = 0.f; p1[r] = 0.f; }
        }
        { const LAS unsigned char* kt = lds + bf * KT + r32 * KROW;
          const LAS unsigned char* kb4[4];
          const int key = DQK == 128 ? r32 : (r32 >> 1), hb = DQK == 128 ? ((r32 >> 3) & 1) : 0;
#pragma unroll
          for (int dd = 0; dd < 4; ++dd) kb4[dd] = kt + ((((dd * 2 + hi) ^ key) & 7) << 4) + hb * 128;
#define ATT_KADDR(d0_) (DQK == 128 ? kb4[(d0_) & 3] + (((d0_) >> 2) ? 128 - 256 * hb : 0) : kb4[(d0_) & 3] + ((d0_) >> 2) * 128)
          constexpr int PFD = (DV == 128) ? 2 : 0;
          bf16x8 kf[PFD + 1][2];
#pragma unroll
          for (int d0 = 0; d0 < PFD; ++d0) { const LAS unsigned char* a = ATT_KADDR(d0); kf[d0][0] = *(const LAS bf16x8*)a; kf[d0][1] = *(const LAS bf16x8*)(a + 32 * KROW); }
#pragma unroll
          for (int d0 = 0; d0 < NQF; ++d0) {
              if (d0 + PFD < NQF) { const LAS unsigned char* a = ATT_KADDR(d0 + PFD); kf[(d0 + PFD) % (PFD + 1)][0] = *(const LAS bf16x8*)a; kf[(d0 + PFD) % (PFD + 1)][1] = *(const LAS bf16x8*)(a + 32 * KROW); }
              if (PFD) __builtin_amdgcn_sched_barrier(0);
              p0 = __builtin_amdgcn_mfma_f32_32x32x16_bf16(kf[d0 % (PFD + 1)][0], qr[d0], p0, 0, 0, 0);
              p1 = __builtin_amdgcn_mfma_f32_32x32x16_bf16(kf[d0 % (PFD + 1)][1], qr[d0], p1, 0, 0, 0);
              if (PFD) __builtin_amdgcn_sched_barrier(0); }
#undef ATT_KADDR
        }
        __builtin_amdgcn_sched_barrier(0);
        const int kb = t * 64;
        float bq = 0.f;
        if (ALIBI) bq = slope2 * (float)(kb - qi);
        if (jb == (wid >> 1)) { const int dq = qi - kb - 4 * hi; const float NEG = -__builtin_inff();
#pragma unroll
            for (int r = 0; r < 16; ++r) { const int c = (r & 3) + 8 * (r >> 2); if (c > dq) p0[r] = NEG; if (c + 32 > dq) p1[r] = NEG; } }
        float pmax = p0[0];
#pragma unroll
        for (int r = 1; r < 16; ++r) pmax = fmaxf(pmax, p0[r]);
#pragma unroll
        for (int r = 0; r < 16; ++r) pmax = fmaxf(pmax, p1[r]);
        { auto rr = __builtin_amdgcn_permlane32_swap(__float_as_uint(pmax), __float_as_uint(pmax), false, false); pmax = fmaxf(__uint_as_float(rr[0]), __uint_as_float(rr[1])); }
        const float mx = pmax + bq;
        float alpha = 1.f;
        if (!__all(mx - m_reg <= 8.f)) { const float mn = fmaxf(m_reg, mx); alpha = __builtin_amdgcn_exp2f(m_reg - mn); m_reg = mn;
#pragma unroll
            for (int d0 = 0; d0 < NOD; ++d0)
#pragma unroll
                for (int r = 0; r < 16; ++r) o[d0][r] *= alpha; }
        const float ms = m_reg - bq;
        float ps = 0.f;
#pragma unroll
        for (int r = 0; r < 16; ++r) { p0[r] = __builtin_amdgcn_exp2f(p0[r] - ms); ps += p0[r]; }
#pragma unroll
        for (int r = 0; r < 16; ++r) { p1[r] = __builtin_amdgcn_exp2f(p1[r] - ms); ps += p1[r]; }
        { auto rr = __builtin_amdgcn_permlane32_swap(__float_as_uint(ps), __float_as_uint(ps), false, false); ps = __uint_as_float(rr[0]) + __uint_as_float(rr[1]); }
        l_reg = l_reg * alpha + ps;
        bf16x8 pa0, pa1, pa2, pa3;
#define ATT_PK4(P, B_, OUT) do { const unsigned a0 = cvt_pk(P[B_ + 0], P[B_ + 1]), a1 = cvt_pk(P[B_ + 2], P[B_ + 3]), b0 = cvt_pk(P[B_ + 4], P[B_ + 5]), b1 = cvt_pk(P[B_ + 6], P[B_ + 7]); \
        auto r0 = __builtin_amdgcn_permlane32_swap(a0, b0, false, false); auto r1 = __builtin_amdgcn_permlane32_swap(a1, b1, false, false); \
        v4u w = {r0[0], r1[0], r0[1], r1[1]}; OUT = __builtin_bit_cast(bf16x8, w); } while (0)
        ATT_PK4(p0, 0, pa0); ATT_PK4(p0, 8, pa1); ATT_PK4(p1, 0, pa2); ATT_PK4(p1, 8, pa3);
#undef ATT_PK4
        __builtin_amdgcn_sched_barrier(0);
        { const unsigned vb0 = ldsb + 2 * KT + bf * VT + v_rd_base(lane);
#define ATT_TRRD(dst, off) asm volatile("ds_read_b64_tr_b16 %0, %1 offset:%2" : "=&v"(dst) : "v"(vb0), "i"(off) : "memory")
#pragma unroll
          for (int d0 = 0; d0 < NOD; ++d0) { s16x4 l0, l1, l2, l3, h0, h1, h2, h3;
              ATT_TRRD(l0, (0 * NOD + d0) * 512); ATT_TRRD(h0, (1 * NOD + d0) * 512); ATT_TRRD(l1, (2 * NOD + d0) * 512); ATT_TRRD(h1, (3 * NOD + d0) * 512);
              ATT_TRRD(l2, (4 * NOD + d0) * 512); ATT_TRRD(h2, (5 * NOD + d0) * 512); ATT_TRRD(l3, (6 * NOD + d0) * 512); ATT_TRRD(h3, (7 * NOD + d0) * 512);
              asm volatile("s_waitcnt lgkmcnt(0)" ::: "memory"); __builtin_amdgcn_sched_barrier(0);
              o[d0] = __builtin_amdgcn_mfma_f32_32x32x16_bf16((bf16x8){l0[0], l0[1], l0[2], l0[3], h0[0], h0[1], h0[2], h0[3]}, pa0, o[d0], 0, 0, 0);
              o[d0] = __builtin_amdgcn_mfma_f32_32x32x16_bf16((bf16x8){l1[0], l1[1], l1[2], l1[3], h1[0], h1[1], h1[2], h1[3]}, pa1, o[d0], 0, 0, 0);
              o[d0] = __builtin_amdgcn_mfma_f32_32x32x16_bf16((bf16x8){l2[0], l2[1], l2[2], l2[3], h2[0], h2[1], h2[2], h2[3]}, pa2, o[d0], 0, 0, 0);
              o[d0] = __builtin_amdgcn_mfma_f32_32x32x16_bf16((bf16x8){l3[0], l3[1], l3[2], l3[3], h3[0], h3[1], h3[2], h3[3]}, pa3, o[d0], 0, 0, 0); }
#undef ATT_TRRD
        }
    }
#undef ATT_ISSUE
#undef ATT_ISSUE_RC
#undef KSW
    l_out = l_reg;
}

#define ATT_ST_PAIR(row_, colg_, A_, B_) do { v2u a_ = (A_), b_ = (B_); \
        auto rx_ = __builtin_amdgcn_permlane32_swap(a_.x, b_.x, false, false); auto ry_ = __builtin_amdgcn_permlane32_swap(a_.y, b_.y, false, false); \
        *(v4u*)((row_) + (colg_) + 8 * hi) = (v4u){rx_[0], ry_[0], rx_[1], ry_[1]}; } while (0)
constexpr int CW_ATTQ = 8192, CW_NMAX = 12288;
__device__ __forceinline__ void attn_phase(const Ptrs& P, LAS unsigned char* lds, volatile LAS unsigned* MISC, gu32* ctl, int qoff) {
    const int tid = threadIdx.x, wid = __builtin_amdgcn_readfirstlane(tid >> 6), lane = tid & 63, r32 = lane & 31, hi = lane >> 5;
    unsigned char* ws = P.ws;
    const bf16* QKV = (const bf16*)(ws + WS_QKV); const bf16* QB = (const bf16*)(ws + WS_QB); bf16* OAB = (bf16*)(ws + WS_OAB);
    float lam;
    { const float s1 = wave_sum(P.lq1[lane] * P.lk1[lane] + P.lq1[lane + 64] * P.lk1[lane + 64]), s2 = wave_sum(P.lq2[lane] * P.lk2[lane] + P.lq2[lane + 64] * P.lk2[lane + 64]);
      lam = expf(s1) - expf(s2) + LAMBDA_INIT; }
    const int q0 = (int)(xb_xcc_id() & 7u);
    if (tid < 64) MISC[64 + tid] = 0u;
    __syncthreads();
    { const int w = tid & 63; unsigned mx = 0u; const GAS unsigned* part = (const GAS unsigned*)(ws + WS_NPART);
      for (int g = tid >> 6; g < (int)gridDim.x; g += 8) { const unsigned v = part[g * 64 + w]; mx = v > mx ? v : mx; }
      __hip_atomic_fetch_max((LAS unsigned*)(MISC + 64 + w), mx, __ATOMIC_RELAXED, __HIP_MEMORY_SCOPE_WORKGROUP); }
    __syncthreads();
    if (tid < 32) { const int b = tid >> 4, h = (tid >> 1) & 7, map = tid & 1;
        const float nq = __uint_as_float(MISC[64 + (b * 16 + h * 2 + map) * 2]), nk = __uint_as_float(MISC[64 + (b * 16 + h * 2 + map) * 2 + 1]);
        const float slope2 = LOG2E * exp2f(-(float)(h + 1));
        const float B = sqrtf(nq * nk) * 1.001f + 0.01f, Wf = (2.f * B + 126.f) / slope2;
        const float wq = ceilf(Wf * (1.0001f / 256.f) + 0.001f);
        MISC[32 + tid] = wq < 1000.f ? (unsigned)wq : 1000u; }
    __syncthreads();
    for (int dq = 0; dq < 8; ++dq) {
        const int q = (q0 + dq) & 7, b = q >> 2, qx = q & 3;
        for (;;) {
            if (tid == 0) MISC[16] = __hip_atomic_fetch_add((unsigned*)(ctl + CW_ATTQ + qoff + 64 * q), 1u, __ATOMIC_RELAXED, __HIP_MEMORY_SCOPE_AGENT);
            __syncthreads();
            const int n = (int)__builtin_amdgcn_readfirstlane(MISC[16]);
            __syncthreads();
            if (n >= 64) break;
            const int h = (n < 32) ? 7 - qx : qx, qb = 31 - (n & 31);
            const float slope2 = LOG2E * exp2f(-(float)(h + 1));
            unsigned char* scrb = ws + WS_O0 + (size_t)blockIdx.x * 262144 + (size_t)wid * 32768;
            const size_t rowq = (size_t)b * SEQ + (size_t)qb * 256;
#pragma unroll 1
            for (int map = 0; map < 2; ++map) {
                int qs = qb - (int)MISC[32 + (b * 8 + h) * 2 + map]; qs = __builtin_amdgcn_readfirstlane(qs > 0 ? qs : 0);
                f32x16 o[8]; float l;
                attn_block<128, 256, true>(lds, ws, QKV + rowq * 6144 + h * 256 + map * 128, 6144,
                                           (unsigned)(WS_QKV + (((size_t)b * SEQ + (size_t)qs * 256) * 6144 + 2048 + h * 256 + map * 128) * 2), 12288u,
                                           (unsigned)(WS_QKV + (((size_t)b * SEQ + (size_t)qs * 256) * 6144 + 4096 + h * 256) * 2), 12288u, qb - qs, slope2, o, l);
                const float inv = 1.f / l;
                unsigned so = (unsigned)lane * 16u; asm volatile("" : "+v"(so));
                f32x4* scr = (f32x4*)(scrb + so);
                if (map == 0) {
#pragma unroll
                    for (int d0 = 0; d0 < 8; ++d0)
#pragma unroll
                        for (int g = 0; g < 4; ++g) scr[(d0 * 4 + g) * 64] = (f32x4){o[d0][4 * g] * inv, o[d0][4 * g + 1] * inv, o[d0][4 * g + 2] * inv, o[d0][4 * g + 3] * inv};
                } else {
                    const float li = lam * inv; float ss = 0.f;
#pragma unroll
                    for (int d0 = 0; d0 < 8; ++d0) {
#pragma unroll
                        for (int g = 0; g < 4; ++g) { const f32x4 a = scr[(d0 * 4 + g) * 64];
#pragma unroll
                            for (int e = 0; e < 4; ++e) { const float v = a[e] - li * o[d0][4 * g + e]; ss += v * v; } }
                        asm volatile("" : "+v"(ss) :: "memory"); }
                    { auto rr = __builtin_amdgcn_permlane32_swap(__float_as_uint(ss), __float_as_uint(ss), false, false); ss = __uint_as_float(rr[0]) + __uint_as_float(rr[1]); }
                    const float rs = __builtin_amdgcn_rsqf(ss * (1.f / 256.f) + RMS_EPS) * (1.f - LAMBDA_INIT);
                    unsigned oo = (unsigned)((wid * 32 + r32) * 4096) * 2u; asm volatile("" : "+v"(oo));
                    bf16* orow = (bf16*)((unsigned char*)(OAB + rowq * 4096 + h * 256) + oo);
#pragma unroll
                    for (int d0 = 0; d0 < 8; ++d0) {
#pragma unroll
                        for (int g = 0; g < 4; g += 2) { v2u w[2];
#pragma unroll
                            for (int q = 0; q < 2; ++q) { const f32x4 a = scr[(d0 * 4 + g + q) * 64]; const f32x4 gg = *(const f32x4*)(P.subln_g + d0 * 32 + 8 * (g + q) + 4 * hi);
                                float v[4];
#pragma unroll
                                for (int e = 0; e < 4; ++e) v[e] = (a[e] - li * o[d0][4 * (g + q) + e]) * rs * gg[e];
                                w[q].x = cvt_pk(v[0], v[1]); w[q].y = cvt_pk(v[2], v[3]); }
                            ATT_ST_PAIR(orow, d0 * 32 + 8 * g, w[0], w[1]); }
                        asm volatile("" ::: "memory"); }
                }
            }
        }
    }
    for (int dq = 0; dq < 8; ++dq) {
        const int q = (q0 + dq) & 7, b = q >> 2, qx = q & 3;
        for (;;) {
            if (tid == 0) MISC[16] = __hip_atomic_fetch_add((unsigned*)(ctl + CW_ATTQ + qoff + 64 * (8 + q)), 1u, __ATOMIC_RELAXED, __HIP_MEMORY_SCOPE_AGENT);
            __syncthreads();
            const int n = (int)__builtin_amdgcn_readfirstlane(MISC[16]);
            __syncthreads();
            if (n >= 128) break;
            const int h = 4 * qx + (n & 3), qb = 31 - (n >> 2);
            const size_t rowq = (size_t)b * SEQ + (size_t)qb * 256;
            f32x16 o[4]; float l;
            const unsigned kofs = (unsigned)(WS_KVB + ((size_t)b * SEQ * KVLD + h * 320) * 2);
            attn_block<192, 128, false>(lds, ws, QB + rowq * 3072 + h * 192, 3072, kofs, (unsigned)(KVLD * 2), kofs + 384u, (unsigned)(KVLD * 2), qb, 0.f, o, l);
            const float inv = 1.f / l;
            unsigned oo = (unsigned)((wid * 32 + r32) * 4096) * 2u; asm volatile("" : "+v"(oo));
            bf16* orow = (bf16*)((unsigned char*)(OAB + rowq * 4096 + 2048 + h * 128) + oo);
#pragma unroll
            for (int d0 = 0; d0 < 4; ++d0)
#pragma unroll
                for (int g = 0; g < 4; g += 2) { v2u w0, w1;
                    w0.x = cvt_pk(o[d0][4 * g] * inv, o[d0][4 * g + 1] * inv); w0.y = cvt_pk(o[d0][4 * g + 2] * inv, o[d0][4 * g + 3] * inv);
                    w1.x = cvt_pk(o[d0][4 * g + 4] * inv, o[d0][4 * g + 5] * inv); w1.y = cvt_pk(o[d0][4 * g + 6] * inv, o[d0][4 * g + 7] * inv);
                    ATT_ST_PAIR(orow, d0 * 32 + 8 * g, w0, w1); }
        }
    }
}
}

__device__ __forceinline__ void rowss_phase(const bf16* LAT, float* rowss, int gw, int NGW, int lane) {
    for (int m = gw; m < M; m += NGW) {
        const GAS v4u* r = (const GAS v4u*)(LAT + (size_t)m * 1536) + lane;
        float sq = 0.f, sk = 0.f;
#pragma unroll
        for (int j = 0; j < 3; ++j) { const v4u w = r[64 * j]; f32x4 a, b; pg8::unpack8(w, a, b);
            const float t = (a[0] * a[0] + a[1] * a[1]) + (a[2] * a[2] + a[3] * a[3]) + (b[0] * b[0] + b[1] * b[1]) + (b[2] * b[2] + b[3] * b[3]);
            if (j < 2) sq += t; else sk += t; }
        sq = wave_sum(sq); sk = wave_sum(sk);
        if (lane == 0) { rowss[m] = sq; rowss[M + m] = sk; }
    }
}
__device__ __forceinline__ void normmax_phase(const bf16* QKV, volatile LAS unsigned* nmax  , int gw, int NGW, int lane) {
    float mq[4] = {0.f, 0.f, 0.f, 0.f}, mk[4] = {0.f, 0.f, 0.f, 0.f}; int cur_b = -1;
    for (int m = gw; ; m += NGW) {
        const int b = m < M ? m / SEQ : -2;
        if (b != cur_b) {
            if (cur_b >= 0 && (lane & 15) == 0) {
#pragma unroll
                for (int j = 0; j < 4; ++j) { const int v = j * 4 + (lane >> 4);
                    __hip_atomic_fetch_max((LAS unsigned*)(nmax + (cur_b * 16 + v) * 2), __float_as_uint(mq[j]), __ATOMIC_RELAXED, __HIP_MEMORY_SCOPE_WORKGROUP);
                    __hip_atomic_fetch_max((LAS unsigned*)(nmax + (cur_b * 16 + v) * 2 + 1), __float_as_uint(mk[j]), __ATOMIC_RELAXED, __HIP_MEMORY_SCOPE_WORKGROUP); } }
#pragma unroll
            for (int j = 0; j < 4; ++j) { mq[j] = 0.f; mk[j] = 0.f; }
            cur_b = b;
        }
        if (m >= M) break;
        const GAS v4u* rq = (const GAS v4u*)(QKV + (size_t)m * 6144) + lane;
#pragma unroll
        for (int j = 0; j < 4; ++j) {
            f32x4 a, c; pg8::unpack8(rq[64 * j], a, c);
            float tq = (a[0] * a[0] + a[1] * a[1]) + (a[2] * a[2] + a[3] * a[3]) + (c[0] * c[0] + c[1] * c[1]) + (c[2] * c[2] + c[3] * c[3]);
            pg8::unpack8(rq[256 + 64 * j], a, c);
            float tk = (a[0] * a[0] + a[1] * a[1]) + (a[2] * a[2] + a[3] * a[3]) + (c[0] * c[0] + c[1] * c[1]) + (c[2] * c[2] + c[3] * c[3]);
#pragma unroll
            for (int o = 1; o < 16; o <<= 1) { tq += __shfl_xor(tq, o); tk += __shfl_xor(tk, o); }
            mq[j] = fmaxf(mq[j], tq); mk[j] = fmaxf(mk[j], tk);
        }
    }
}
__device__ __forceinline__ void ln_phase(const bf16* in, const float* g, const float* bta, float* of, bf16* ob, float* stat  , int gw, int NGW, int lane) {
    for (int m = gw; m < M; m += NGW) {
        GAS const v4u* xr = (GAS const v4u*)(in + (size_t)m * DM) + lane;
        f32x4 v[8][2]; float s = 0.f;
#pragma unroll
        for (int j = 0; j < 8; ++j) { const v4u w = xr[64 * j]; pg8::unpack8h(w, v[j][0], v[j][1]);
            s += ((v[j][0][0] + v[j][0][1]) + (v[j][0][2] + v[j][0][3])) + ((v[j][1][0] + v[j][1][1]) + (v[j][1][2] + v[j][1][3])); }
        const float mean = wave_sum(s) * (1.f / DM); float s2 = 0.f;
#pragma unroll
        for (int j = 0; j < 8; ++j)
#pragma unroll
            for (int h = 0; h < 2; ++h) { v[j][h] = v[j][h] - mean; s2 += (v[j][h][0] * v[j][h][0] + v[j][h][1] * v[j][h][1]) + (v[j][h][2] * v[j][h][2] + v[j][h][3] * v[j][h][3]); }
        const float rstd = 1.f / sqrtf(wave_sum(s2) * (1.f / DM) + LN_EPS);
        if (stat && lane == 0) { stat[m] = mean; stat[M + m] = rstd; }
#pragma unroll
        for (int j = 0; j < 8; ++j) { const int c = 8 * lane + 512 * j;
            const f32x4 y0 = v[j][0] * rstd * *(const f32x4*)(g + c) + *(const f32x4*)(bta + c), y1 = v[j][1] * rstd * *(const f32x4*)(g + c + 4) + *(const f32x4*)(bta + c + 4);
            if (of) { GAS f32x4* o = (GAS f32x4*)(of + (size_t)m * DM + c); o[0] = y0; o[1] = y1; }
            if (ob) *((GAS v4u*)(ob + (size_t)m * DM + c)) = pg8::pack8(y0, y1); }
    }
}
__device__ __forceinline__ void conv_fix_phase(const bf16* SIDE, const float* cw, const float* cb, bf16* ACT, int gw, int NGW, int lane) {
    constexpr int NCG = (DFF + 511) / 512, NCH = M / 64;
    for (int it = gw; it < NCG * NCH; it += NGW) {
        const int cg = it % NCG, c = it / NCG, ch = cg * 512 + lane * 8;
        if (ch >= DFF) continue;
        const bool first = (c % (SEQ / 64)) == 0;
        f32x4 u[4][2][2];
#pragma unroll
        for (int j = 0; j < 4; ++j)
#pragma unroll
            for (int gv = 0; gv < 2; ++gv) {
                if (j < 2 && first) { u[j][gv][0] = (f32x4){0.f, 0.f, 0.f, 0.f}; u[j][gv][1] = (f32x4){0.f, 0.f, 0.f, 0.f}; }
                else { const int cc = j < 2 ? c - 1 : c, jj = j < 2 ? j + 2 : j - 2;
                    pg8::unpack8(*(const v4u*)(SIDE + ((size_t)(cc * 4 + jj) * 2 + gv) * DFF + ch), u[j][gv][0], u[j][gv][1]); } }
#pragma unroll
        for (int r = 0; r < 2; ++r) {
            float o[8];
#pragma unroll
            for (int e = 0; e < 8; ++e) {
                const int h = e >> 2, q = e & 3;
                const float cgate = cb[ch + e] + cw[ch + e] * u[r][0][h][q] + cw[(size_t)2 * DFF + ch + e] * u[r + 1][0][h][q] + cw[(size_t)4 * DFF + ch + e] * u[r + 2][0][h][q];
                const float cval = cb[DFF + ch + e] + cw[DFF + ch + e] * u[r][1][h][q] + cw[(size_t)3 * DFF + ch + e] * u[r + 1][1][h][q] + cw[(size_t)5 * DFF + ch + e] * u[r + 2][1][h][q];
                o[e] = cgate * pg8::sigmoidf_(cgate) * cval;
            }
            v4u w; w.x = cvt_pk(o[0], o[1]); w.y = cvt_pk(o[2], o[3]); w.z = cvt_pk(o[4], o[5]); w.w = cvt_pk(o[6], o[7]);
            *(v4u*)(ACT + (size_t)(c * 64 + r) * DFF + ch) = w;
        }
    }
}

struct Args { const void* in[24]; float* out; unsigned char* ws; int ph_lo, ph_hi, li, pad; };
constexpr int N_PHASES = 11;
__global__ void __launch_bounds__(NWAVES * 64, 2) mk_fwd(Args args) {
    extern __shared__ __attribute__((aligned(16))) unsigned char lds_raw[];
    LAS unsigned char* lds = (LAS unsigned char*)lds_raw;
    volatile LAS unsigned* MISC = (volatile LAS unsigned*)(lds + MISC_OFF);
    const int tid = threadIdx.x, lane = tid & 63, wave = __builtin_amdgcn_readfirstlane(tid >> 6);
    const int G = gridDim.x; const int bx = blockIdx.x; const int vcu = (G % 8 == 0) ? (bx % 8) * (G / 8) + bx / 8 : bx;
    Ptrs P;
    P.x = (const float*)args.in[0]; P.pos = (const int*)args.in[1]; P.w_in = (const float*)args.in[2]; P.b_gate = (const float*)args.in[3];
    P.lq1 = (const float*)args.in[4]; P.lk1 = (const float*)args.in[5]; P.lq2 = (const float*)args.in[6]; P.lk2 = (const float*)args.in[7];
    P.subln_g = (const float*)args.in[8]; P.qn_g = (const float*)args.in[9]; P.kvn_g = (const float*)args.in[10];
    P.w_uq = (const float*)args.in[11]; P.w_ukv = (const float*)args.in[12]; P.w_pa = (const float*)args.in[13]; P.w_pb = (const float*)args.in[14]; P.w_out = (const float*)args.in[15];
    P.ln1_g = (const float*)args.in[16]; P.ln1_b = (const float*)args.in[17]; P.w_up = (const float*)args.in[18]; P.conv_w = (const float*)args.in[19]; P.conv_b = (const float*)args.in[20];
    P.w_down = (const float*)args.in[21]; P.ln2_g = (const float*)args.in[22]; P.ln2_b = (const float*)args.in[23];
    P.out = args.out; P.ws = args.ws;
    unsigned char* ws = args.ws;
    gu32* ctl = (gu32*)(ws + WS_CTL);
    for (int u = tid; u < (LDS_BYTES - LDSCTL_OFF) / 4; u += NWAVES * 64) ((LAS unsigned*)(lds + LDSCTL_OFF))[u] = 0u;
    __syncthreads();
    XcdBarrier bar = xcd_barrier_post((unsigned*)(ctl + 4096) + args.li * XCD_BAR_WORDS, MISC + 8);
    const int lo = args.ph_lo, hi = args.ph_hi;
#define IN(k) (lo <= (k) && (k) < hi)
#define SEAM(k) do { if (IN(k) && IN((k) + 1)) xcd_barrier(bar); } while (0)
#define SEAM2B() do { if (IN(2)) xcd_barrier(bar); } while (0)
    const int gw = vcu * NWAVES + wave, NGW = G * NWAVES;
    typedef pg8::bf16_t bt;
    const int xcd_rot = bx & 7;
#define KOFF(K_) ((((K_) / 64) * xcd_rot / 8) & ~1)

#define PH_ALIGN(n) asm volatile(".p2align 8\n\t.rept %0\n\ts_nop 0\n\t.endr" :: "n"(n))
    if (IN(0)) { p0_prologue(P, lds, vcu, G, wave, lane); } SEAM(0);

    if (IN(1)) {
        PH_ALIGN(0);
        pg8::Gemm g{(const bt*)(ws + WS_XB), (const bt*)(ws + WS_WIN), M, N1, DM, DM, DM, KOFF(DM)}; pg8::StaticOrder S; S.init(M, N1, G, bx);
        pg8::EpiIn E{(bt*)(ws + WS_QKV), (bt*)(ws + WS_LAT), (bt*)(ws + WS_G), (bt*)(ws + WS_KVB), (float*)(ws + WS_ROWSS), P.b_gate, (const float*)(ws + WS_ROPE), C2A, M};
        pg8::gemm_phase<pg8::EpiIn, pg8::StaticOrder, true, true>(lds, g, S, E);
    } SEAM(1);

    if (IN(2)) {
        if (tid < 64) MISC[64 + tid] = 0u;
        __syncthreads();
        rowss_phase((const bf16*)(ws + WS_LAT), (float*)(ws + WS_ROWSS), gw, NGW, lane);
        normmax_phase((const bf16*)(ws + WS_QKV), MISC + 64, gw, NGW, lane);
        __syncthreads();
        if (tid < 64) ((GAS unsigned*)(ws + WS_NPART))[bx * 64 + tid] = MISC[64 + tid];
    } SEAM2B();

    if (IN(2)) {
        PH_ALIGN(0);
        { pg8::Gemm g{(const bt*)(ws + WS_LAT), (const bt*)(ws + WS_WUQ), M, 3072, 1024, 1536, 1024, KOFF(1024)}; pg8::StaticOrder S; S.init(M, 3072, G, bx);
          pg8::EpiQb E{(bt*)(ws + WS_QB), (const float*)(ws + WS_ROWSS), (const float*)(ws + WS_ROPE), C2B};
          pg8::gemm_phase<pg8::EpiQb, pg8::StaticOrder, true, true>(lds, g, S, E); }
        { pg8::Gemm g{(const bt*)(ws + WS_LAT) + 1024, (const bt*)(ws + WS_WUKV), M, 4096, 512, 1536, 512, KOFF(512)}; pg8::StaticOrder S; S.init(M, 4096, G, bx);
          pg8::EpiKv E{(bt*)(ws + WS_KVB), (const float*)(ws + WS_ROWSS) + M};
          pg8::gemm_phase<pg8::EpiKv, pg8::StaticOrder, true, true>(lds, g, S, E); }
    } SEAM(2);

    if (IN(3)) { PH_ALIGN(0); att::attn_phase(P, lds, MISC, ctl, 0); } SEAM(3);

    if (IN(4)) { PH_ALIGN(0);
        pg8::Gemm g{(const bt*)(ws + WS_OAB), (const bt*)(ws + WS_WPA), M, 4096, 4096, 4096, 4096, 0}; pg8::StaticOrder S; S.init(M, 4096, G, bx);
        pg8::EpiMerge E{(const bt*)(ws + WS_G), (bt*)(ws + WS_MRG)};
        pg8::gemm_phase<pg8::EpiMerge, pg8::StaticOrder, true, true>(lds, g, S, E);
    } SEAM(4);

    if (IN(5)) { PH_ALIGN(0);
        pg8::Gemm g{(const bt*)(ws + WS_MRG), (const bt*)(ws + WS_WOUT), M, 4096, 4096, 4096, 4096, KOFF(4096)}; pg8::StaticOrder S; S.init(M, 4096, G, bx);
        pg8::EpiRes E{P.x, (bt*)(ws + WS_YB), ALPHA};
        pg8::gemm_phase<pg8::EpiRes, pg8::StaticOrder, true, true>(lds, g, S, E);
    } SEAM(5);

    if (IN(6)) { PH_ALIGN(0); ln_phase((const bf16*)(ws + WS_YB), P.ln1_g, P.ln1_b, nullptr, (bf16*)(ws + WS_H1B), (float*)(ws + WS_ROWSS), gw, NGW, lane); } SEAM(6);

    if (IN(7)) { PH_ALIGN(0);
        pg8::Gemm g{(const bt*)(ws + WS_H1B), (const bt*)(ws + WS_WUP), M, 22016, 4096, 4096, 4096, KOFF(4096)}; pg8::StaticOrder S; S.init(M, 22016, G, bx);
        pg8::EpiConv E{(bt*)(ws + WS_ACT), (bt*)(ws + WS_SIDE), P.conv_w, P.conv_b, DFF};
        pg8::gemm_phase<pg8::EpiConv, pg8::StaticOrder, true, true>(lds, g, S, E);
    } SEAM(7);

    if (IN(8)) { PH_ALIGN(0); conv_fix_phase((const bf16*)(ws + WS_SIDE), P.conv_w, P.conv_b, (bf16*)(ws + WS_ACT), gw, NGW, lane); } SEAM(8);

    if (IN(9)) { PH_ALIGN(0);
        pg8::Gemm g{(const bt*)(ws + WS_ACT), (const bt*)(ws + WS_WDN), M, 4096, DFF, DFF, DFF, KOFF(DFF)}; pg8::StaticOrder S; S.init(M, 4096, G, bx);
        pg8::EpiDown E{(const bt*)(ws + WS_YB), (bt*)(ws + WS_Y2B), (const float*)(ws + WS_ROWSS), P.ln1_g, P.ln1_b, ALPHA, M};
        pg8::gemm_phase<pg8::EpiDown, pg8::StaticOrder, true, true>(lds, g, S, E);
    } SEAM(9);

    if (IN(10)) { PH_ALIGN(0); ln_phase((const bf16*)(ws + WS_Y2B), P.ln2_g, P.ln2_b, P.out, nullptr, nullptr, gw, NGW, lane); }
#undef IN
#undef SEAM
#undef SEAM2B
}

extern "C" void kernel_launch(void* const* d_in, const int* in_sizes, int n_in, void* d_out, int out_size, void* d_ws, size_t ws_size, hipStream_t stream) {
    static int grid = 0;
    if (grid == 0) {
        if (n_in != 24 || in_sizes[0] != M * DM || out_size != M * DM || ws_size < WS_END) { fprintf(stderr, "kernel_launch: unexpected shapes (n_in %d, x %d, out %d, ws %zu < %zu)\n", n_in, n_in > 0 ? in_sizes[0] : -1, out_size, ws_size, (size_t)WS_END); grid = -1; return; }
        int dev = 0, cus = 0, per_cu = 0;
        if (hipGetDevice(&dev) != hipSuccess || hipDeviceGetAttribute(&cus, hipDeviceAttributeMultiprocessorCount, dev) != hipSuccess) { grid = -1; return; }
        if (hipFuncSetAttribute((const void*)mk_fwd, hipFuncAttributeMaxDynamicSharedMemorySize, LDS_BYTES) != hipSuccess) { fprintf(stderr, "kernel_launch: hipFuncSetAttribute failed\n"); grid = -1; return; }
        if (hipOccupancyMaxActiveBlocksPerMultiprocessor(&per_cu, (const void*)mk_fwd, NWAVES * 64, LDS_BYTES) != hipSuccess || per_cu < 1) fprintf(stderr, "kernel_launch: occupancy query says %d\n", per_cu);
        (void)hipGetLastError();
        grid = cus < 256 ? cus : 256;
    }
    if (grid < 0) return;
    if (hipMemsetAsync((char*)d_ws + WS_CTL, 0, CTL_ZERO_BYTES, stream) != hipSuccess) return;
    Args a{};
    for (int i = 0; i < 24; ++i) a.in[i] = d_in[i];
    a.out = (float*)d_out; a.ws = (unsigned char*)d_ws;
    constexpr int NL = MK_N_LAUNCHES;
    for (int li = 0; li < NL; ++li) {
        constexpr bool ONE = (MK_N_LAUNCHES == 1);
        a.ph_lo = ONE ? 0 : li; a.ph_hi = ONE ? N_PHASES : li + 1; a.li = ONE ? 0 : li; a.pad = 0;
        hipLaunchKernelGGL(mk_fwd, dim3(grid), dim3(NWAVES * 64), LDS_BYTES, stream, a);
        const hipError_t le = hipPeekAtLastError();
        if (le != hipSuccess) { fprintf(stderr, "kernel_launch: launch %d failed: %s\n", li, hipGetErrorName(le)); break; }
    }
}
```

```cpp
#include <hip/hip_runtime.h>
#include <cstdio>
#include <cstdint>

#ifndef MK_N_LAUNCHES
#define MK_N_LAUNCHES 1
#endif

constexpr int BATCH = 2, SEQ = 8192, DM = 4096, M = BATCH * SEQ;
constexpr int DA_H = 8, ML_H = 16, DFF = 11008;
constexpr int IN_COLS = 15936, N1 = 16128;
constexpr float ALPHA = 1.189207115002721f;
constexpr float LN_EPS = 1e-5f, RMS_EPS = 1e-6f;
constexpr float LOG2E = 1.4426950408889634f;
constexpr float C2A = 0.08838834764831845f * LOG2E;
constexpr float C2B = 0.07216878364870323f * LOG2E;
constexpr float LAMBDA_INIT = 0.2f;

constexpr size_t MiB = 1u << 20;
constexpr size_t WS_CTL = 0, CTL_ZERO_BYTES = 65536;
constexpr size_t WS_ROPE = 1 * MiB;
constexpr size_t WS_ROWSS = 5 * MiB;
constexpr size_t WS_NPART = 6 * MiB;
constexpr size_t WS_WIN = 8 * MiB, WS_WUQ = 134 * MiB, WS_WUKV = 140 * MiB, WS_WPA = 144 * MiB, WS_WPB = 160 * MiB, WS_WOUT = 176 * MiB, WS_WUP = 208 * MiB, WS_WDN = 380 * MiB;
constexpr size_t WS_XB = 466 * MiB;
constexpr size_t WS_OAB = WS_XB, WS_H1B = WS_XB;
constexpr size_t WS_QKV = 594 * MiB;
constexpr size_t WS_QB = 786 * MiB;
constexpr size_t WS_KVB = 882 * MiB;
constexpr size_t WS_LAT = 1042 * MiB;
constexpr size_t WS_G = 1090 * MiB;
constexpr size_t WS_TMP = 594 * MiB;
constexpr size_t WS_MRG = 850 * MiB;
constexpr size_t WS_SIDE = 594 * MiB;
constexpr size_t WS_ACT = 640 * MiB;
constexpr size_t WS_O0 = 8 * MiB;
constexpr size_t WS_YB = 1000 * MiB;
constexpr size_t WS_Y2B = 1136 * MiB;
constexpr size_t WS_END = 1376 * MiB;
constexpr int KVLD = 5120;

constexpr int RING_BYTES = 131072, LDSCTL_OFF = RING_BYTES, MISC_OFF = LDSCTL_OFF + 320, LDS_BYTES = 147456;
constexpr int NWAVES = 8;

#define GAS __attribute__((address_space(1)))
#define LAS __attribute__((address_space(3)))
typedef unsigned short bf16;
typedef unsigned v4u __attribute__((ext_vector_type(4)));
typedef unsigned v2u __attribute__((ext_vector_type(2)));
typedef float f32x4 __attribute__((ext_vector_type(4)));
typedef float f32x2 __attribute__((ext_vector_type(2)));
typedef float f32x16 __attribute__((ext_vector_type(16)));
typedef short bf16x8 __attribute__((ext_vector_type(8)));
typedef short s16x4 __attribute__((ext_vector_type(4)));
typedef GAS unsigned gu32;
#define RLX_AGENT __ATOMIC_RELAXED, __HIP_MEMORY_SCOPE_AGENT
#define LDS_WAIT() asm volatile("s_waitcnt lgkmcnt(0)" ::: "memory")
#define VM_WAIT() asm volatile("s_waitcnt vmcnt(0)" ::: "memory")
typedef __bf16 bf16x2_t __attribute__((ext_vector_type(2)));
__device__ __forceinline__ unsigned cvt_pk(float lo, float hi) { const f32x2 v = {lo, hi}; const bf16x2_t b = __builtin_convertvector(v, bf16x2_t); return __builtin_bit_cast(unsigned, b); }
__device__ __forceinline__ float bf_lo(unsigned w) { return __uint_as_float(w << 16); }
__device__ __forceinline__ float bf_hi(unsigned w) { return __uint_as_float(w & 0xffff0000u); }
__device__ __forceinline__ float wave_sum(float v) {
#pragma unroll
    for (int o = 1; o < 64; o <<= 1) v += __shfl_xor(v, o);
    return v;
}
namespace pg8 {
#define PG8_LAS __attribute__((address_space(3)))
typedef unsigned short bf16_t;
typedef short bf16x8 __attribute__((ext_vector_type(8)));
typedef float f32x4 __attribute__((ext_vector_type(4)));
typedef unsigned u32x4 __attribute__((ext_vector_type(4)));
constexpr int BM = 256, BK = 64, HALF = 128, HTB = HALF * BK * 2  , STAGE_BYTES = 8 * HTB, NXCD = 8, WGM = 8;

__host__ __device__ __forceinline__ int lds_byte(int r, int c) { const int st = (r >> 4) * 2 + (c >> 5), rr = r & 15, cc = c & 31, ob = rr * 64 + cc * 2; return st * 1024 + (ob ^ (((ob >> 9) & 1) << 5)); }
__host__ __device__ __forceinline__ void stage_rc(int b, int& R, int& C) { const int st = b / 1024, sb = b % 1024, swz = sb ^ (((sb >> 9) & 1) << 5); R = (st >> 1) * 16 + swz / 64; C = (st & 1) * 32 + (swz % 64) / 2; }
__host__ __device__ __forceinline__ int perm32(int rho) { const int n = rho >> 4, i = rho & 15; return 8 * (i >> 2) + 4 * n + (i & 3); }

struct Unit { int pm, pn; };
struct Gemm { const bf16_t* A; const bf16_t* Bt; int M, N, K, lda, ldb, koff; };

struct StaticOrder {
    int nM, nN, nwg, G, c;
    __host__ __device__ void init(int M, int N, int G_, int c_) { nM = M / BM; nN = N / BM; nwg = nM * nN; G = G_; c = c_; }
    __host__ __device__ bool next(int i, Unit& u) const {
        const long L = (long)i * G + c; if (L >= nwg) return false;
        int wgid = (int)L; { const int q = nwg / NXCD, r = nwg % NXCD, xcd = wgid % NXCD, off = wgid / NXCD; wgid = (xcd < r ? xcd * (q + 1) : r * (q + 1) + (xcd - r) * q) + off; }
        const int nig = WGM * nN, gid = wgid / nig, fm = gid * WGM, gsz = (nM - fm) < WGM ? (nM - fm) : WGM;
        u.pm = fm + ((wgid % nig) % gsz); u.pn = (wgid % nig) / gsz; return true;
    }
    __device__ __forceinline__ void a_ready(const Unit&) const {}
    __device__ __forceinline__ void done(const Unit&) const {}
};

__device__ __forceinline__ unsigned cvt_pk_bf16(float lo, float hi) { return ::cvt_pk(lo, hi); }
typedef float f32x2 __attribute__((ext_vector_type(2)));
__device__ __forceinline__ u32x4 pack8(f32x4 a, f32x4 b) { u32x4 w; w.x = cvt_pk_bf16(a[0], a[1]); w.y = cvt_pk_bf16(a[2], a[3]); w.z = cvt_pk_bf16(b[0], b[1]); w.w = cvt_pk_bf16(b[2], b[3]); return w; }
__device__ __forceinline__ float bflo(unsigned w) { return __uint_as_float(w << 16); }
__device__ __forceinline__ float bfhi(unsigned w) { return __uint_as_float(w & 0xffff0000u); }
__device__ __forceinline__ float sigmoidf_(float x) { return __builtin_amdgcn_rcpf(1.f + __builtin_amdgcn_exp2f(-1.4426950408889634f * x)); }
__device__ __forceinline__ void rope8(f32x4& v0, f32x4& v1, const float* cs  , int i0) {
    const f32x4 c = *(const f32x4*)(cs + i0), s = *(const f32x4*)(cs + 32 + i0);
    const f32x4 a = v0, b = v1;
    v0[0] = a[0] * c[0] - a[1] * s[0]; v0[1] = a[0] * s[0] + a[1] * c[0];
    v0[2] = a[2] * c[1] - a[3] * s[1]; v0[3] = a[2] * s[1] + a[3] * c[1];
    v1[0] = b[0] * c[2] - b[1] * s[2]; v1[1] = b[0] * s[2] + b[1] * c[2];
    v1[2] = b[2] * c[3] - b[3] * s[3]; v1[3] = b[2] * s[3] + b[3] * c[3];
}
#define PG8_ROWLOOP _Pragma("unroll") for (int ai = 0; ai < 2; ++ai) _Pragma("unroll") for (int m = 0; m < 4; ++m)

struct EpiIn {
    static constexpr bool PERM = true, AFTER_DRAIN = false, MID = false;
    bf16_t* qkv; bf16_t* lat; bf16_t* gate; bf16_t* kvb; float* rowss; const float* bgate; const float* rope; float c2a; int Mrows;
    __device__ __forceinline__ void operator()(const f32x4 (&acc)[2][2][4][2], const Unit& u, int wr, int wc, int fr, int fq) const {
        const int row0 = u.pm * BM + wr * 64 + fr, lc0 = wc * 32 + 8 * fq, pn = u.pn;
        if (pn < 24) {
            const float sc = pn < 8 ? c2a : 1.f;
            PG8_ROWLOOP { bf16_t* rowp = qkv + (size_t)(row0 + ai * HALF + m * 16) * 6144 + pn * 256 + lc0;
#pragma unroll
                for (int bj = 0; bj < 2; ++bj) *(u32x4*)(rowp + bj * HALF) = pack8(acc[ai][bj][m][0] * sc, acc[ai][bj][m][1] * sc); }
        } else if (pn < 30) {
            PG8_ROWLOOP { bf16_t* rowp = lat + (size_t)(row0 + ai * HALF + m * 16) * 1536 + (pn - 24) * 256 + lc0;
#pragma unroll
                for (int bj = 0; bj < 2; ++bj) *(u32x4*)(rowp + bj * HALF) = pack8(acc[ai][bj][m][0], acc[ai][bj][m][1]); }
        } else if (pn < 62) {
            const int gc0 = (pn - 30) * 256 + lc0;
            f32x4 bv[2][2];
#pragma unroll
            for (int bj = 0; bj < 2; ++bj)
#pragma unroll
                for (int n = 0; n < 2; ++n) bv[bj][n] = *(const f32x4*)(bgate + gc0 + bj * HALF + 4 * n);
            PG8_ROWLOOP { bf16_t* rowp = gate + (size_t)(row0 + ai * HALF + m * 16) * 8192 + gc0;
#pragma unroll
                for (int bj = 0; bj < 2; ++bj) { f32x4 a = acc[ai][bj][m][0] + bv[bj][0], b = acc[ai][bj][m][1] + bv[bj][1];
#pragma unroll
                    for (int e = 0; e < 4; ++e) { a[e] = sigmoidf_(a[e]); b[e] = sigmoidf_(b[e]); }
                    *(u32x4*)(rowp + bj * HALF) = pack8(a, b); } }
        } else {
            if (wc < 2) {
                PG8_ROWLOOP { const int row = row0 + ai * HALF + m * 16; f32x4 a = acc[ai][0][m][0], b = acc[ai][0][m][1];
                    rope8(a, b, rope + (size_t)row * 64, lc0 >> 1);
                    const u32x4 w = pack8(a, b); bf16_t* rowp = kvb + (size_t)row * 5120 + 128 + lc0;
#pragma unroll
                    for (int h = 0; h < 16; ++h) *(u32x4*)(rowp + h * 320) = w; }
            }
        }
    }
};
struct EpiQb {
    static constexpr bool PERM = true, AFTER_DRAIN = false, MID = false;
    bf16_t* qb; const float* rowss; const float* rope; float c2b;
    __device__ __forceinline__ void operator()(const f32x4 (&acc)[2][2][4][2], const Unit& u, int wr, int wc, int fr, int fq) const {
        const int row0 = u.pm * BM + wr * 64 + fr, lc0 = wc * 32 + 8 * fq;
        int col[2], i0[2]; bool isr[2];
#pragma unroll
        for (int bj = 0; bj < 2; ++bj) { col[bj] = u.pn * 256 + bj * HALF + lc0; const int h = col[bj] / 192, j = col[bj] - h * 192; isr[bj] = j >= 128; i0[bj] = (j - 128) >> 1; }
        PG8_ROWLOOP { const int row = row0 + ai * HALF + m * 16; const float rs = __builtin_amdgcn_rsqf(rowss[row] * (1.f / 1024.f) + 1e-6f) * c2b;
#pragma unroll
            for (int bj = 0; bj < 2; ++bj) { f32x4 a = acc[ai][bj][m][0] * rs, b = acc[ai][bj][m][1] * rs;
                if (isr[bj]) rope8(a, b, rope + (size_t)row * 64, i0[bj]);
                *(u32x4*)(qb + (size_t)row * 3072 + col[bj]) = pack8(a, b); } }
    }
};
struct EpiKv {
    static constexpr bool PERM = true, AFTER_DRAIN = false, MID = false;
    bf16_t* kvb; const float* rowss;
    __device__ __forceinline__ void operator()(const f32x4 (&acc)[2][2][4][2], const Unit& u, int wr, int wc, int fr, int fq) const {
        const int row0 = u.pm * BM + wr * 64 + fr, lc0 = wc * 32 + 8 * fq;
        PG8_ROWLOOP { const int row = row0 + ai * HALF + m * 16; const float rs = __builtin_amdgcn_rsqf(rowss[row] * (1.f / 512.f) + 1e-6f);
            bf16_t* rowp = kvb + (size_t)row * 5120 + u.pn * 320 + lc0;
            *(u32x4*)(rowp) = pack8(acc[ai][0][m][0] * rs, acc[ai][0][m][1] * rs);
            *(u32x4*)(rowp + 192) = pack8(acc[ai][1][m][0] * rs, acc[ai][1][m][1] * rs); }
    }
};
__device__ __forceinline__ void unpack8(const u32x4 w, f32x4& a, f32x4& b) { a[0] = bflo(w.x); a[1] = bfhi(w.x); a[2] = bflo(w.y); a[3] = bfhi(w.y); b[0] = bflo(w.z); b[1] = bfhi(w.z); b[2] = bflo(w.w); b[3] = bfhi(w.w); }
typedef _Float16 h16x2 __attribute__((ext_vector_type(2)));
__device__ __forceinline__ unsigned cvt_pk_h(float a, float b) { const f32x2 v = {a, b}; return __builtin_bit_cast(unsigned, __builtin_convertvector(v, h16x2)); }
__device__ __forceinline__ u32x4 pack8h(f32x4 a, f32x4 b) { u32x4 w; w.x = cvt_pk_h(a[0], a[1]); w.y = cvt_pk_h(a[2], a[3]); w.z = cvt_pk_h(b[0], b[1]); w.w = cvt_pk_h(b[2], b[3]); return w; }
__device__ __forceinline__ f32x2 h2f(unsigned w) { return __builtin_convertvector(__builtin_bit_cast(h16x2, w), f32x2); }
__device__ __forceinline__ void unpack8h(const u32x4 w, f32x4& a, f32x4& b) { const f32x2 p = h2f(w.x), q = h2f(w.y), r = h2f(w.z), t = h2f(w.w); a[0] = p[0]; a[1] = p[1]; a[2] = q[0]; a[3] = q[1]; b[0] = r[0]; b[1] = r[1]; b[2] = t[0]; b[3] = t[1]; }
struct EpiMerge {
    static constexpr bool PERM = true, AFTER_DRAIN = false, MID = true;
    const bf16_t* gate; bf16_t* mrg;
    __device__ __forceinline__ void mid(f32x4 (&acc)[2][2][4][2], const Unit& u, int wr, int wc, int fr, int fq) const {
        int fro = fr; asm volatile("" : "+v"(fro));
        const int row0 = u.pm * BM + wr * 64 + fro, c0 = u.pn * 256 + wc * 32 + 8 * fq;
        PG8_ROWLOOP { const bf16_t* gp = gate + (size_t)(row0 + ai * HALF + m * 16) * 8192 + c0;
#pragma unroll
            for (int bj = 0; bj < 2; ++bj) { f32x4 a0, a1, b0, b1; unpack8(*(const u32x4*)(gp + bj * HALF), a0, a1); unpack8(*(const u32x4*)(gp + 4096 + bj * HALF), b0, b1);
#pragma unroll
                for (int e = 0; e < 4; ++e) { acc[ai][bj][m][0][e] *= a0[e] * __builtin_amdgcn_rcpf(fmaxf(b0[e], 1e-30f)); acc[ai][bj][m][1][e] *= a1[e] * __builtin_amdgcn_rcpf(fmaxf(b1[e], 1e-30f)); } }
            asm volatile("" : "+v"(acc[ai][0][m][0]), "+v"(acc[ai][0][m][1]), "+v"(acc[ai][1][m][0]), "+v"(acc[ai][1][m][1]) :: "memory"); }
    }
    __device__ __forceinline__ void operator()(const f32x4 (&acc)[2][2][4][2], const Unit& u, int wr, int wc, int fr, int fq) const {
        const int row0 = u.pm * BM + wr * 64 + fr, c0 = u.pn * 256 + wc * 32 + 8 * fq;
        PG8_ROWLOOP { const int row = row0 + ai * HALF + m * 16;
#pragma unroll
            for (int bj = 0; bj < 2; ++bj) { const int c = c0 + bj * HALF; f32x4 b0, b1; unpack8(*(const u32x4*)(gate + (size_t)row * 8192 + 4096 + c), b0, b1);
#pragma unroll
                for (int e = 0; e < 4; ++e) { b0[e] = fmaxf(b0[e], 1e-30f); b1[e] = fmaxf(b1[e], 1e-30f); }
                *(u32x4*)(mrg + (size_t)row * 4096 + c) = pack8(acc[ai][bj][m][0] * b0, acc[ai][bj][m][1] * b1); } }
    }
};
struct EpiRes {
    static constexpr bool PERM = true, AFTER_DRAIN = false, MID = false;
    const float* base; bf16_t* out; float alpha;
    __device__ __forceinline__ void operator()(const f32x4 (&acc)[2][2][4][2], const Unit& u, int wr, int wc, int fr, int fq) const {
        const int row0 = u.pm * BM + wr * 64 + fr, c0 = u.pn * 256 + wc * 32 + 8 * fq;
        PG8_ROWLOOP { const size_t ro = (size_t)(row0 + ai * HALF + m * 16) * 4096;
#pragma unroll
            for (int bj = 0; bj < 2; ++bj) { const size_t off = ro + c0 + bj * HALF; const f32x4 xa = *(const f32x4*)(base + off), xb = *(const f32x4*)(base + off + 4);
                *(u32x4*)(out + off) = pack8h(xa * alpha + acc[ai][bj][m][0], xb * alpha + acc[ai][bj][m][1]); } }
    }
};
struct EpiDown {
    static constexpr bool PERM = true, AFTER_DRAIN = false, MID = false;
    const bf16_t* yb; bf16_t* out; const float* stat; const float* g; const float* b; float alpha; int Mrows;
    __device__ __forceinline__ void operator()(const f32x4 (&acc)[2][2][4][2], const Unit& u, int wr, int wc, int fr, int fq) const {
        const int row0 = u.pm * BM + wr * 64 + fr, c0 = u.pn * 256 + wc * 32 + 8 * fq;
        f32x4 gv[2][2], bv[2][2];
#pragma unroll
        for (int bj = 0; bj < 2; ++bj)
#pragma unroll
            for (int n = 0; n < 2; ++n) { gv[bj][n] = *(const f32x4*)(g + c0 + bj * HALF + 4 * n) * alpha; bv[bj][n] = *(const f32x4*)(b + c0 + bj * HALF + 4 * n) * alpha; }
        PG8_ROWLOOP { const int row = row0 + ai * HALF + m * 16; const size_t ro = (size_t)row * 4096; const float mean = stat[row], rstd = stat[Mrows + row];
#pragma unroll
            for (int bj = 0; bj < 2; ++bj) { const size_t off = ro + c0 + bj * HALF; f32x4 ya, yc; unpack8h(*(const u32x4*)(yb + off), ya, yc);
                *(u32x4*)(out + off) = pack8h((ya - mean) * rstd * gv[bj][0] + bv[bj][0] + acc[ai][bj][m][0], (yc - mean) * rstd * gv[bj][1] + bv[bj][1] + acc[ai][bj][m][1]); } }
    }
};
__device__ __forceinline__ float dpp_prev(float prev_grp, float cur, int k) {
    const int pg = __builtin_bit_cast(int, prev_grp), cu = __builtin_bit_cast(int, cur);
    const int ro = k == 1 ? __builtin_amdgcn_mov_dpp(pg, 0x121, 0xf, 0xf, false) : __builtin_amdgcn_mov_dpp(pg, 0x122, 0xf, 0xf, false);
    const int r = k == 1 ? __builtin_amdgcn_update_dpp(ro, cu, 0x111, 0xf, 0xf, false) : __builtin_amdgcn_update_dpp(ro, cu, 0x112, 0xf, 0xf, false);
    return __builtin_bit_cast(float, r);
}
struct EpiConv {
    static constexpr bool PERM = true, AFTER_DRAIN = false, MID = false;
    bf16_t* act; bf16_t* side; const float* cw; const float* cb; int dff;
    __device__ __forceinline__ void operator()(const f32x4 (&acc)[2][2][4][2], const Unit& u, int wr, int wc, int fr, int fq) const {
        const int ch0 = u.pn * 128 + wc * 32 + 8 * fq;
#pragma unroll
        for (int n = 0; n < 2; ++n) {
            const int ch = ch0 + 4 * n;
            f32x4 wg[3], wv[3];
#pragma unroll
            for (int k = 0; k < 3; ++k) { wg[k] = *(const f32x4*)(cw + (size_t)k * 2 * dff + ch); wv[k] = *(const f32x4*)(cw + (size_t)k * 2 * dff + dff + ch); }
            const f32x4 bg = *(const f32x4*)(cb + ch), bv = *(const f32x4*)(cb + dff + ch);
#pragma unroll
            for (int ai = 0; ai < 2; ++ai) {
                const int rowc = u.pm * BM + ai * HALF + wr * 64;
#pragma unroll
                for (int m = 0; m < 4; ++m) {
                    const f32x4 g0 = acc[ai][0][m][n], v0 = acc[ai][1][m][n];
                    const f32x4 gp = m > 0 ? acc[ai][0][m - 1][n] : (f32x4){0.f, 0.f, 0.f, 0.f}, vp = m > 0 ? acc[ai][1][m - 1][n] : (f32x4){0.f, 0.f, 0.f, 0.f};
                    f32x4 o;
#pragma unroll
                    for (int e = 0; e < 4; ++e) {
                        const float g1 = dpp_prev(gp[e], g0[e], 1), g2 = dpp_prev(gp[e], g0[e], 2), v1 = dpp_prev(vp[e], v0[e], 1), v2 = dpp_prev(vp[e], v0[e], 2);
                        const float cg = bg[e] + wg[0][e] * g2 + wg[1][e] * g1 + wg[2][e] * g0[e];
                        const float cv = bv[e] + wv[0][e] * v2 + wv[1][e] * v1 + wv[2][e] * v0[e];
                        o[e] = cg * sigmoidf_(cg) * cv;
                    }
                    const int row = rowc + m * 16 + fr;
                    typedef unsigned u32x2 __attribute__((ext_vector_type(2)));
                    if (m > 0 || fr >= 2) { u32x2 w; w.x = cvt_pk_bf16(o[0], o[1]); w.y = cvt_pk_bf16(o[2], o[3]); *(u32x2*)(act + (size_t)row * dff + ch) = w; }
                    if ((m == 0 && fr < 2) || (m == 3 && fr >= 14)) {
                        const int j = m == 0 ? fr : fr - 12;
                        bf16_t* sp = side + ((size_t)((rowc >> 6) * 4 + j) * 2) * dff + ch;
                        u32x2 wgt; wgt.x = cvt_pk_bf16(g0[0], g0[1]); wgt.y = cvt_pk_bf16(g0[2], g0[3]); *(u32x2*)sp = wgt;
                        u32x2 wvl; wvl.x = cvt_pk_bf16(v0[0], v0[1]); wvl.y = cvt_pk_bf16(v0[2], v0[3]); *(u32x2*)(sp + dff) = wvl;
                    }
                }
            }
        }
    }
};
template <class Epi, class Sched, bool ALIGN_EPI = false, bool SP2 = false>
__device__ __forceinline__ void gemm_phase(PG8_LAS unsigned char* lds, const Gemm g, const Sched& S, const Epi& E) {
    const int tid = threadIdx.x, wid = __builtin_amdgcn_readfirstlane(tid >> 6), lane = tid & 63, wr = wid >> 2, wc = wid & 3, fr = lane & 15, fq = lane >> 4;
    const int K = g.K, nt = K / BK;
    unsigned voffA[2], voffB[2];
#pragma unroll
    for (int i = 0; i < 2; ++i) { int R, C; stage_rc(tid * 16 + i * 8192, R, C); const int Rb = Epi::PERM ? ((R & ~31) + perm32(R & 31)) : R;
        voffA[i] = (unsigned)(R * g.lda + C) * 2u; voffB[i] = (unsigned)(Rb * g.ldb + C) * 2u; }
    const size_t kstep = (size_t)(BK * 2);
    const int koff = g.koff; const size_t kob = (size_t)koff * kstep;
#define PG8_KP(base, t_) ((base) + (size_t)(((t_) + koff) >= nt ? (t_) + koff - nt : (t_) + koff) * kstep)
    const size_t hstepA = (size_t)HALF * g.lda * 2, hstepB = (size_t)HALF * g.ldb * 2;
    const size_t tstepA = 2 * hstepA, tstepB = 2 * hstepB;
    const unsigned ldsw = (unsigned)wid * 1024u;
    const int aoff = lds_byte(wr * 64 + fr, fq * 8), boff = lds_byte(wc * 32 + fr, fq * 8);
#define PG8_SA(b, h) (((b) * 2 + (h)) * HTB)
#define PG8_SB(b, h) ((4 + (b) * 2 + (h)) * HTB)
    const __amdgpu_buffer_rsrc_t rsrc_voffA = __builtin_amdgcn_make_buffer_rsrc((void*)g.A, (short)0, 0x7ffffff0, 0x00020000);
    const __amdgpu_buffer_rsrc_t rsrc_voffB = __builtin_amdgcn_make_buffer_rsrc((void*)g.Bt, (short)0, 0x7ffffff0, 0x00020000);
    const char* const base_voffA = (const char*)g.A; const char* const base_voffB = (const char*)g.Bt;
#define PG8_STAGE(bufoff, gbase, voff) do { const int so_ = (int)((const char*)(gbase) - base_##voff); _Pragma("unroll") for (int _i = 0; _i < 2; ++_i) \
        __builtin_amdgcn_raw_ptr_buffer_load_lds(rsrc_##voff, (PG8_LAS void*)(lds + (bufoff) + ldsw + _i * 8192), 16, (int)(voff)[_i], so_, 0, 0); } while (0)
#define PG8_LDA(dst, b, h) do { _Pragma("unroll") for (int m = 0; m < 4; ++m) _Pragma("unroll") for (int k = 0; k < 2; ++k) dst[m][k] = *(const PG8_LAS bf16x8*)(lds + PG8_SA(b, h) + aoff + m * 2048 + k * 1024); } while (0)
#define PG8_LDB(dst, b, h) do { _Pragma("unroll") for (int n = 0; n < 2; ++n) _Pragma("unroll") for (int k = 0; k < 2; ++k) dst[n][k] = *(const PG8_LAS bf16x8*)(lds + PG8_SB(b, h) + boff + n * 2048 + k * 1024); } while (0)
#define PG8_MMA(ai, bj, At, Bt) do { __builtin_amdgcn_s_setprio(1); _Pragma("unroll") for (int m = 0; m < 4; ++m) _Pragma("unroll") for (int n = 0; n < 2; ++n) _Pragma("unroll") for (int k = 0; k < 2; ++k) \
        acc[ai][bj][m][n] = __builtin_amdgcn_mfma_f32_16x16x32_bf16(Bt[n][k], At[m][k], acc[ai][bj][m][n], 0, 0, 0); __builtin_amdgcn_s_setprio(0); } while (0)
#define PG8_WAIT_V(n) asm volatile("s_waitcnt vmcnt(" #n ")" ::: "memory")
#define PG8_WAIT_L(n) asm volatile("s_waitcnt lgkmcnt(" #n ")" ::: "memory")
#define PG8_BAR __builtin_amdgcn_s_barrier()
#define PG8_SCHED __builtin_amdgcn_sched_barrier(0)
    Unit cur, nxt; int ui = 0;
    if (!S.next(0, cur)) return;
    f32x4 acc[2][2][4][2];
#pragma unroll
    for (int a = 0; a < 2; ++a)
#pragma unroll
        for (int b = 0; b < 2; ++b)
#pragma unroll
            for (int m = 0; m < 4; ++m)
#pragma unroll
                for (int n = 0; n < 2; ++n) acc[a][b][m][n] = (f32x4){0.f, 0.f, 0.f, 0.f};
    bf16x8 At[4][2], B0[2][2], B1[2][2];
    const char* cA = (const char*)g.A + (size_t)cur.pm * tstepA; const char* cB = (const char*)g.Bt + (size_t)cur.pn * tstepB;
    S.a_ready(cur);
    if constexpr (SP2) {
        PG8_STAGE(PG8_SB(0, 0), cB + kob, voffB); PG8_STAGE(PG8_SB(0, 1), cB + kob + hstepB, voffB); PG8_STAGE(PG8_SA(0, 0), cA + kob, voffA); PG8_STAGE(PG8_SA(0, 1), cA + kob + hstepA, voffA);
        if (wr == 1) PG8_BAR;
        PG8_WAIT_V(2); PG8_BAR;
        PG8_STAGE(PG8_SB(1, 0), cB + kob + kstep, voffB); PG8_STAGE(PG8_SA(1, 0), cA + kob + kstep, voffA); PG8_STAGE(PG8_SB(1, 1), cB + kob + hstepB + kstep, voffB);
        PG8_WAIT_V(6); PG8_BAR;
    } else {
        PG8_STAGE(PG8_SB(0, 0), cB + kob, voffB); PG8_STAGE(PG8_SA(0, 0), cA + kob, voffA); PG8_STAGE(PG8_SB(0, 1), cB + kob + hstepB, voffB); PG8_STAGE(PG8_SA(0, 1), cA + kob + hstepA, voffA);
        if (wr == 1) PG8_BAR;
        PG8_WAIT_V(4); PG8_BAR;
        PG8_STAGE(PG8_SB(1, 0), cB + kob + kstep, voffB); PG8_STAGE(PG8_SA(1, 0), cA + kob + kstep, voffA); PG8_STAGE(PG8_SB(1, 1), cB + kob + hstepB + kstep, voffB);
        PG8_WAIT_V(6); PG8_BAR;
    }
    for (;;) {
        const bool has_next = S.next(ui + 1, nxt);
        const char* nA = has_next ? (const char*)g.A + (size_t)nxt.pm * tstepA : cA; const char* nB = has_next ? (const char*)g.Bt + (size_t)nxt.pn * tstepB : cB;
        asm volatile(".p2align 6");
        for (int t = 0; t < nt; t += 2) {
            if constexpr (Epi::MID) { if (t == nt / 2) E.mid(acc, cur, wr, wc, fr, fq); }
            const bool last = (t == nt - 2);
            const char* a1 = PG8_KP(cA, t + 1);
            const char* a2 = last ? nA + kob : PG8_KP(cA, t + 2); const char* b2 = last ? nB + kob : PG8_KP(cB, t + 2);
            const char* a3 = a2 + kstep; const char* b3 = b2 + kstep;
            if (last && has_next) S.a_ready(nxt);
            if constexpr (SP2) {
            PG8_LDB(B0, 0, 0); PG8_LDB(B1, 0, 1); PG8_SCHED; PG8_LDA(At, 0, 0); PG8_STAGE(PG8_SA(1, 1), a1 + hstepA, voffA);
            PG8_WAIT_V(8); PG8_WAIT_L(0); PG8_BAR; PG8_MMA(0, 0, At, B0); PG8_MMA(0, 1, At, B1); PG8_BAR; PG8_SCHED;
            PG8_LDA(At, 0, 1); PG8_STAGE(PG8_SB(0, 0), b2, voffB); PG8_STAGE(PG8_SB(0, 1), b2 + hstepB, voffB); PG8_STAGE(PG8_SA(0, 0), a2, voffA);
            PG8_WAIT_V(8); PG8_WAIT_L(0); PG8_BAR; PG8_MMA(1, 0, At, B0); PG8_MMA(1, 1, At, B1); PG8_BAR; PG8_SCHED;
            PG8_LDB(B0, 1, 0); PG8_LDB(B1, 1, 1); PG8_SCHED; PG8_LDA(At, 1, 0); PG8_STAGE(PG8_SA(0, 1), a2 + hstepA, voffA);
            PG8_WAIT_V(8); PG8_WAIT_L(0); PG8_BAR; PG8_MMA(0, 0, At, B0); PG8_MMA(0, 1, At, B1); PG8_BAR; PG8_SCHED;
            PG8_LDA(At, 1, 1); PG8_STAGE(PG8_SB(1, 0), b3, voffB); PG8_STAGE(PG8_SB(1, 1), b3 + hstepB, voffB); PG8_STAGE(PG8_SA(1, 0), a3, voffA);
            PG8_WAIT_V(8); PG8_WAIT_L(0); PG8_BAR; PG8_MMA(1, 0, At, B0); PG8_MMA(1, 1, At, B1); PG8_BAR; PG8_SCHED;
            } else {
            PG8_LDB(B0, 0, 0); PG8_SCHED; PG8_LDA(At, 0, 0); PG8_STAGE(PG8_SA(1, 1), a1 + hstepA, voffA);
            PG8_WAIT_L(8); PG8_BAR; PG8_WAIT_L(0); PG8_MMA(0, 0, At, B0); PG8_BAR; PG8_SCHED;
            PG8_LDB(B1, 0, 1); PG8_STAGE(PG8_SB(0, 0), b2, voffB);
            PG8_BAR; PG8_WAIT_L(0); PG8_MMA(0, 1, At, B1); PG8_BAR;
            PG8_LDA(At, 0, 1); PG8_STAGE(PG8_SA(0, 0), a2, voffA);
            PG8_BAR; PG8_WAIT_L(0); PG8_MMA(1, 0, At, B0); PG8_BAR; PG8_SCHED;
            PG8_STAGE(PG8_SB(0, 1), b2 + hstepB, voffB);
            PG8_WAIT_V(6); PG8_BAR; PG8_MMA(1, 1, At, B1); PG8_BAR;
            PG8_LDB(B0, 1, 0); PG8_SCHED; PG8_LDA(At, 1, 0); PG8_STAGE(PG8_SA(0, 1), a2 + hstepA, voffA);
            PG8_WAIT_L(8); PG8_BAR; PG8_WAIT_L(0); PG8_MMA(0, 0, At, B0); PG8_BAR; PG8_SCHED;
            PG8_LDB(B1, 1, 1); PG8_STAGE(PG8_SB(1, 0), b3, voffB);
            PG8_BAR; PG8_WAIT_L(0); PG8_MMA(0, 1, At, B1); PG8_BAR;
            PG8_LDA(At, 1, 1); PG8_STAGE(PG8_SA(1, 0), a3, voffA);
            PG8_BAR; PG8_WAIT_L(0); PG8_MMA(1, 0, At, B0); PG8_BAR; PG8_SCHED;
            PG8_STAGE(PG8_SB(1, 1), b3 + hstepB, voffB);
            PG8_WAIT_V(6); PG8_BAR; PG8_MMA(1, 1, At, B1); PG8_BAR;
            }
        }
        if constexpr (ALIGN_EPI) { if (wr == 0) PG8_BAR; }
        if constexpr (!Epi::AFTER_DRAIN) { E(acc, cur, wr, wc, fr, fq); S.done(cur); }
        if (!has_next) break;
#pragma unroll
        for (int a = 0; a < 2; ++a)
#pragma unroll
            for (int b = 0; b < 2; ++b)
#pragma unroll
                for (int m = 0; m < 4; ++m)
#pragma unroll
                    for (int n = 0; n < 2; ++n) acc[a][b][m][n] = (f32x4){0.f, 0.f, 0.f, 0.f};
        cur = nxt; cA = nA; cB = nB; ++ui;
        if constexpr (ALIGN_EPI) { if (wr == 1) PG8_BAR; }
    }
    PG8_WAIT_V(0);
    if constexpr (!ALIGN_EPI) { if (wr == 0) PG8_BAR; }
    PG8_BAR;
    if constexpr (Epi::AFTER_DRAIN) { E.fused(acc, cur, wr, wc, fr, fq, lds, wid, lane); S.done(cur); }
#undef PG8_KP
#undef PG8_SA
#undef PG8_SB
#undef PG8_STAGE
#undef PG8_LDA
#undef PG8_LDB
#undef PG8_MMA
#undef PG8_WAIT_V
#undef PG8_WAIT_L
#undef PG8_BAR
#undef PG8_SCHED
}
}
#define XB_TMO      128
#define XB_XCNT(j)  (256  + 64 * (j))
#define XB_XSUB(j)  (1280 + 64 * (j))
#define XB_XGEN(j)  (2304 + 64 * (j))
#define XB_TOP      3328
#define XB_TOPGEN   3392
#define XCD_BAR_WORDS 3456
#define XB_SPIN_CAP (1u << 18)

__device__ __forceinline__ unsigned xb_ld(unsigned* p)              { return __hip_atomic_load(p, __ATOMIC_RELAXED, __HIP_MEMORY_SCOPE_AGENT); }
__device__ __forceinline__ unsigned xb_add(unsigned* p, unsigned v) { return __hip_atomic_fetch_add(p, v, __ATOMIC_RELAXED, __HIP_MEMORY_SCOPE_AGENT); }
__device__ __forceinline__ unsigned xb_xcc_id() { return (unsigned)__builtin_amdgcn_s_getreg((3 << 11) | 20) & 0xFu; }
#define XB_SPIN(cond, bar) do { unsigned _sp = 0; while (cond) { __builtin_amdgcn_s_sleep(1); \
    if ((++_sp & 255u) == 0u) { if (xb_ld(&(bar)[XB_TMO])) break; if (_sp > XB_SPIN_CAP) { atomicAdd(&(bar)[XB_TMO], 1u); break; } } } } while (0)

struct XcdBarrier {
    unsigned* bar; unsigned x;
    volatile LAS unsigned* st;
};

__device__ __forceinline__ XcdBarrier xcd_barrier_post(unsigned* bar, volatile LAS unsigned* st) {
    XcdBarrier b; b.bar = bar; b.x = xb_xcc_id(); b.st = st;
    if (threadIdx.x == 0) (void)xb_add(&bar[XB_XCNT(b.x)], 1u);
    return b;
}
__device__ __forceinline__ void xcd_barrier_complete(unsigned* bar, unsigned x, unsigned& nloc, unsigned& nx) {
    const unsigned G = gridDim.x * gridDim.y * gridDim.z;
    unsigned sum, cnt, mine, sp = 0u;
    for (;;) {
        sum = 0u; cnt = 0u; mine = 0u;
#pragma unroll
        for (unsigned j = 0; j < 16; ++j) { const unsigned c = xb_ld(&bar[XB_XCNT(j)]); sum += c; cnt += (c > 0u) ? 1u : 0u; mine = (j == x) ? c : mine; }
        if (sum == G) break;
        __builtin_amdgcn_s_sleep(1);
        if ((++sp & 255u) == 0u) { if (xb_ld(&bar[XB_TMO])) break; if (sp > XB_SPIN_CAP) { atomicAdd(&bar[XB_TMO], 1u); break; } }
    }
    nloc = mine > 0u ? mine : 1u; nx = cnt > 0u ? cnt : 1u;
}

__device__ __forceinline__ void xcd_barrier(const XcdBarrier& b) {
    asm volatile("s_waitcnt vmcnt(0)" ::: "memory");
    __syncthreads();
    if (threadIdx.x == 0) {
        unsigned* bar = b.bar;
        __builtin_amdgcn_s_waitcnt(0);
        unsigned nloc = b.st[0], nx = b.st[1];
        if (nloc == 0u) { xcd_barrier_complete(bar, b.x, nloc, nx); b.st[0] = nloc; b.st[1] = nx; }
        const unsigned old = xb_add(&bar[XB_XSUB(b.x)], 1u);
        const unsigned gen = old / nloc;
        if (old + 1u == (gen + 1u) * nloc) {
            __builtin_amdgcn_fence(__ATOMIC_RELEASE, "agent");
            asm volatile("s_waitcnt vmcnt(0)" ::: "memory");
            const unsigned og = xb_add(&bar[XB_TOP], 1u);
            const unsigned tg = og / nx;
            if (og + 1u == (tg + 1u) * nx) xb_add(&bar[XB_TOPGEN], 1u);
            else XB_SPIN(xb_ld(&bar[XB_TOPGEN]) == tg, bar);
            __builtin_amdgcn_fence(__ATOMIC_ACQUIRE, "agent");
            xb_add(&bar[XB_XGEN(b.x)], 1u);
            asm volatile("s_waitcnt vmcnt(0)" ::: "memory");
        } else {
            XB_SPIN(xb_ld(&bar[XB_XGEN(b.x)]) == gen, bar);
            __builtin_amdgcn_fence(__ATOMIC_ACQUIRE, "agent");
            asm volatile("s_waitcnt vmcnt(0)" ::: "memory");
        }
    }
    __syncthreads();
}
template <int MODE> __device__ __forceinline__ int dest_row(int n) {
    if (MODE == 1) { if (n < 7680) return n; if (n < 7744) { const int i = n - 7680; return 15872 + (i < 32 ? 2 * i : 2 * (i - 32) + 1); } return n - 64; }
    if (MODE == 2) { const int h = n / 192, j = n - h * 192; if (j < 128) return n; const int i = j - 128; return h * 192 + 128 + (i < 32 ? 2 * i : 2 * (i - 32) + 1); }
    if (MODE == 3) { const int isv = n >= DFF ? 1 : 0, ch = n - isv * DFF; return (ch >> 7) * 256 + isv * 128 + (ch & 127); }
    return n;
}
template <int MODE>
__device__ __forceinline__ void tr_item(const float* W, int K, int N, const float* gk, bf16* WT, LAS unsigned* scr, int kb, int nb, int lane, int ldk = 0, int kofs = 0) {
    const int k0 = kb * 64, n0 = nb * 64;
    const float* src = W + (size_t)k0 * N + n0 + lane;
#pragma unroll
    for (int i = 0; i < 32; ++i) {
        float a = src[(size_t)(2 * i) * N], b = src[(size_t)(2 * i + 1) * N];
        if (gk) { a *= gk[k0 + 2 * i]; b *= gk[k0 + 2 * i + 1]; }
        scr[i * 65 + lane] = cvt_pk(a, b);
    }
    LDS_WAIT(); asm volatile("" ::: "memory");
    const int c = lane & 7;
#pragma unroll
    for (int j = 0; j < 8; ++j) { const int n = (lane >> 3) + 8 * j; const LAS unsigned* s = scr + (4 * c) * 65 + n;
        v4u o; o.x = s[0]; o.y = s[65]; o.z = s[130]; o.w = s[195];
        *(GAS v4u*)(WT + (size_t)dest_row<MODE>(n0 + n) * (ldk ? ldk : K) + kofs + k0 + 8 * c) = o; }
    LDS_WAIT(); asm volatile("" ::: "memory");
}

struct Ptrs {
    const float* x; const int* pos; const float* w_in; const float* b_gate; const float *lq1, *lk1, *lq2, *lk2; const float* subln_g; const float *qn_g, *kvn_g;
    const float *w_uq, *w_ukv, *w_pa, *w_pb, *w_out, *ln1_g, *ln1_b, *w_up, *conv_w, *conv_b, *w_down, *ln2_g, *ln2_b;
    float* out; unsigned char* ws;
};

__device__ __forceinline__ void p0_prologue(const Ptrs& P, LAS unsigned char* lds, int vcu, int G, int wave, int lane) {
    LAS unsigned* scr = (LAS unsigned*)(lds + wave * 8448);
    const int gw = vcu * NWAVES + wave, NGW = G * NWAVES;
    unsigned char* ws = P.ws;
    constexpr int I_IN = (IN_COLS / 64) * (DM / 64), I_UQ = (3072 / 64) * (1024 / 64), I_UKV = (4096 / 64) * (512 / 64), I_PA = (4096 / 64) * (2048 / 64), I_OUT = (4096 / 64) * (4096 / 64),
                  I_UP = (22016 / 64) * (4096 / 64), I_DN = (4096 / 64) * (DFF / 64);
    constexpr int NITEMS = I_IN + I_UQ + I_UKV + 2 * I_PA + I_OUT + I_UP + I_DN;
    for (int it = gw; it < NITEMS; it += NGW) {
        int r = it;
        if (r < I_IN)  { tr_item<1>(P.w_in, DM, IN_COLS, nullptr, (bf16*)(ws + WS_WIN), scr, r % (DM / 64), r / (DM / 64), lane); continue; } r -= I_IN;
        if (r < I_UQ)  { tr_item<2>(P.w_uq, 1024, 3072, P.qn_g, (bf16*)(ws + WS_WUQ), scr, r % 16, r / 16, lane); continue; } r -= I_UQ;
        if (r < I_UKV) { tr_item<0>(P.w_ukv, 512, 4096, P.kvn_g, (bf16*)(ws + WS_WUKV), scr, r % 8, r / 8, lane); continue; } r -= I_UKV;
        if (r < I_PA)  { tr_item<0>(P.w_pa, 2048, 4096, nullptr, (bf16*)(ws + WS_WPA), scr, r % 32, r / 32, lane, 4096, 0); continue; } r -= I_PA;
        if (r < I_PA)  { tr_item<0>(P.w_pb, 2048, 4096, nullptr, (bf16*)(ws + WS_WPA), scr, r % 32, r / 32, lane, 4096, 2048); continue; } r -= I_PA;
        if (r < I_OUT) { tr_item<0>(P.w_out, 4096, 4096, nullptr, (bf16*)(ws + WS_WOUT), scr, r % 64, r / 64, lane); continue; } r -= I_OUT;
        if (r < I_UP)  { tr_item<3>(P.w_up, 4096, 22016, nullptr, (bf16*)(ws + WS_WUP), scr, r % 64, r / 64, lane); continue; } r -= I_UP;
        tr_item<0>(P.w_down, DFF, 4096, nullptr, (bf16*)(ws + WS_WDN), scr, r % (DFF / 64), r / (DFF / 64), lane);
    }
    { const size_t n8 = (size_t)M * DM / 8; GAS v4u* xb = (GAS v4u*)(ws + WS_XB);
      for (size_t i = (size_t)gw * 64 + lane; i < n8; i += (size_t)NGW * 64) { const f32x4 a = *(const GAS f32x4*)(P.x + i * 8), b = *(const GAS f32x4*)(P.x + i * 8 + 4);
          v4u o; o.x = cvt_pk(a[0], a[1]); o.y = cvt_pk(a[2], a[3]); o.z = cvt_pk(b[0], b[1]); o.w = cvt_pk(b[2], b[3]); xb[i] = o; } }
    { GAS v4u* z = (GAS v4u*)(ws + WS_WIN + (size_t)IN_COLS * DM * 2); const size_t nz = (size_t)(N1 - IN_COLS) * DM * 2 / 16;
      for (size_t i = (size_t)gw * 64 + lane; i < nz; i += (size_t)NGW * 64) z[i] = (v4u){0u, 0u, 0u, 0u};
    }
    { GAS float* rt = (GAS float*)(ws + WS_ROPE);
      for (int i = gw * 64 + lane; i < M * 32; i += NGW * 64) { const int m = i >> 5, k = i & 31;
          const double inv = exp2(-(double)k * (13.287712379549449 / 32.0));
          const double rev = (double)P.pos[m] * inv * 0.15915494309189535;
          const float fr = (float)(rev - rint(rev));
          rt[(size_t)m * 64 + k] = __builtin_amdgcn_cosf(fr); rt[(size_t)m * 64 + 32 + k] = __builtin_amdgcn_sinf(fr); } }
}

namespace att {
__device__ __forceinline__ void glds16(const void* sbase, unsigned voff, unsigned lds_dst) {
    unsigned keep;
    asm volatile("s_mov_b32 %0, m0\n\ts_mov_b32 m0, %3\n\ts_nop 0\n\tglobal_load_lds_dwordx4 %1, %2\n\ts_mov_b32 m0, %0" : "=&s"(keep) : "v"(voff), "s"(sbase), "s"(lds_dst) : "memory");
}
__device__ __forceinline__ int v_rd_base(int lane) { return ((lane & 3) << 3) | (((lane >> 2) & 3) << 6) | (((lane >> 4) & 1) << 5) | (((lane >> 5) & 1) << 8); }
#define ATT_BAR() asm volatile("s_barrier" ::: "memory")

template <int DQK, int DV, bool ALIBI>
__device__ __forceinline__ void attn_block(LAS unsigned char* lds, const unsigned char* wsb, const bf16* Q, int ldq, unsigned kofs, unsigned ldkB, unsigned vofs, unsigned ldvB,
                                           int qb, float slope2, f32x16 (&o)[DV / 32], float& l_out) {
    constexpr int NQF = DQK / 16, NOD = DV / 32, KROW = DQK * 2, KT = 64 * KROW, VT = 64 * DV * 2, KCH = DQK / 8, NKI = KT / 8192, NVI = VT / 8192;
    const int tid = threadIdx.x, wid = __builtin_amdgcn_readfirstlane(tid >> 6), lane = tid & 63, r32 = lane & 31, hi = lane >> 5;
    const unsigned ldsb = (unsigned)(uintptr_t)lds;
    __builtin_assume(qb >= 0); __builtin_assume(qb < 32);
    const int NT = 4 * (qb + 1);
    constexpr bool KEEP = (DV == 128);
    constexpr int NB = (DV == 128) ? 3 : 2;
    static_assert(NB * (KT + VT) <= RING_BYTES, "tile buffers must fit the ring");
#define KSW(cs_, row_) (DQK == 128 ? ((cs_) ^ ((row_) & 15)) : (((cs_) & ~7) | (((cs_) ^ ((row_) >> 1)) & 7)))
    unsigned krel[NKI], vrel[NVI];
    if (KEEP) {
#pragma unroll
        for (int j = 0; j < NKI; ++j) { const int p = (j * 8 + wid) * 64 + lane, row = p / KCH, cs = p - row * KCH, c = KSW(cs, row); krel[j] = kofs + (unsigned)row * ldkB + (unsigned)c * 16u; }
#pragma unroll
        for (int j = 0; j < NVI; ++j) { const int p = (j * 8 + wid) * 64 + lane, s = p >> 5, rr = (p & 31) >> 2, cc = p & 3, kg = s / NOD, d0 = s - kg * NOD, kk = kg * 8 + rr;
            const int key = (kk & ~0xC) | ((kk & 4) << 1) | ((kk & 8) >> 1); vrel[j] = vofs + (unsigned)key * ldvB + (unsigned)(d0 * 32 + cc * 8) * 2u; }
    }
#define ATT_ISSUE(t_, bf_) do { if (KEEP) { const unsigned kb_ = (unsigned)(t_) * 64u; \
        _Pragma("unroll") for (int j = 0; j < NKI; ++j) glds16(wsb, krel[j] + kb_ * ldkB, (unsigned)__builtin_amdgcn_readfirstlane(ldsb + (bf_) * KT + (j * 8 + wid) * 1024)); \
        _Pragma("unroll") for (int j = 0; j < NVI; ++j) glds16(wsb, vrel[j] + kb_ * ldvB, (unsigned)__builtin_amdgcn_readfirstlane(ldsb + NB * KT + (bf_) * VT + (j * 8 + wid) * 1024)); } else ATT_ISSUE_RC(t_, bf_); } while (0)
#define ATT_ISSUE_RC(t_, bf_) do { const unsigned kb_ = (unsigned)(t_) * 64u; int ln_ = lane; asm volatile("" : "+v"(ln_)); \
        _Pragma("unroll") for (int j = 0; j < NKI; ++j) { const int p = (j * 8 + wid) * 64 + ln_, row = p / KCH, cs = p - row * KCH, c = KSW(cs, row); \
            glds16(wsb, kofs + ((unsigned)row + kb_) * ldkB + (unsigned)c * 16u, (unsigned)__builtin_amdgcn_readfirstlane(ldsb + (bf_) * KT + (j * 8 + wid) * 1024)); } \
        _Pragma("unroll") for (int j = 0; j < NVI; ++j) { const int p = (j * 8 + wid) * 64 + ln_, s = p >> 5, rr = (p & 31) >> 2, cc = p & 3, kg = s / NOD, d0 = s - kg * NOD, kk = kg * 8 + rr; \
            const int key = (kk & ~0xC) | ((kk & 4) << 1) | ((kk & 8) >> 1); \
            glds16(wsb, vofs + ((unsigned)key + kb_) * ldvB + (unsigned)(d0 * 32 + cc * 8) * 2u, (unsigned)__builtin_amdgcn_readfirstlane(ldsb + NB * KT + (bf_) * VT + (j * 8 + wid) * 1024)); } } while (0)
    ATT_BAR();
    ATT_ISSUE(NT - 1, 0);
    if (NB == 3) ATT_ISSUE(NT - 2, 1);
    bf16x8 qr[NQF];
#pragma unroll
    for (int d0 = 0; d0 < NQF; ++d0) qr[d0] = *(const bf16x8*)(Q + (size_t)(wid * 32 + r32) * ldq + d0 * 16 + hi * 8);
    float m_reg = -1e30f, l_reg = 0.f;
#pragma unroll
    for (int d0 = 0; d0 < NOD; ++d0)
#pragma unroll
        for (int r = 0; r < 16; ++r) o[d0][r] = 0.f;
    const int qi = qb * 256 + wid * 32 + r32;
    asm volatile(".p2align 6");
    int bf = NB == 3 ? -1 : 0;
    for (int i = 0; i < NT; ++i) {
        const int t = NT - 1 - i;
        if (NB == 3) { if (++bf == 3) bf = 0;
            if (i + 1 < NT) asm volatile("s_waitcnt vmcnt(%0)\n\ts_barrier" :: "n"(NKI + NVI) : "memory"); else asm volatile("s_waitcnt vmcnt(0)\n\ts_barrier" ::: "memory");
        } else { bf = i & 1;
            asm volatile("s_waitcnt vmcnt(0)\n\ts_barrier" ::: "memory");
            if (i + 1 < NT) ATT_ISSUE(t - 1, bf ^ 1); }
        const int bfn = bf == 0 ? 2 : bf - 1;
        const int jb = t - 4 * qb;
        if (!(jb > (wid >> 1))) {
        f32x16 p0, p1;
        if (ALIBI) {
            float s2o = slope2; asm volatile("" : "+v"(s2o));
            const float h4 = s2o * (float)(4 * hi);
#pragma unroll
            for (int r = 0; r < 16; ++r) { const float cr = (float)((r & 3) + 8 * (r >> 2)); p0[r] = __builtin_fmaf(s2o, cr, h4); p1[r] = __builtin_fmaf(s2o, cr + 32.f, h4); }
        } else {
#pragma unroll
            for (int r = 0; r < 16; ++r) { p0[r] = 0.f; p1[r] = 0.f; }
        }
        { const LAS unsigned char* kt = lds + bf * KT + r32 * KROW;
          const LAS unsigned char* kb4[4];
          const int key = DQK == 128 ? r32 : (r32 >> 1), hb = DQK == 128 ? ((r32 >> 3) & 1) : 0;
#pragma unroll
          for (int dd = 0; dd < 4; ++dd) kb4[dd] = kt + ((((dd * 2 + hi) ^ key) & 7) << 4) + hb * 128;
#define ATT_KADDR(d0_) (DQK == 128 ? kb4[(d0_) & 3] + (((d0_) >> 2) ? 128 - 256 * hb : 0) : kb4[(d0_) & 3] + ((d0_) >> 2) * 128)
          constexpr int PFD = (DV == 128) ? 2 : 0;
          bf16x8 kf[PFD + 1][2];
#pragma unroll
          for (int d0 = 0; d0 < PFD; ++d0) { const LAS unsigned char* a = ATT_KADDR(d0); kf[d0][0] = *(const LAS bf16x8*)a; kf[d0][1] = *(const LAS bf16x8*)(a + 32 * KROW); }
#pragma unroll
          for (int d0 = 0; d0 < NQF; ++d0) {
              if (d0 + PFD < NQF) { const LAS unsigned char* a = ATT_KADDR(d0 + PFD); kf[(d0 + PFD) % (PFD + 1)][0] = *(const LAS bf16x8*)a; kf[(d0 + PFD) % (PFD + 1)][1] = *(const LAS bf16x8*)(a + 32 * KROW); }
              if (PFD) __builtin_amdgcn_sched_barrier(0);
              p0 = __builtin_amdgcn_mfma_f32_32x32x16_bf16(kf[d0 % (PFD + 1)][0], qr[d0], p0, 0, 0, 0);
              p1 = __builtin_amdgcn_mfma_f32_32x32x16_bf16(kf[d0 % (PFD + 1)][1], qr[d0], p1, 0, 0, 0);
              if (PFD) __builtin_amdgcn_sched_barrier(0); }
#undef ATT_KADDR
        }
        __builtin_amdgcn_sched_barrier(0);
        const int kb = t * 64;
        float bq = 0.f;
        if (ALIBI) bq = slope2 * (float)(kb - qi);
        if (jb == (wid >> 1)) { const int dq = qi - kb - 4 * hi; const float NEG = -__builtin_inff();
#pragma unroll
            for (int r = 0; r < 16; ++r) { const int c = (r & 3) + 8 * (r >> 2); if (c > dq) p0[r] = NEG; if (c + 32 > dq) p1[r] = NEG; } }
        float pmax = p0[0];
#pragma unroll
        for (int r = 1; r < 16; ++r) pmax = fmaxf(pmax, p0[r]);
#pragma unroll
        for (int r = 0; r < 16; ++r) pmax = fmaxf(pmax, p1[r]);
        { auto rr = __builtin_amdgcn_permlane32_swap(__float_as_uint(pmax), __float_as_uint(pmax), false, false); pmax = fmaxf(__uint_as_float(rr[0]), __uint_as_float(rr[1])); }
        const float mx = pmax + bq;
        float alpha = 1.f;
        if (!__all(mx - m_reg <= 8.f)) { const float mn = fmaxf(m_reg, mx); alpha = __builtin_amdgcn_exp2f(m_reg - mn); m_reg = mn;
#pragma unroll
            for (int d0 = 0; d0 < NOD; ++d0)
#pragma unroll
                for (int r = 0; r < 16; ++r) o[d0][r] *= alpha; }
        const float ms = m_reg - bq;
        float ps = 0.f;
#pragma unroll
        for (int r = 0; r < 16; ++r) { p0[r] = __builtin_amdgcn_exp2f(p0[r] - ms); ps += p0[r]; }
#pragma unroll
        for (int r = 0; r < 16; ++r) { p1[r] = __builtin_amdgcn_exp2f(p1[r] - ms); ps += p1[r]; }
        { auto rr = __builtin_amdgcn_permlane32_swap(__float_as_uint(ps), __float_as_uint(ps), false, false); ps = __uint_as_float(rr[0]) + __uint_as_float(rr[1]); }
        l_reg = l_reg * alpha + ps;
        bf16x8 pa0, pa1, pa2, pa3;
#define ATT_PK4(P, B_, OUT) do { const unsigned a0 = cvt_pk(P[B_ + 0], P[B_ + 1]), a1 = cvt_pk(P[B_ + 2], P[B_ + 3]), b0 = cvt_pk(P[B_ + 4], P[B_ + 5]), b1 = cvt_pk(P[B_ + 6], P[B_ + 7]); \
        auto r0 = __builtin_amdgcn_permlane32_swap(a0, b0, false, false); auto r1 = __builtin_amdgcn_permlane32_swap(a1, b1, false, false); \
        v4u w = {r0[0], r1[0], r0[1], r1[1]}; OUT = __builtin_bit_cast(bf16x8, w); } while (0)
        ATT_PK4(p0, 0, pa0); ATT_PK4(p0, 8, pa1); ATT_PK4(p1, 0, pa2); ATT_PK4(p1, 8, pa3);
#undef ATT_PK4
        __builtin_amdgcn_sched_barrier(0);
        { const unsigned vb0 = ldsb + NB * KT + bf * VT + v_rd_base(lane);
#define ATT_TRRD(dst, off) asm volatile("ds_read_b64_tr_b16 %0, %1 offset:%2" : "=&v"(dst) : "v"(vb0), "i"(off) : "memory")
#pragma unroll
          for (int d0 = 0; d0 < NOD; ++d0) { s16x4 l0, l1, l2, l3, h0, h1, h2, h3;
              ATT_TRRD(l0, (0 * NOD + d0) * 512); ATT_TRRD(h0, (1 * NOD + d0) * 512); ATT_TRRD(l1, (2 * NOD + d0) * 512); ATT_TRRD(h1, (3 * NOD + d0) * 512);
              ATT_TRRD(l2, (4 * NOD + d0) * 512); ATT_TRRD(h2, (5 * NOD + d0) * 512); ATT_TRRD(l3, (6 * NOD + d0) * 512); ATT_TRRD(h3, (7 * NOD + d0) * 512);
              asm volatile("s_waitcnt lgkmcnt(0)" ::: "memory"); __builtin_amdgcn_sched_barrier(0);
              o[d0] = __builtin_amdgcn_mfma_f32_32x32x16_bf16((bf16x8){l0[0], l0[1], l0[2], l0[3], h0[0], h0[1], h0[2], h0[3]}, pa0, o[d0], 0, 0, 0);
              o[d0] = __builtin_amdgcn_mfma_f32_32x32x16_bf16((bf16x8){l1[0], l1[1], l1[2], l1[3], h1[0], h1[1], h1[2], h1[3]}, pa1, o[d0], 0, 0, 0);
              o[d0] = __builtin_amdgcn_mfma_f32_32x32x16_bf16((bf16x8){l2[0], l2[1], l2[2], l2[3], h2[0], h2[1], h2[2], h2[3]}, pa2, o[d0], 0, 0, 0);
              o[d0] = __builtin_amdgcn_mfma_f32_32x32x16_bf16((bf16x8){l3[0], l3[1], l3[2], l3[3], h3[0], h3[1], h3[2], h3[3]}, pa3, o[d0], 0, 0, 0); }
#undef ATT_TRRD
        }
        }
        if (NB == 3 && i + 2 < NT) ATT_ISSUE(t - 2, bfn);
    }
#undef ATT_ISSUE
#undef ATT_ISSUE_RC
#undef KSW
    l_out = l_reg;
}

#define ATT_ST_PAIR(row_, colg_, A_, B_) do { v2u a_ = (A_), b_ = (B_); \
        auto rx_ = __builtin_amdgcn_permlane32_swap(a_.x, b_.x, false, false); auto ry_ = __builtin_amdgcn_permlane32_swap(a_.y, b_.y, false, false); \
        *(v4u*)((row_) + (colg_) + 8 * hi) = (v4u){rx_[0], ry_[0], rx_[1], ry_[1]}; } while (0)
constexpr int CW_ATTQ = 8192, CW_NMAX = 12288;
__device__ __forceinline__ void attn_phase(const Ptrs& P, LAS unsigned char* lds, volatile LAS unsigned* MISC, gu32* ctl, int qoff) {
    const int tid = threadIdx.x, wid = __builtin_amdgcn_readfirstlane(tid >> 6), lane = tid & 63, r32 = lane & 31, hi = lane >> 5;
    unsigned char* ws = P.ws;
    const bf16* QKV = (const bf16*)(ws + WS_QKV); const bf16* QB = (const bf16*)(ws + WS_QB); bf16* OAB = (bf16*)(ws + WS_OAB);
    float lam;
    { const float s1 = wave_sum(P.lq1[lane] * P.lk1[lane] + P.lq1[lane + 64] * P.lk1[lane + 64]), s2 = wave_sum(P.lq2[lane] * P.lk2[lane] + P.lq2[lane + 64] * P.lk2[lane + 64]);
      lam = expf(s1) - expf(s2) + LAMBDA_INIT; }
    const int q0 = (int)(xb_xcc_id() & 7u);
    if (tid < 64) MISC[64 + tid] = 0u;
    __syncthreads();
    { const int w = tid & 63; unsigned mx = 0u; const GAS unsigned* part = (const GAS unsigned*)(ws + WS_NPART);
      for (int g = tid >> 6; g < (int)gridDim.x; g += 8) { const unsigned v = part[g * 64 + w]; mx = v > mx ? v : mx; }
      __hip_atomic_fetch_max((LAS unsigned*)(MISC + 64 + w), mx, __ATOMIC_RELAXED, __HIP_MEMORY_SCOPE_WORKGROUP); }
    __syncthreads();
    if (tid < 32) { const int b = tid >> 4, h = (tid >> 1) & 7, map = tid & 1;
        const float nq = __uint_as_float(MISC[64 + (b * 16 + h * 2 + map) * 2]), nk = __uint_as_float(MISC[64 + (b * 16 + h * 2 + map) * 2 + 1]);
        const float slope2 = LOG2E * exp2f(-(float)(h + 1));
        const float B = sqrtf(nq * nk) * 1.001f + 0.01f, Wf = (2.f * B + 126.f) / slope2;
        const float wq = ceilf(Wf * (1.0001f / 256.f) + 0.001f);
        MISC[32 + tid] = wq < 1000.f ? (unsigned)wq : 1000u; }
    __syncthreads();
    for (int dq = 0; dq < 8; ++dq) {
        const int q = (q0 + dq) & 7, b = q >> 2, qx = q & 3;
        for (;;) {
            if (tid == 0) MISC[16] = __hip_atomic_fetch_add((unsigned*)(ctl + CW_ATTQ + qoff + 64 * q), 1u, __ATOMIC_RELAXED, __HIP_MEMORY_SCOPE_AGENT);
            __syncthreads();
            const int n = (int)__builtin_amdgcn_readfirstlane(MISC[16]);
            __syncthreads();
            if (n >= 64) break;
            const int h = (n < 32) ? 7 - qx : qx, qb = 31 - (n & 31);
            const float slope2 = LOG2E * exp2f(-(float)(h + 1));
            unsigned char* scrb = ws + WS_O0 + (size_t)blockIdx.x * 262144 + (size_t)wid * 32768;
            const size_t rowq = (size_t)b * SEQ + (size_t)qb * 256;
#pragma unroll 1
            for (int map = 0; map < 2; ++map) {
                int qs = qb - (int)MISC[32 + (b * 8 + h) * 2 + map]; qs = __builtin_amdgcn_readfirstlane(qs > 0 ? qs : 0);
                f32x16 o[8]; float l;
                attn_block<128, 256, true>(lds, ws, QKV + rowq * 6144 + h * 256 + map * 128, 6144,
                                           (unsigned)(WS_QKV + (((size_t)b * SEQ + (size_t)qs * 256) * 6144 + 2048 + h * 256 + map * 128) * 2), 12288u,
                                           (unsigned)(WS_QKV + (((size_t)b * SEQ + (size_t)qs * 256) * 6144 + 4096 + h * 256) * 2), 12288u, qb - qs, slope2, o, l);
                const float inv = 1.f / l;
                unsigned so = (unsigned)lane * 16u; asm volatile("" : "+v"(so));
                f32x4* scr = (f32x4*)(scrb + so);
                if (map == 0) {
#pragma unroll
                    for (int d0 = 0; d0 < 8; ++d0)
#pragma unroll
                        for (int g = 0; g < 4; ++g) scr[(d0 * 4 + g) * 64] = (f32x4){o[d0][4 * g] * inv, o[d0][4 * g + 1] * inv, o[d0][4 * g + 2] * inv, o[d0][4 * g + 3] * inv};
                } else {
                    const float li = lam * inv; float ss = 0.f;
#pragma unroll
                    for (int d0 = 0; d0 < 8; ++d0) {
#pragma unroll
                        for (int g = 0; g < 4; ++g) { const f32x4 a = scr[(d0 * 4 + g) * 64];
#pragma unroll
                            for (int e = 0; e < 4; ++e) { const float v = a[e] - li * o[d0][4 * g + e]; ss += v * v; } }
                        asm volatile("" : "+v"(ss) :: "memory"); }
                    { auto rr = __builtin_amdgcn_permlane32_swap(__float_as_uint(ss), __float_as_uint(ss), false, false); ss = __uint_as_float(rr[0]) + __uint_as_float(rr[1]); }
                    const float rs = __builtin_amdgcn_rsqf(ss * (1.f / 256.f) + RMS_EPS) * (1.f - LAMBDA_INIT);
                    unsigned oo = (unsigned)((wid * 32 + r32) * 4096) * 2u; asm volatile("" : "+v"(oo));
                    bf16* orow = (bf16*)((unsigned char*)(OAB + rowq * 4096 + h * 256) + oo);
#pragma unroll
                    for (int d0 = 0; d0 < 8; ++d0) {
#pragma unroll
                        for (int g = 0; g < 4; g += 2) { v2u w[2];
#pragma unroll
                            for (int q = 0; q < 2; ++q) { const f32x4 a = scr[(d0 * 4 + g + q) * 64]; const f32x4 gg = *(const f32x4*)(P.subln_g + d0 * 32 + 8 * (g + q) + 4 * hi);
                                float v[4];
#pragma unroll
                                for (int e = 0; e < 4; ++e) v[e] = (a[e] - li * o[d0][4 * (g + q) + e]) * rs * gg[e];
                                w[q].x = cvt_pk(v[0], v[1]); w[q].y = cvt_pk(v[2], v[3]); }
                            ATT_ST_PAIR(orow, d0 * 32 + 8 * g, w[0], w[1]); }
                        asm volatile("" ::: "memory"); }
                }
            }
        }
    }
    for (int dq = 0; dq < 8; ++dq) {
        const int q = (q0 + dq) & 7, b = q >> 2, qx = q & 3;
        for (;;) {
            if (tid == 0) MISC[16] = __hip_atomic_fetch_add((unsigned*)(ctl + CW_ATTQ + qoff + 64 * (8 + q)), 1u, __ATOMIC_RELAXED, __HIP_MEMORY_SCOPE_AGENT);
            __syncthreads();
            const int n = (int)__builtin_amdgcn_readfirstlane(MISC[16]);
            __syncthreads();
            if (n >= 128) break;
            const int h = 4 * qx + (n & 3), qb = 31 - (n >> 2);
            const size_t rowq = (size_t)b * SEQ + (size_t)qb * 256;
            f32x16 o[4]; float l;
            const unsigned kofs = (unsigned)(WS_KVB + ((size_t)b * SEQ * KVLD + h * 320) * 2);
            attn_block<192, 128, false>(lds, ws, QB + rowq * 3072 + h * 192, 3072, kofs, (unsigned)(KVLD * 2), kofs + 384u, (unsigned)(KVLD * 2), qb, 0.f, o, l);
            const float inv = 1.f / l;
            unsigned oo = (unsigned)((wid * 32 + r32) * 4096) * 2u; asm volatile("" : "+v"(oo));
            bf16* orow = (bf16*)((unsigned char*)(OAB + rowq * 4096 + 2048 + h * 128) + oo);
#pragma unroll
            for (int d0 = 0; d0 < 4; ++d0)
#pragma unroll
                for (int g = 0; g < 4; g += 2) { v2u w0, w1;
                    w0.x = cvt_pk(o[d0][4 * g] * inv, o[d0][4 * g + 1] * inv); w0.y = cvt_pk(o[d0][4 * g + 2] * inv, o[d0][4 * g + 3] * inv);
                    w1.x = cvt_pk(o[d0][4 * g + 4] * inv, o[d0][4 * g + 5] * inv); w1.y = cvt_pk(o[d0][4 * g + 6] * inv, o[d0][4 * g + 7] * inv);
                    ATT_ST_PAIR(orow, d0 * 32 + 8 * g, w0, w1); }
        }
    }
}
}

__device__ __forceinline__ void rowss_phase(const bf16* LAT, float* rowss, int gw, int NGW, int lane) {
    for (int m = gw; m < M; m += NGW) {
        const GAS v4u* r = (const GAS v4u*)(LAT + (size_t)m * 1536) + lane;
        float sq = 0.f, sk = 0.f;
#pragma unroll
        for (int j = 0; j < 3; ++j) { const v4u w = r[64 * j]; f32x4 a, b; pg8::unpack8(w, a, b);
            const float t = (a[0] * a[0] + a[1] * a[1]) + (a[2] * a[2] + a[3] * a[3]) + (b[0] * b[0] + b[1] * b[1]) + (b[2] * b[2] + b[3] * b[3]);
            if (j < 2) sq += t; else sk += t; }
        sq = wave_sum(sq); sk = wave_sum(sk);
        if (lane == 0) { rowss[m] = sq; rowss[M + m] = sk; }
    }
}
__device__ __forceinline__ void normmax_phase(const bf16* QKV, volatile LAS unsigned* nmax  , int gw, int NGW, int lane) {
    float mq[4] = {0.f, 0.f, 0.f, 0.f}, mk[4] = {0.f, 0.f, 0.f, 0.f}; int cur_b = -1;
    for (int m = gw; ; m += NGW) {
        const int b = m < M ? m / SEQ : -2;
        if (b != cur_b) {
            if (cur_b >= 0 && (lane & 15) == 0) {
#pragma unroll
                for (int j = 0; j < 4; ++j) { const int v = j * 4 + (lane >> 4);
                    __hip_atomic_fetch_max((LAS unsigned*)(nmax + (cur_b * 16 + v) * 2), __float_as_uint(mq[j]), __ATOMIC_RELAXED, __HIP_MEMORY_SCOPE_WORKGROUP);
                    __hip_atomic_fetch_max((LAS unsigned*)(nmax + (cur_b * 16 + v) * 2 + 1), __float_as_uint(mk[j]), __ATOMIC_RELAXED, __HIP_MEMORY_SCOPE_WORKGROUP); } }
#pragma unroll
            for (int j = 0; j < 4; ++j) { mq[j] = 0.f; mk[j] = 0.f; }
            cur_b = b;
        }
        if (m >= M) break;
        const GAS v4u* rq = (const GAS v4u*)(QKV + (size_t)m * 6144) + lane;
#pragma unroll
        for (int j = 0; j < 4; ++j) {
            f32x4 a, c; pg8::unpack8(rq[64 * j], a, c);
            float tq = (a[0] * a[0] + a[1] * a[1]) + (a[2] * a[2] + a[3] * a[3]) + (c[0] * c[0] + c[1] * c[1]) + (c[2] * c[2] + c[3] * c[3]);
            pg8::unpack8(rq[256 + 64 * j], a, c);
            float tk = (a[0] * a[0] + a[1] * a[1]) + (a[2] * a[2] + a[3] * a[3]) + (c[0] * c[0] + c[1] * c[1]) + (c[2] * c[2] + c[3] * c[3]);
#pragma unroll
            for (int o = 1; o < 16; o <<= 1) { tq += __shfl_xor(tq, o); tk += __shfl_xor(tk, o); }
            mq[j] = fmaxf(mq[j], tq); mk[j] = fmaxf(mk[j], tk);
        }
    }
}
__device__ __forceinline__ void ln_phase(const bf16* in, const float* g, const float* bta, float* of, bf16* ob, float* stat  , int gw, int NGW, int lane) {
    for (int m = gw; m < M; m += NGW) {
        GAS const v4u* xr = (GAS const v4u*)(in + (size_t)m * DM) + lane;
        f32x4 v[8][2]; float s = 0.f;
#pragma unroll
        for (int j = 0; j < 8; ++j) { const v4u w = xr[64 * j]; pg8::unpack8h(w, v[j][0], v[j][1]);
            s += ((v[j][0][0] + v[j][0][1]) + (v[j][0][2] + v[j][0][3])) + ((v[j][1][0] + v[j][1][1]) + (v[j][1][2] + v[j][1][3])); }
        const float mean = wave_sum(s) * (1.f / DM); float s2 = 0.f;
#pragma unroll
        for (int j = 0; j < 8; ++j)
#pragma unroll
            for (int h = 0; h < 2; ++h) { v[j][h] = v[j][h] - mean; s2 += (v[j][h][0] * v[j][h][0] + v[j][h][1] * v[j][h][1]) + (v[j][h][2] * v[j][h][2] + v[j][h][3] * v[j][h][3]); }
        const float rstd = 1.f / sqrtf(wave_sum(s2) * (1.f / DM) + LN_EPS);
        if (stat && lane == 0) { stat[m] = mean; stat[M + m] = rstd; }
#pragma unroll
        for (int j = 0; j < 8; ++j) { const int c = 8 * lane + 512 * j;
            const f32x4 y0 = v[j][0] * rstd * *(const f32x4*)(g + c) + *(const f32x4*)(bta + c), y1 = v[j][1] * rstd * *(const f32x4*)(g + c + 4) + *(const f32x4*)(bta + c + 4);
            if (of) { GAS f32x4* o = (GAS f32x4*)(of + (size_t)m * DM + c); o[0] = y0; o[1] = y1; }
            if (ob) *((GAS v4u*)(ob + (size_t)m * DM + c)) = pg8::pack8(y0, y1); }
    }
}
__device__ __forceinline__ void conv_fix_phase(const bf16* SIDE, const float* cw, const float* cb, bf16* ACT, int gw, int NGW, int lane) {
    constexpr int NCG = (DFF + 511) / 512, NCH = M / 64;
    for (int it = gw; it < NCG * NCH; it += NGW) {
        const int cg = it % NCG, c = it / NCG, ch = cg * 512 + lane * 8;
        if (ch >= DFF) continue;
        const bool first = (c % (SEQ / 64)) == 0;
        f32x4 u[4][2][2];
#pragma unroll
        for (int j = 0; j < 4; ++j)
#pragma unroll
            for (int gv = 0; gv < 2; ++gv) {
                if (j < 2 && first) { u[j][gv][0] = (f32x4){0.f, 0.f, 0.f, 0.f}; u[j][gv][1] = (f32x4){0.f, 0.f, 0.f, 0.f}; }
                else { const int cc = j < 2 ? c - 1 : c, jj = j < 2 ? j + 2 : j - 2;
                    pg8::unpack8(*(const v4u*)(SIDE + ((size_t)(cc * 4 + jj) * 2 + gv) * DFF + ch), u[j][gv][0], u[j][gv][1]); } }
#pragma unroll
        for (int r = 0; r < 2; ++r) {
            float o[8];
#pragma unroll
            for (int e = 0; e < 8; ++e) {
                const int h = e >> 2, q = e & 3;
                const float cgate = cb[ch + e] + cw[ch + e] * u[r][0][h][q] + cw[(size_t)2 * DFF + ch + e] * u[r + 1][0][h][q] + cw[(size_t)4 * DFF + ch + e] * u[r + 2][0][h][q];
                const float cval = cb[DFF + ch + e] + cw[DFF + ch + e] * u[r][1][h][q] + cw[(size_t)3 * DFF + ch + e] * u[r + 1][1][h][q] + cw[(size_t)5 * DFF + ch + e] * u[r + 2][1][h][q];
                o[e] = cgate * pg8::sigmoidf_(cgate) * cval;
            }
            v4u w; w.x = cvt_pk(o[0], o[1]); w.y = cvt_pk(o[2], o[3]); w.z = cvt_pk(o[4], o[5]); w.w = cvt_pk(o[6], o[7]);
            *(v4u*)(ACT + (size_t)(c * 64 + r) * DFF + ch) = w;
        }
    }
}

struct Args { const void* in[24]; float* out; unsigned char* ws; int ph_lo, ph_hi, li, pad; };
constexpr int N_PHASES = 11;
__global__ void __launch_bounds__(NWAVES * 64, 2) mk_fwd(Args args) {
    extern __shared__ __attribute__((aligned(16))) unsigned char lds_raw[];
    LAS unsigned char* lds = (LAS unsigned char*)lds_raw;
    volatile LAS unsigned* MISC = (volatile LAS unsigned*)(lds + MISC_OFF);
    const int tid = threadIdx.x, lane = tid & 63, wave = __builtin_amdgcn_readfirstlane(tid >> 6);
    const int G = gridDim.x; const int bx = blockIdx.x; const int vcu = (G % 8 == 0) ? (bx % 8) * (G / 8) + bx / 8 : bx;
    Ptrs P;
    P.x = (const float*)args.in[0]; P.pos = (const int*)args.in[1]; P.w_in = (const float*)args.in[2]; P.b_gate = (const float*)args.in[3];
    P.lq1 = (const float*)args.in[4]; P.lk1 = (const float*)args.in[5]; P.lq2 = (const float*)args.in[6]; P.lk2 = (const float*)args.in[7];
    P.subln_g = (const float*)args.in[8]; P.qn_g = (const float*)args.in[9]; P.kvn_g = (const float*)args.in[10];
    P.w_uq = (const float*)args.in[11]; P.w_ukv = (const float*)args.in[12]; P.w_pa = (const float*)args.in[13]; P.w_pb = (const float*)args.in[14]; P.w_out = (const float*)args.in[15];
    P.ln1_g = (const float*)args.in[16]; P.ln1_b = (const float*)args.in[17]; P.w_up = (const float*)args.in[18]; P.conv_w = (const float*)args.in[19]; P.conv_b = (const float*)args.in[20];
    P.w_down = (const float*)args.in[21]; P.ln2_g = (const float*)args.in[22]; P.ln2_b = (const float*)args.in[23];
    P.out = args.out; P.ws = args.ws;
    unsigned char* ws = args.ws;
    gu32* ctl = (gu32*)(ws + WS_CTL);
    for (int u = tid; u < (LDS_BYTES - LDSCTL_OFF) / 4; u += NWAVES * 64) ((LAS unsigned*)(lds + LDSCTL_OFF))[u] = 0u;
    __syncthreads();
    XcdBarrier bar = xcd_barrier_post((unsigned*)(ctl + 4096) + args.li * XCD_BAR_WORDS, MISC + 8);
    const int lo = args.ph_lo, hi = args.ph_hi;
#define IN(k) (lo <= (k) && (k) < hi)
#define SEAM(k) do { if (IN(k) && IN((k) + 1)) xcd_barrier(bar); } while (0)
#define SEAM2B() do { if (IN(2)) xcd_barrier(bar); } while (0)
    const int gw = vcu * NWAVES + wave, NGW = G * NWAVES;
    typedef pg8::bf16_t bt;
    const int xcd_rot = bx & 7;
#define KOFF(K_) ((((K_) / 64) * xcd_rot / 8) & ~1)

#define PH_ALIGN(n) asm volatile(".p2align 8\n\t.rept %0\n\ts_nop 0\n\t.endr" :: "n"(n))
    if (IN(0)) { p0_prologue(P, lds, vcu, G, wave, lane); } SEAM(0);

    if (IN(1)) {
        PH_ALIGN(0);
        pg8::Gemm g{(const bt*)(ws + WS_XB), (const bt*)(ws + WS_WIN), M, N1, DM, DM, DM, KOFF(DM)}; pg8::StaticOrder S; S.init(M, N1, G, bx);
        pg8::EpiIn E{(bt*)(ws + WS_QKV), (bt*)(ws + WS_LAT), (bt*)(ws + WS_G), (bt*)(ws + WS_KVB), (float*)(ws + WS_ROWSS), P.b_gate, (const float*)(ws + WS_ROPE), C2A, M};
        pg8::gemm_phase<pg8::EpiIn, pg8::StaticOrder, true, true>(lds, g, S, E);
    } SEAM(1);

    if (IN(2)) {
        if (tid < 64) MISC[64 + tid] = 0u;
        __syncthreads();
        rowss_phase((const bf16*)(ws + WS_LAT), (float*)(ws + WS_ROWSS), gw, NGW, lane);
        normmax_phase((const bf16*)(ws + WS_QKV), MISC + 64, gw, NGW, lane);
        __syncthreads();
        if (tid < 64) ((GAS unsigned*)(ws + WS_NPART))[bx * 64 + tid] = MISC[64 + tid];
    } SEAM2B();

    if (IN(2)) {
        PH_ALIGN(0);
        { pg8::Gemm g{(const bt*)(ws + WS_LAT), (const bt*)(ws + WS_WUQ), M, 3072, 1024, 1536, 1024, KOFF(1024)}; pg8::StaticOrder S; S.init(M, 3072, G, bx);
          pg8::EpiQb E{(bt*)(ws + WS_QB), (const float*)(ws + WS_ROWSS), (const float*)(ws + WS_ROPE), C2B};
          pg8::gemm_phase<pg8::EpiQb, pg8::StaticOrder, true, true>(lds, g, S, E); }
        { pg8::Gemm g{(const bt*)(ws + WS_LAT) + 1024, (const bt*)(ws + WS_WUKV), M, 4096, 512, 1536, 512, KOFF(512)}; pg8::StaticOrder S; S.init(M, 4096, G, bx);
          pg8::EpiKv E{(bt*)(ws + WS_KVB), (const float*)(ws + WS_ROWSS) + M};
          pg8::gemm_phase<pg8::EpiKv, pg8::StaticOrder, true, true>(lds, g, S, E); }
    } SEAM(2);

    if (IN(3)) { PH_ALIGN(0); att::attn_phase(P, lds, MISC, ctl, 0); } SEAM(3);

    if (IN(4)) { PH_ALIGN(0);
        pg8::Gemm g{(const bt*)(ws + WS_OAB), (const bt*)(ws + WS_WPA), M, 4096, 4096, 4096, 4096, 0}; pg8::StaticOrder S; S.init(M, 4096, G, bx);
        pg8::EpiMerge E{(const bt*)(ws + WS_G), (bt*)(ws + WS_MRG)};
        pg8::gemm_phase<pg8::EpiMerge, pg8::StaticOrder, true, true>(lds, g, S, E);
    } SEAM(4);

    if (IN(5)) { PH_ALIGN(0);
        pg8::Gemm g{(const bt*)(ws + WS_MRG), (const bt*)(ws + WS_WOUT), M, 4096, 4096, 4096, 4096, KOFF(4096)}; pg8::StaticOrder S; S.init(M, 4096, G, bx);
        pg8::EpiRes E{P.x, (bt*)(ws + WS_YB), ALPHA};
        pg8::gemm_phase<pg8::EpiRes, pg8::StaticOrder, true, true>(lds, g, S, E);
    } SEAM(5);

    if (IN(6)) { PH_ALIGN(0); ln_phase((const bf16*)(ws + WS_YB), P.ln1_g, P.ln1_b, nullptr, (bf16*)(ws + WS_H1B), (float*)(ws + WS_ROWSS), gw, NGW, lane); } SEAM(6);

    if (IN(7)) { PH_ALIGN(0);
        pg8::Gemm g{(const bt*)(ws + WS_H1B), (const bt*)(ws + WS_WUP), M, 22016, 4096, 4096, 4096, KOFF(4096)}; pg8::StaticOrder S; S.init(M, 22016, G, bx);
        pg8::EpiConv E{(bt*)(ws + WS_ACT), (bt*)(ws + WS_SIDE), P.conv_w, P.conv_b, DFF};
        pg8::gemm_phase<pg8::EpiConv, pg8::StaticOrder, true, true>(lds, g, S, E);
    } SEAM(7);

    if (IN(8)) { PH_ALIGN(0); conv_fix_phase((const bf16*)(ws + WS_SIDE), P.conv_w, P.conv_b, (bf16*)(ws + WS_ACT), gw, NGW, lane); } SEAM(8);

    if (IN(9)) { PH_ALIGN(0);
        pg8::Gemm g{(const bt*)(ws + WS_ACT), (const bt*)(ws + WS_WDN), M, 4096, DFF, DFF, DFF, KOFF(DFF)}; pg8::StaticOrder S; S.init(M, 4096, G, bx);
        pg8::EpiDown E{(const bt*)(ws + WS_YB), (bt*)(ws + WS_Y2B), (const float*)(ws + WS_ROWSS), P.ln1_g, P.ln1_b, ALPHA, M};
        pg8::gemm_phase<pg8::EpiDown, pg8::StaticOrder, true, true>(lds, g, S, E);
    } SEAM(9);

    if (IN(10)) { PH_ALIGN(0); ln_phase((const bf16*)(ws + WS_Y2B), P.ln2_g, P.ln2_b, P.out, nullptr, nullptr, gw, NGW, lane); }
#undef IN
#undef SEAM
#undef SEAM2B
}

extern "C" void kernel_launch(void* const* d_in, const int* in_sizes, int n_in, void* d_out, int out_size, void* d_ws, size_t ws_size, hipStream_t stream) {
    static int grid = 0;
    if (grid == 0) {
        if (n_in != 24 || in_sizes[0] != M * DM || out_size != M * DM || ws_size < WS_END) { fprintf(stderr, "kernel_launch: unexpected shapes (n_in %d, x %d, out %d, ws %zu < %zu)\n", n_in, n_in > 0 ? in_sizes[0] : -1, out_size, ws_size, (size_t)WS_END); grid = -1; return; }
        int dev = 0, cus = 0, per_cu = 0;
        if (hipGetDevice(&dev) != hipSuccess || hipDeviceGetAttribute(&cus, hipDeviceAttributeMultiprocessorCount, dev) != hipSuccess) { grid = -1; return; }
        if (hipFuncSetAttribute((const void*)mk_fwd, hipFuncAttributeMaxDynamicSharedMemorySize, LDS_BYTES) != hipSuccess) { fprintf(stderr, "kernel_launch: hipFuncSetAttribute failed\n"); grid = -1; return; }
        if (hipOccupancyMaxActiveBlocksPerMultiprocessor(&per_cu, (const void*)mk_fwd, NWAVES * 64, LDS_BYTES) != hipSuccess || per_cu < 1) fprintf(stderr, "kernel_launch: occupancy query says %d\n", per_cu);
        (void)hipGetLastError();
        grid = cus < 256 ? cus : 256;
    }
    if (grid < 0) return;
    if (hipMemsetAsync((char*)d_ws + WS_CTL, 0, CTL_ZERO_BYTES, stream) != hipSuccess) return;
    Args a{};
    for (int i = 0; i < 24; ++i) a.in[i] = d_in[i];
    a.out = (float*)d_out; a.ws = (unsigned char*)d_ws;
    constexpr int NL = MK_N_LAUNCHES;
    for (int li = 0; li < NL; ++li) {
        constexpr bool ONE = (MK_N_LAUNCHES == 1);
        a.ph_lo = ONE ? 0 : li; a.ph_hi = ONE ? N_PHASES : li + 1; a.li = ONE ? 0 : li; a.pad = 0;
        hipLaunchKernelGGL(mk_fwd, dim3(grid), dim3(NWAVES * 64), LDS_BYTES, stream, a);
        const hipError_t le = hipPeekAtLastError();
        if (le != hipSuccess) { fprintf(stderr, "kernel_launch: launch %d failed: %s\n", li, hipGetErrorName(le)); break; }
    }
}
```

```cpp
#include <hip/hip_runtime.h>
#include <cstdio>
#include <cstdint>

#ifndef MK_N_LAUNCHES
#define MK_N_LAUNCHES 1
#endif

constexpr int BATCH = 2, SEQ = 8192, DM = 4096, M = BATCH * SEQ;
constexpr int DA_H = 8, ML_H = 16, DFF = 11008;
constexpr int IN_COLS = 15936, N1 = 16128;
constexpr float ALPHA = 1.189207115002721f;
constexpr float LN_EPS = 1e-5f, RMS_EPS = 1e-6f;
constexpr float LOG2E = 1.4426950408889634f;
constexpr float C2A = 0.08838834764831845f * LOG2E;
constexpr float C2B = 0.07216878364870323f * LOG2E;
constexpr float LAMBDA_INIT = 0.2f;

constexpr size_t MiB = 1u << 20;
constexpr size_t WS_CTL = 0, CTL_ZERO_BYTES = 65536;
constexpr size_t WS_ROPE = 1 * MiB;
constexpr size_t WS_ROWSS = 5 * MiB;
constexpr size_t WS_NPART = 6 * MiB;
constexpr size_t WS_WIN = 8 * MiB, WS_WUQ = 134 * MiB, WS_WUKV = 140 * MiB, WS_WPA = 144 * MiB, WS_WPB = 160 * MiB, WS_WOUT = 176 * MiB, WS_WUP = 208 * MiB, WS_WDN = 380 * MiB;
constexpr size_t WS_XB = 466 * MiB;
constexpr size_t WS_OAB = WS_XB, WS_H1B = WS_XB;
constexpr size_t WS_QKV = 594 * MiB;
constexpr size_t WS_QB = 786 * MiB;
constexpr size_t WS_KVB = 882 * MiB;
constexpr size_t WS_LAT = 1042 * MiB;
constexpr size_t WS_G = 1090 * MiB;
constexpr size_t WS_TMP = 594 * MiB;
constexpr size_t WS_MRG = 850 * MiB;
constexpr size_t WS_SIDE = 594 * MiB;
constexpr size_t WS_ACT = 640 * MiB;
constexpr size_t WS_O0 = 8 * MiB;
constexpr size_t WS_YB = 1000 * MiB;
constexpr size_t WS_Y2B = 1136 * MiB;
constexpr size_t WS_END = 1376 * MiB;
constexpr int KVLD = 5120;

constexpr int RING_BYTES = 131072, LDSCTL_OFF = RING_BYTES, MISC_OFF = LDSCTL_OFF + 320, LDS_BYTES = 147456;
constexpr int NWAVES = 8;

#define GAS __attribute__((address_space(1)))
#define LAS __attribute__((address_space(3)))
typedef unsigned short bf16;
typedef unsigned v4u __attribute__((ext_vector_type(4)));
typedef unsigned v2u __attribute__((ext_vector_type(2)));
typedef float f32x4 __attribute__((ext_vector_type(4)));
typedef float f32x2 __attribute__((ext_vector_type(2)));
typedef float f32x16 __attribute__((ext_vector_type(16)));
typedef short bf16x8 __attribute__((ext_vector_type(8)));
typedef short s16x4 __attribute__((ext_vector_type(4)));
typedef GAS unsigned gu32;
#define RLX_AGENT __ATOMIC_RELAXED, __HIP_MEMORY_SCOPE_AGENT
#define LDS_WAIT() asm volatile("s_waitcnt lgkmcnt(0)" ::: "memory")
#define VM_WAIT() asm volatile("s_waitcnt vmcnt(0)" ::: "memory")
typedef __bf16 bf16x2_t __attribute__((ext_vector_type(2)));
__device__ __forceinline__ unsigned cvt_pk(float lo, float hi) { const f32x2 v = {lo, hi}; const bf16x2_t b = __builtin_convertvector(v, bf16x2_t); return __builtin_bit_cast(unsigned, b); }
__device__ __forceinline__ float bf_lo(unsigned w) { return __uint_as_float(w << 16); }
__device__ __forceinline__ float bf_hi(unsigned w) { return __uint_as_float(w & 0xffff0000u); }
__device__ __forceinline__ float wave_sum(float v) {
#pragma unroll
    for (int o = 1; o < 64; o <<= 1) v += __shfl_xor(v, o);
    return v;
}
namespace pg8 {
#define PG8_LAS __attribute__((address_space(3)))
typedef unsigned short bf16_t;
typedef short bf16x8 __attribute__((ext_vector_type(8)));
typedef float f32x4 __attribute__((ext_vector_type(4)));
typedef unsigned u32x4 __attribute__((ext_vector_type(4)));
constexpr int BM = 256, BK = 64, HALF = 128, HTB = HALF * BK * 2  , STAGE_BYTES = 8 * HTB, NXCD = 8, WGM = 8;

__host__ __device__ __forceinline__ int lds_byte(int r, int c) { const int st = (r >> 4) * 2 + (c >> 5), rr = r & 15, cc = c & 31, ob = rr * 64 + cc * 2; return st * 1024 + (ob ^ (((ob >> 9) & 1) << 5)); }
__host__ __device__ __forceinline__ void stage_rc(int b, int& R, int& C) { const int st = b / 1024, sb = b % 1024, swz = sb ^ (((sb >> 9) & 1) << 5); R = (st >> 1) * 16 + swz / 64; C = (st & 1) * 32 + (swz % 64) / 2; }
__host__ __device__ __forceinline__ int perm32(int rho) { const int n = rho >> 4, i = rho & 15; return 8 * (i >> 2) + 4 * n + (i & 3); }

struct Unit { int pm, pn; };
struct Gemm { const bf16_t* A; const bf16_t* Bt; int M, N, K, lda, ldb, koff; };

struct StaticOrder {
    int nM, nN, nwg, G, c;
    __host__ __device__ void init(int M, int N, int G_, int c_) { nM = M / BM; nN = N / BM; nwg = nM * nN; G = G_; c = c_; }
    __host__ __device__ bool next(int i, Unit& u) const {
        const long L = (long)i * G + c; if (L >= nwg) return false;
        int wgid = (int)L; { const int q = nwg / NXCD, r = nwg % NXCD, xcd = wgid % NXCD, off = wgid / NXCD; wgid = (xcd < r ? xcd * (q + 1) : r * (q + 1) + (xcd - r) * q) + off; }
        const int nig = WGM * nN, gid = wgid / nig, fm = gid * WGM, gsz = (nM - fm) < WGM ? (nM - fm) : WGM;
        u.pm = fm + ((wgid % nig) % gsz); u.pn = (wgid % nig) / gsz; return true;
    }
    __device__ __forceinline__ void a_ready(const Unit&) const {}
    __device__ __forceinline__ void done(const Unit&) const {}
};

__device__ __forceinline__ unsigned cvt_pk_bf16(float lo, float hi) { return ::cvt_pk(lo, hi); }
typedef float f32x2 __attribute__((ext_vector_type(2)));
__device__ __forceinline__ u32x4 pack8(f32x4 a, f32x4 b) { u32x4 w; w.x = cvt_pk_bf16(a[0], a[1]); w.y = cvt_pk_bf16(a[2], a[3]); w.z = cvt_pk_bf16(b[0], b[1]); w.w = cvt_pk_bf16(b[2], b[3]); return w; }
__device__ __forceinline__ float bflo(unsigned w) { return __uint_as_float(w << 16); }
__device__ __forceinline__ float bfhi(unsigned w) { return __uint_as_float(w & 0xffff0000u); }
__device__ __forceinline__ float sigmoidf_(float x) { return __builtin_amdgcn_rcpf(1.f + __builtin_amdgcn_exp2f(-1.4426950408889634f * x)); }
__device__ __forceinline__ void rope8(f32x4& v0, f32x4& v1, const float* cs  , int i0) {
    const f32x4 c = *(const f32x4*)(cs + i0), s = *(const f32x4*)(cs + 32 + i0);
    const f32x4 a = v0, b = v1;
    v0[0] = a[0] * c[0] - a[1] * s[0]; v0[1] = a[0] * s[0] + a[1] * c[0];
    v0[2] = a[2] * c[1] - a[3] * s[1]; v0[3] = a[2] * s[1] + a[3] * c[1];
    v1[0] = b[0] * c[2] - b[1] * s[2]; v1[1] = b[0] * s[2] + b[1] * c[2];
    v1[2] = b[2] * c[3] - b[3] * s[3]; v1[3] = b[2] * s[3] + b[3] * c[3];
}
#define PG8_ROWLOOP _Pragma("unroll") for (int ai = 0; ai < 2; ++ai) _Pragma("unroll") for (int m = 0; m < 4; ++m)

struct EpiIn {
    static constexpr bool PERM = true, AFTER_DRAIN = false, MID = false;
    bf16_t* qkv; bf16_t* lat; bf16_t* gate; bf16_t* kvb; float* rowss; const float* bgate; const float* rope; float c2a; int Mrows;
    __device__ __forceinline__ void operator()(const f32x4 (&acc)[2][2][4][2], const Unit& u, int wr, int wc, int fr, int fq) const {
        const int row0 = u.pm * BM + wr * 64 + fr, lc0 = wc * 32 + 8 * fq, pn = u.pn;
        if (pn < 24) {
            const float sc = pn < 8 ? c2a : 1.f;
            PG8_ROWLOOP { bf16_t* rowp = qkv + (size_t)(row0 + ai * HALF + m * 16) * 6144 + pn * 256 + lc0;
#pragma unroll
                for (int bj = 0; bj < 2; ++bj) *(u32x4*)(rowp + bj * HALF) = pack8(acc[ai][bj][m][0] * sc, acc[ai][bj][m][1] * sc); }
        } else if (pn < 30) {
            PG8_ROWLOOP { bf16_t* rowp = lat + (size_t)(row0 + ai * HALF + m * 16) * 1536 + (pn - 24) * 256 + lc0;
#pragma unroll
                for (int bj = 0; bj < 2; ++bj) *(u32x4*)(rowp + bj * HALF) = pack8(acc[ai][bj][m][0], acc[ai][bj][m][1]); }
        } else if (pn < 62) {
            const int gc0 = (pn - 30) * 256 + lc0;
            f32x4 bv[2][2];
#pragma unroll
            for (int bj = 0; bj < 2; ++bj)
#pragma unroll
                for (int n = 0; n < 2; ++n) bv[bj][n] = *(const f32x4*)(bgate + gc0 + bj * HALF + 4 * n);
            PG8_ROWLOOP { bf16_t* rowp = gate + (size_t)(row0 + ai * HALF + m * 16) * 8192 + gc0;
#pragma unroll
                for (int bj = 0; bj < 2; ++bj) { f32x4 a = acc[ai][bj][m][0] + bv[bj][0], b = acc[ai][bj][m][1] + bv[bj][1];
#pragma unroll
                    for (int e = 0; e < 4; ++e) { a[e] = sigmoidf_(a[e]); b[e] = sigmoidf_(b[e]); }
                    *(u32x4*)(rowp + bj * HALF) = pack8(a, b); } }
        } else {
            if (wc < 2) {
                PG8_ROWLOOP { const int row = row0 + ai * HALF + m * 16; f32x4 a = acc[ai][0][m][0], b = acc[ai][0][m][1];
                    rope8(a, b, rope + (size_t)row * 64, lc0 >> 1);
                    const u32x4 w = pack8(a, b); bf16_t* rowp = kvb + (size_t)row * 5120 + 128 + lc0;
#pragma unroll
                    for (int h = 0; h < 16; ++h) *(u32x4*)(rowp + h * 320) = w; }
            }
        }
    }
};
struct EpiQb {
    static constexpr bool PERM = true, AFTER_DRAIN = false, MID = false;
    bf16_t* qb; const float* rowss; const float* rope; float c2b;
    __device__ __forceinline__ void operator()(const f32x4 (&acc)[2][2][4][2], const Unit& u, int wr, int wc, int fr, int fq) const {
        const int row0 = u.pm * BM + wr * 64 + fr, lc0 = wc * 32 + 8 * fq;
        int col[2], i0[2]; bool isr[2];
#pragma unroll
        for (int bj = 0; bj < 2; ++bj) { col[bj] = u.pn * 256 + bj * HALF + lc0; const int h = col[bj] / 192, j = col[bj] - h * 192; isr[bj] = j >= 128; i0[bj] = (j - 128) >> 1; }
        PG8_ROWLOOP { const int row = row0 + ai * HALF + m * 16; const float rs = __builtin_amdgcn_rsqf(rowss[row] * (1.f / 1024.f) + 1e-6f) * c2b;
#pragma unroll
            for (int bj = 0; bj < 2; ++bj) { f32x4 a = acc[ai][bj][m][0] * rs, b = acc[ai][bj][m][1] * rs;
                if (isr[bj]) rope8(a, b, rope + (size_t)row * 64, i0[bj]);
                *(u32x4*)(qb + (size_t)row * 3072 + col[bj]) = pack8(a, b); } }
    }
};
struct EpiKv {
    static constexpr bool PERM = true, AFTER_DRAIN = false, MID = false;
    bf16_t* kvb; const float* rowss;
    __device__ __forceinline__ void operator()(const f32x4 (&acc)[2][2][4][2], const Unit& u, int wr, int wc, int fr, int fq) const {
        const int row0 = u.pm * BM + wr * 64 + fr, lc0 = wc * 32 + 8 * fq;
        PG8_ROWLOOP { const int row = row0 + ai * HALF + m * 16; const float rs = __builtin_amdgcn_rsqf(rowss[row] * (1.f / 512.f) + 1e-6f);
            bf16_t* rowp = kvb + (size_t)row * 5120 + u.pn * 320 + lc0;
            *(u32x4*)(rowp) = pack8(acc[ai][0][m][0] * rs, acc[ai][0][m][1] * rs);
            *(u32x4*)(rowp + 192) = pack8(acc[ai][1][m][0] * rs, acc[ai][1][m][1] * rs); }
    }
};
__device__ __forceinline__ void unpack8(const u32x4 w, f32x4& a, f32x4& b) { a[0] = bflo(w.x); a[1] = bfhi(w.x); a[2] = bflo(w.y); a[3] = bfhi(w.y); b[0] = bflo(w.z); b[1] = bfhi(w.z); b[2] = bflo(w.w); b[3] = bfhi(w.w); }
typedef _Float16 h16x2 __attribute__((ext_vector_type(2)));
__device__ __forceinline__ unsigned cvt_pk_h(float a, float b) { const f32x2 v = {a, b}; return __builtin_bit_cast(unsigned, __builtin_convertvector(v, h16x2)); }
__device__ __forceinline__ u32x4 pack8h(f32x4 a, f32x4 b) { u32x4 w; w.x = cvt_pk_h(a[0], a[1]); w.y = cvt_pk_h(a[2], a[3]); w.z = cvt_pk_h(b[0], b[1]); w.w = cvt_pk_h(b[2], b[3]); return w; }
__device__ __forceinline__ f32x2 h2f(unsigned w) { return __builtin_convertvector(__builtin_bit_cast(h16x2, w), f32x2); }
__device__ __forceinline__ void unpack8h(const u32x4 w, f32x4& a, f32x4& b) { const f32x2 p = h2f(w.x), q = h2f(w.y), r = h2f(w.z), t = h2f(w.w); a[0] = p[0]; a[1] = p[1]; a[2] = q[0]; a[3] = q[1]; b[0] = r[0]; b[1] = r[1]; b[2] = t[0]; b[3] = t[1]; }
struct EpiMerge {
    static constexpr bool PERM = true, AFTER_DRAIN = false, MID = true;
    const bf16_t* gate; bf16_t* mrg;
    __device__ __forceinline__ void mid(f32x4 (&acc)[2][2][4][2], const Unit& u, int wr, int wc, int fr, int fq) const {
        int fro = fr; asm volatile("" : "+v"(fro));
        const int row0 = u.pm * BM + wr * 64 + fro, c0 = u.pn * 256 + wc * 32 + 8 * fq;
        PG8_ROWLOOP { const bf16_t* gp = gate + (size_t)(row0 + ai * HALF + m * 16) * 8192 + c0;
#pragma unroll
            for (int bj = 0; bj < 2; ++bj) { f32x4 a0, a1, b0, b1; unpack8(*(const u32x4*)(gp + bj * HALF), a0, a1); unpack8(*(const u32x4*)(gp + 4096 + bj * HALF), b0, b1);
#pragma unroll
                for (int e = 0; e < 4; ++e) { acc[ai][bj][m][0][e] *= a0[e] * __builtin_amdgcn_rcpf(fmaxf(b0[e], 1e-30f)); acc[ai][bj][m][1][e] *= a1[e] * __builtin_amdgcn_rcpf(fmaxf(b1[e], 1e-30f)); } }
            asm volatile("" : "+v"(acc[ai][0][m][0]), "+v"(acc[ai][0][m][1]), "+v"(acc[ai][1][m][0]), "+v"(acc[ai][1][m][1]) :: "memory"); }
    }
    __device__ __forceinline__ void operator()(const f32x4 (&acc)[2][2][4][2], const Unit& u, int wr, int wc, int fr, int fq) const {
        const int row0 = u.pm * BM + wr * 64 + fr, c0 = u.pn * 256 + wc * 32 + 8 * fq;
        PG8_ROWLOOP { const int row = row0 + ai * HALF + m * 16;
#pragma unroll
            for (int bj = 0; bj < 2; ++bj) { const int c = c0 + bj * HALF; f32x4 b0, b1; unpack8(*(const u32x4*)(gate + (size_t)row * 8192 + 4096 + c), b0, b1);
#pragma unroll
                for (int e = 0; e < 4; ++e) { b0[e] = fmaxf(b0[e], 1e-30f); b1[e] = fmaxf(b1[e], 1e-30f); }
                *(u32x4*)(mrg + (size_t)row * 4096 + c) = pack8(acc[ai][bj][m][0] * b0, acc[ai][bj][m][1] * b1); } }
    }
};
struct EpiRes {
    static constexpr bool PERM = true, AFTER_DRAIN = false, MID = false;
    const float* base; bf16_t* out; float alpha;
    __device__ __forceinline__ void operator()(const f32x4 (&acc)[2][2][4][2], const Unit& u, int wr, int wc, int fr, int fq) const {
        const int row0 = u.pm * BM + wr * 64 + fr, c0 = u.pn * 256 + wc * 32 + 8 * fq;
        PG8_ROWLOOP { const size_t ro = (size_t)(row0 + ai * HALF + m * 16) * 4096;
#pragma unroll
            for (int bj = 0; bj < 2; ++bj) { const size_t off = ro + c0 + bj * HALF; const f32x4 xa = *(const f32x4*)(base + off), xb = *(const f32x4*)(base + off + 4);
                *(u32x4*)(out + off) = pack8h(xa * alpha + acc[ai][bj][m][0], xb * alpha + acc[ai][bj][m][1]); } }
    }
};
struct EpiDown {
    static constexpr bool PERM = true, AFTER_DRAIN = false, MID = false;
    const bf16_t* yb; bf16_t* out; const float* stat; const float* g; const float* b; float alpha; int Mrows;
    __device__ __forceinline__ void operator()(const f32x4 (&acc)[2][2][4][2], const Unit& u, int wr, int wc, int fr, int fq) const {
        const int row0 = u.pm * BM + wr * 64 + fr, c0 = u.pn * 256 + wc * 32 + 8 * fq;
        f32x4 gv[2][2], bv[2][2];
#pragma unroll
        for (int bj = 0; bj < 2; ++bj)
#pragma unroll
            for (int n = 0; n < 2; ++n) { gv[bj][n] = *(const f32x4*)(g + c0 + bj * HALF + 4 * n) * alpha; bv[bj][n] = *(const f32x4*)(b + c0 + bj * HALF + 4 * n) * alpha; }
        PG8_ROWLOOP { const int row = row0 + ai * HALF + m * 16; const size_t ro = (size_t)row * 4096; const float mean = stat[row], rstd = stat[Mrows + row];
#pragma unroll
            for (int bj = 0; bj < 2; ++bj) { const size_t off = ro + c0 + bj * HALF; f32x4 ya, yc; unpack8h(*(const u32x4*)(yb + off), ya, yc);
                *(u32x4*)(out + off) = pack8h((ya - mean) * rstd * gv[bj][0] + bv[bj][0] + acc[ai][bj][m][0], (yc - mean) * rstd * gv[bj][1] + bv[bj][1] + acc[ai][bj][m][1]); } }
    }
};
__device__ __forceinline__ float dpp_prev(float prev_grp, float cur, int k) {
    const int pg = __builtin_bit_cast(int, prev_grp), cu = __builtin_bit_cast(int, cur);
    const int ro = k == 1 ? __builtin_amdgcn_mov_dpp(pg, 0x121, 0xf, 0xf, false) : __builtin_amdgcn_mov_dpp(pg, 0x122, 0xf, 0xf, false);
    const int r = k == 1 ? __builtin_amdgcn_update_dpp(ro, cu, 0x111, 0xf, 0xf, false) : __builtin_amdgcn_update_dpp(ro, cu, 0x112, 0xf, 0xf, false);
    return __builtin_bit_cast(float, r);
}
struct EpiConv {
    static constexpr bool PERM = true, AFTER_DRAIN = false, MID = false;
    bf16_t* act; bf16_t* side; const float* cw; const float* cb; int dff;
    __device__ __forceinline__ void operator()(const f32x4 (&acc)[2][2][4][2], const Unit& u, int wr, int wc, int fr, int fq) const {
        const int ch0 = u.pn * 128 + wc * 32 + 8 * fq;
#pragma unroll
        for (int n = 0; n < 2; ++n) {
            const int ch = ch0 + 4 * n;
            f32x4 wg[3], wv[3];
#pragma unroll
            for (int k = 0; k < 3; ++k) { wg[k] = *(const f32x4*)(cw + (size_t)k * 2 * dff + ch); wv[k] = *(const f32x4*)(cw + (size_t)k * 2 * dff + dff + ch); }
            const f32x4 bg = *(const f32x4*)(cb + ch), bv = *(const f32x4*)(cb + dff + ch);
#pragma unroll
            for (int ai = 0; ai < 2; ++ai) {
                const int rowc = u.pm * BM + ai * HALF + wr * 64;
#pragma unroll
                for (int m = 0; m < 4; ++m) {
                    const f32x4 g0 = acc[ai][0][m][n], v0 = acc[ai][1][m][n];
                    const f32x4 gp = m > 0 ? acc[ai][0][m - 1][n] : (f32x4){0.f, 0.f, 0.f, 0.f}, vp = m > 0 ? acc[ai][1][m - 1][n] : (f32x4){0.f, 0.f, 0.f, 0.f};
                    f32x4 o;
#pragma unroll
                    for (int e = 0; e < 4; ++e) {
                        const float g1 = dpp_prev(gp[e], g0[e], 1), g2 = dpp_prev(gp[e], g0[e], 2), v1 = dpp_prev(vp[e], v0[e], 1), v2 = dpp_prev(vp[e], v0[e], 2);
                        const float cg = bg[e] + wg[0][e] * g2 + wg[1][e] * g1 + wg[2][e] * g0[e];
                        const float cv = bv[e] + wv[0][e] * v2 + wv[1][e] * v1 + wv[2][e] * v0[e];
                        o[e] = cg * sigmoidf_(cg) * cv;
                    }
                    const int row = rowc + m * 16 + fr;
                    typedef unsigned u32x2 __attribute__((ext_vector_type(2)));
                    if (m > 0 || fr >= 2) { u32x2 w; w.x = cvt_pk_bf16(o[0], o[1]); w.y = cvt_pk_bf16(o[2], o[3]); *(u32x2*)(act + (size_t)row * dff + ch) = w; }
                    if ((m == 0 && fr < 2) || (m == 3 && fr >= 14)) {
                        const int j = m == 0 ? fr : fr - 12;
                        bf16_t* sp = side + ((size_t)((rowc >> 6) * 4 + j) * 2) * dff + ch;
                        u32x2 wgt; wgt.x = cvt_pk_bf16(g0[0], g0[1]); wgt.y = cvt_pk_bf16(g0[2], g0[3]); *(u32x2*)sp = wgt;
                        u32x2 wvl; wvl.x = cvt_pk_bf16(v0[0], v0[1]); wvl.y = cvt_pk_bf16(v0[2], v0[3]); *(u32x2*)(sp + dff) = wvl;
                    }
                }
            }
        }
    }
};
template <class Epi, class Sched, bool ALIGN_EPI = false, bool SP2 = false>
__device__ __forceinline__ void gemm_phase(PG8_LAS unsigned char* lds, const Gemm g, const Sched& S, const Epi& E) {
    const int tid = threadIdx.x, wid = __builtin_amdgcn_readfirstlane(tid >> 6), lane = tid & 63, wr = wid >> 2, wc = wid & 3, fr = lane & 15, fq = lane >> 4;
    const int K = g.K, nt = K / BK;
    unsigned voffA[2], voffB[2];
#pragma unroll
    for (int i = 0; i < 2; ++i) { int R, C; stage_rc(tid * 16 + i * 8192, R, C); const int Rb = Epi::PERM ? ((R & ~31) + perm32(R & 31)) : R;
        voffA[i] = (unsigned)(R * g.lda + C) * 2u; voffB[i] = (unsigned)(Rb * g.ldb + C) * 2u; }
    const size_t kstep = (size_t)(BK * 2);
    const int koff = g.koff; const size_t kob = (size_t)koff * kstep;
#define PG8_KP(base, t_) ((base) + (size_t)(((t_) + koff) >= nt ? (t_) + koff - nt : (t_) + koff) * kstep)
    const size_t hstepA = (size_t)HALF * g.lda * 2, hstepB = (size_t)HALF * g.ldb * 2;
    const size_t tstepA = 2 * hstepA, tstepB = 2 * hstepB;
    const unsigned ldsw = (unsigned)wid * 1024u;
    const int aoff = lds_byte(wr * 64 + fr, fq * 8), boff = lds_byte(wc * 32 + fr, fq * 8);
#define PG8_SA(b, h) (((b) * 2 + (h)) * HTB)
#define PG8_SB(b, h) ((4 + (b) * 2 + (h)) * HTB)
    const __amdgpu_buffer_rsrc_t rsrc_voffA = __builtin_amdgcn_make_buffer_rsrc((void*)g.A, (short)0, 0x7ffffff0, 0x00020000);
    const __amdgpu_buffer_rsrc_t rsrc_voffB = __builtin_amdgcn_make_buffer_rsrc((void*)g.Bt, (short)0, 0x7ffffff0, 0x00020000);
    const char* const base_voffA = (const char*)g.A; const char* const base_voffB = (const char*)g.Bt;
#define PG8_STAGE(bufoff, gbase, voff) do { const int so_ = (int)((const char*)(gbase) - base_##voff); _Pragma("unroll") for (int _i = 0; _i < 2; ++_i) \
        __builtin_amdgcn_raw_ptr_buffer_load_lds(rsrc_##voff, (PG8_LAS void*)(lds + (bufoff) + ldsw + _i * 8192), 16, (int)(voff)[_i], so_, 0, 0); } while (0)
#define PG8_LDA(dst, b, h) do { _Pragma("unroll") for (int m = 0; m < 4; ++m) _Pragma("unroll") for (int k = 0; k < 2; ++k) dst[m][k] = *(const PG8_LAS bf16x8*)(lds + PG8_SA(b, h) + aoff + m * 2048 + k * 1024); } while (0)
#define PG8_LDB(dst, b, h) do { _Pragma("unroll") for (int n = 0; n < 2; ++n) _Pragma("unroll") for (int k = 0; k < 2; ++k) dst[n][k] = *(const PG8_LAS bf16x8*)(lds + PG8_SB(b, h) + boff + n * 2048 + k * 1024); } while (0)
#define PG8_MMA(ai, bj, At, Bt) do { __builtin_amdgcn_s_setprio(1); _Pragma("unroll") for (int m = 0; m < 4; ++m) _Pragma("unroll") for (int n = 0; n < 2; ++n) _Pragma("unroll") for (int k = 0; k < 2; ++k) \
        acc[ai][bj][m][n] = __builtin_amdgcn_mfma_f32_16x16x32_bf16(Bt[n][k], At[m][k], acc[ai][bj][m][n], 0, 0, 0); __builtin_amdgcn_s_setprio(0); } while (0)
#define PG8_WAIT_V(n) asm volatile("s_waitcnt vmcnt(" #n ")" ::: "memory")
#define PG8_WAIT_L(n) asm volatile("s_waitcnt lgkmcnt(" #n ")" ::: "memory")
#define PG8_BAR __builtin_amdgcn_s_barrier()
#define PG8_SCHED __builtin_amdgcn_sched_barrier(0)
    Unit cur, nxt; int ui = 0;
    if (!S.next(0, cur)) return;
    f32x4 acc[2][2][4][2];
#pragma unroll
    for (int a = 0; a < 2; ++a)
#pragma unroll
        for (int b = 0; b < 2; ++b)
#pragma unroll
            for (int m = 0; m < 4; ++m)
#pragma unroll
                for (int n = 0; n < 2; ++n) acc[a][b][m][n] = (f32x4){0.f, 0.f, 0.f, 0.f};
    bf16x8 At[4][2], B0[2][2], B1[2][2];
    const char* cA = (const char*)g.A + (size_t)cur.pm * tstepA; const char* cB = (const char*)g.Bt + (size_t)cur.pn * tstepB;
    S.a_ready(cur);
    if constexpr (SP2) {
        PG8_STAGE(PG8_SB(0, 0), cB + kob, voffB); PG8_STAGE(PG8_SB(0, 1), cB + kob + hstepB, voffB); PG8_STAGE(PG8_SA(0, 0), cA + kob, voffA); PG8_STAGE(PG8_SA(0, 1), cA + kob + hstepA, voffA);
        if (wr == 1) PG8_BAR;
        PG8_WAIT_V(2); PG8_BAR;
        PG8_STAGE(PG8_SB(1, 0), cB + kob + kstep, voffB); PG8_STAGE(PG8_SA(1, 0), cA + kob + kstep, voffA); PG8_STAGE(PG8_SB(1, 1), cB + kob + hstepB + kstep, voffB);
        PG8_WAIT_V(6); PG8_BAR;
    } else {
        PG8_STAGE(PG8_SB(0, 0), cB + kob, voffB); PG8_STAGE(PG8_SA(0, 0), cA + kob, voffA); PG8_STAGE(PG8_SB(0, 1), cB + kob + hstepB, voffB); PG8_STAGE(PG8_SA(0, 1), cA + kob + hstepA, voffA);
        if (wr == 1) PG8_BAR;
        PG8_WAIT_V(4); PG8_BAR;
        PG8_STAGE(PG8_SB(1, 0), cB + kob + kstep, voffB); PG8_STAGE(PG8_SA(1, 0), cA + kob + kstep, voffA); PG8_STAGE(PG8_SB(1, 1), cB + kob + hstepB + kstep, voffB);
        PG8_WAIT_V(6); PG8_BAR;
    }
    for (;;) {
        const bool has_next = S.next(ui + 1, nxt);
        const char* nA = has_next ? (const char*)g.A + (size_t)nxt.pm * tstepA : cA; const char* nB = has_next ? (const char*)g.Bt + (size_t)nxt.pn * tstepB : cB;
        asm volatile(".p2align 6");
        for (int t = 0; t < nt; t += 2) {
            if constexpr (Epi::MID) { if (t == nt / 2) E.mid(acc, cur, wr, wc, fr, fq); }
            const bool last = (t == nt - 2);
            const char* a1 = PG8_KP(cA, t + 1);
            const char* a2 = last ? nA + kob : PG8_KP(cA, t + 2); const char* b2 = last ? nB + kob : PG8_KP(cB, t + 2);
            const char* a3 = a2 + kstep; const char* b3 = b2 + kstep;
            if (last && has_next) S.a_ready(nxt);
            if constexpr (SP2) {
            PG8_LDB(B0, 0, 0); PG8_LDB(B1, 0, 1); PG8_SCHED; PG8_LDA(At, 0, 0); PG8_STAGE(PG8_SA(1, 1), a1 + hstepA, voffA);
            PG8_WAIT_V(8); PG8_WAIT_L(0); PG8_BAR; PG8_MMA(0, 0, At, B0); PG8_MMA(0, 1, At, B1); PG8_BAR; PG8_SCHED;
            PG8_LDA(At, 0, 1); PG8_STAGE(PG8_SB(0, 0), b2, voffB); PG8_STAGE(PG8_SB(0, 1), b2 + hstepB, voffB); PG8_STAGE(PG8_SA(0, 0), a2, voffA);
            PG8_WAIT_V(8); PG8_WAIT_L(0); PG8_BAR; PG8_MMA(1, 0, At, B0); PG8_MMA(1, 1, At, B1); PG8_BAR; PG8_SCHED;
            PG8_LDB(B0, 1, 0); PG8_LDB(B1, 1, 1); PG8_SCHED; PG8_LDA(At, 1, 0); PG8_STAGE(PG8_SA(0, 1), a2 + hstepA, voffA);
            PG8_WAIT_V(8); PG8_WAIT_L(0); PG8_BAR; PG8_MMA(0, 0, At, B0); PG8_MMA(0, 1, At, B1); PG8_BAR; PG8_SCHED;
            PG8_LDA(At, 1, 1); PG8_STAGE(PG8_SB(1, 0), b3, voffB); PG8_STAGE(PG8_SB(1, 1), b3 + hstepB, voffB); PG8_STAGE(PG8_SA(1, 0), a3, voffA);
            PG8_WAIT_V(8); PG8_WAIT_L(0); PG8_BAR; PG8_MMA(1, 0, At, B0); PG8_MMA(1, 1, At, B1); PG8_BAR; PG8_SCHED;
            } else {
            PG8_LDB(B0, 0, 0); PG8_SCHED; PG8_LDA(At, 0, 0); PG8_STAGE(PG8_SA(1, 1), a1 + hstepA, voffA);
            PG8_WAIT_L(8); PG8_BAR; PG8_WAIT_L(0); PG8_MMA(0, 0, At, B0); PG8_BAR; PG8_SCHED;
            PG8_LDB(B1, 0, 1); PG8_STAGE(PG8_SB(0, 0), b2, voffB);
            PG8_BAR; PG8_WAIT_L(0); PG8_MMA(0, 1, At, B1); PG8_BAR;
            PG8_LDA(At, 0, 1); PG8_STAGE(PG8_SA(0, 0), a2, voffA);
            PG8_BAR; PG8_WAIT_L(0); PG8_MMA(1, 0, At, B0); PG8_BAR; PG8_SCHED;
            PG8_STAGE(PG8_SB(0, 1), b2 + hstepB, voffB);
            PG8_WAIT_V(6); PG8_BAR; PG8_MMA(1, 1, At, B1); PG8_BAR;
            PG8_LDB(B0, 1, 0); PG8_SCHED; PG8_LDA(At, 1, 0); PG8_STAGE(PG8_SA(0, 1), a2 + hstepA, voffA);
            PG8_WAIT_L(8); PG8_BAR; PG8_WAIT_L(0); PG8_MMA(0, 0, At, B0); PG8_BAR; PG8_SCHED;
            PG8_LDB(B1, 1, 1); PG8_STAGE(PG8_SB(1, 0), b3, voffB);
            PG8_BAR; PG8_WAIT_L(0); PG8_MMA(0, 1, At, B1); PG8_BAR;
            PG8_LDA(At, 1, 1); PG8_STAGE(PG8_SA(1, 0), a3, voffA);
            PG8_BAR; PG8_WAIT_L(0); PG8_MMA(1, 0, At, B0); PG8_BAR; PG8_SCHED;
            PG8_STAGE(PG8_SB(1, 1), b3 + hstepB, voffB);
            PG8_WAIT_V(6); PG8_BAR; PG8_MMA(1, 1, At, B1); PG8_BAR;
            }
        }
        if constexpr (ALIGN_EPI) { if (wr == 0) PG8_BAR; }
        if constexpr (!Epi::AFTER_DRAIN) { E(acc, cur, wr, wc, fr, fq); S.done(cur); }
        if (!has_next) break;
#pragma unroll
        for (int a = 0; a < 2; ++a)
#pragma unroll
            for (int b = 0; b < 2; ++b)
#pragma unroll
                for (int m = 0; m < 4; ++m)
#pragma unroll
                    for (int n = 0; n < 2; ++n) acc[a][b][m][n] = (f32x4){0.f, 0.f, 0.f, 0.f};
        cur = nxt; cA = nA; cB = nB; ++ui;
        if constexpr (ALIGN_EPI) { if (wr == 1) PG8_BAR; }
    }
    PG8_WAIT_V(0);
    if constexpr (!ALIGN_EPI) { if (wr == 0) PG8_BAR; }
    PG8_BAR;
    if constexpr (Epi::AFTER_DRAIN) { E.fused(acc, cur, wr, wc, fr, fq, lds, wid, lane); S.done(cur); }
#undef PG8_KP
#undef PG8_SA
#undef PG8_SB
#undef PG8_STAGE
#undef PG8_LDA
#undef PG8_LDB
#undef PG8_MMA
#undef PG8_WAIT_V
#undef PG8_WAIT_L
#undef PG8_BAR
#undef PG8_SCHED
}
}
#define XB_TMO      128
#define XB_XCNT(j)  (256  + 64 * (j))
#define XB_XSUB(j)  (1280 + 64 * (j))
#define XB_XGEN(j)  (2304 + 64 * (j))
#define XB_TOP      3328
#define XB_TOPGEN   3392
#define XCD_BAR_WORDS 3456
#define XB_SPIN_CAP (1u << 18)

__device__ __forceinline__ unsigned xb_ld(unsigned* p)              { return __hip_atomic_load(p, __ATOMIC_RELAXED, __HIP_MEMORY_SCOPE_AGENT); }
__device__ __forceinline__ unsigned xb_add(unsigned* p, unsigned v) { return __hip_atomic_fetch_add(p, v, __ATOMIC_RELAXED, __HIP_MEMORY_SCOPE_AGENT); }
__device__ __forceinline__ unsigned xb_xcc_id() { return (unsigned)__builtin_amdgcn_s_getreg((3 << 11) | 20) & 0xFu; }
#define XB_SPIN(cond, bar) do { unsigned _sp = 0; while (cond) { __builtin_amdgcn_s_sleep(1); \
    if ((++_sp & 255u) == 0u) { if (xb_ld(&(bar)[XB_TMO])) break; if (_sp > XB_SPIN_CAP) { atomicAdd(&(bar)[XB_TMO], 1u); break; } } } } while (0)

struct XcdBarrier {
    unsigned* bar; unsigned x;
    volatile LAS unsigned* st;
};

__device__ __forceinline__ XcdBarrier xcd_barrier_post(unsigned* bar, volatile LAS unsigned* st) {
    XcdBarrier b; b.bar = bar; b.x = xb_xcc_id(); b.st = st;
    if (threadIdx.x == 0) (void)xb_add(&bar[XB_XCNT(b.x)], 1u);
    return b;
}
__device__ __forceinline__ void xcd_barrier_complete(unsigned* bar, unsigned x, unsigned& nloc, unsigned& nx) {
    const unsigned G = gridDim.x * gridDim.y * gridDim.z;
    unsigned sum, cnt, mine, sp = 0u;
    for (;;) {
        sum = 0u; cnt = 0u; mine = 0u;
#pragma unroll
        for (unsigned j = 0; j < 16; ++j) { const unsigned c = xb_ld(&bar[XB_XCNT(j)]); sum += c; cnt += (c > 0u) ? 1u : 0u; mine = (j == x) ? c : mine; }
        if (sum == G) break;
        __builtin_amdgcn_s_sleep(1);
        if ((++sp & 255u) == 0u) { if (xb_ld(&bar[XB_TMO])) break; if (sp > XB_SPIN_CAP) { atomicAdd(&bar[XB_TMO], 1u); break; } }
    }
    nloc = mine > 0u ? mine : 1u; nx = cnt > 0u ? cnt : 1u;
}

__device__ __forceinline__ void xcd_barrier(const XcdBarrier& b) {
    asm volatile("s_waitcnt vmcnt(0)" ::: "memory");
    __syncthreads();
    if (threadIdx.x == 0) {
        unsigned* bar = b.bar;
        __builtin_amdgcn_s_waitcnt(0);
        unsigned nloc = b.st[0], nx = b.st[1];
        if (nloc == 0u) { xcd_barrier_complete(bar, b.x, nloc, nx); b.st[0] = nloc; b.st[1] = nx; }
        const unsigned old = xb_add(&bar[XB_XSUB(b.x)], 1u);
        const unsigned gen = old / nloc;
        if (old + 1u == (gen + 1u) * nloc) {
            __builtin_amdgcn_fence(__ATOMIC_RELEASE, "agent");
            asm volatile("s_waitcnt vmcnt(0)" ::: "memory");
            const unsigned og = xb_add(&bar[XB_TOP], 1u);
            const unsigned tg = og / nx;
            if (og + 1u == (tg + 1u) * nx) xb_add(&bar[XB_TOPGEN], 1u);
            else XB_SPIN(xb_ld(&bar[XB_TOPGEN]) == tg, bar);
            __builtin_amdgcn_fence(__ATOMIC_ACQUIRE, "agent");
            xb_add(&bar[XB_XGEN(b.x)], 1u);
            asm volatile("s_waitcnt vmcnt(0)" ::: "memory");
        } else {
            XB_SPIN(xb_ld(&bar[XB_XGEN(b.x)]) == gen, bar);
            __builtin_amdgcn_fence(__ATOMIC_ACQUIRE, "agent");
            asm volatile("s_waitcnt vmcnt(0)" ::: "memory");
        }
    }
    __syncthreads();
}
template <int MODE> __device__ __forceinline__ int dest_row(int n) {
    if (MODE == 1) { if (n < 7680) return n; if (n < 7744) { const int i = n - 7680; return 15872 + (i < 32 ? 2 * i : 2 * (i - 32) + 1); } return n - 64; }
    if (MODE == 2) { const int h = n / 192, j = n - h * 192; if (j < 128) return n; const int i = j - 128; return h * 192 + 128 + (i < 32 ? 2 * i : 2 * (i - 32) + 1); }
    if (MODE == 3) { const int isv = n >= DFF ? 1 : 0, ch = n - isv * DFF; return (ch >> 7) * 256 + isv * 128 + (ch & 127); }
    return n;
}
template <int MODE>
__device__ __forceinline__ void tr_item(const float* W, int K, int N, const float* gk, bf16* WT, LAS unsigned* scr, int kb, int nb, int lane, int ldk = 0, int kofs = 0) {
    const int k0 = kb * 64, n0 = nb * 64;
    const float* src = W + (size_t)k0 * N + n0 + lane;
#pragma unroll
    for (int i = 0; i < 32; ++i) {
        float a = src[(size_t)(2 * i) * N], b = src[(size_t)(2 * i + 1) * N];
        if (gk) { a *= gk[k0 + 2 * i]; b *= gk[k0 + 2 * i + 1]; }
        scr[i * 65 + lane] = cvt_pk(a, b);
    }
    LDS_WAIT(); asm volatile("" ::: "memory");
    const int c = lane & 7;
#pragma unroll
    for (int j = 0; j < 8; ++j) { const int n = (lane >> 3) + 8 * j; const LAS unsigned* s = scr + (4 * c) * 65 + n;
        v4u o; o.x = s[0]; o.y = s[65]; o.z = s[130]; o.w = s[195];
        *(GAS v4u*)(WT + (size_t)dest_row<MODE>(n0 + n) * (ldk ? ldk : K) + kofs + k0 + 8 * c) = o; }
    LDS_WAIT(); asm volatile("" ::: "memory");
}

struct Ptrs {
    const float* x; const int* pos; const float* w_in; const float* b_gate; const float *lq1, *lk1, *lq2, *lk2; const float* subln_g; const float *qn_g, *kvn_g;
    const float *w_uq, *w_ukv, *w_pa, *w_pb, *w_out, *ln1_g, *ln1_b, *w_up, *conv_w, *conv_b, *w_down, *ln2_g, *ln2_b;
    float* out; unsigned char* ws;
};

__device__ __forceinline__ void p0_prologue(const Ptrs& P, LAS unsigned char* lds, int vcu, int G, int wave, int lane) {
    LAS unsigned* scr = (LAS unsigned*)(lds + wave * 8448);
    const int gw = vcu * NWAVES + wave, NGW = G * NWAVES;
    unsigned char* ws = P.ws;
    constexpr int I_IN = (IN_COLS / 64) * (DM / 64), I_UQ = (3072 / 64) * (1024 / 64), I_UKV = (4096 / 64) * (512 / 64), I_PA = (4096 / 64) * (2048 / 64), I_OUT = (4096 / 64) * (4096 / 64),
                  I_UP = (22016 / 64) * (4096 / 64), I_DN = (4096 / 64) * (DFF / 64);
    constexpr int NITEMS = I_IN + I_UQ + I_UKV + 2 * I_PA + I_OUT + I_UP + I_DN;
    for (int it = gw; it < NITEMS; it += NGW) {
        int r = it;
        if (r < I_IN)  { tr_item<1>(P.w_in, DM, IN_COLS, nullptr, (bf16*)(ws + WS_WIN), scr, r % (DM / 64), r / (DM / 64), lane); continue; } r -= I_IN;
        if (r < I_UQ)  { tr_item<2>(P.w_uq, 1024, 3072, P.qn_g, (bf16*)(ws + WS_WUQ), scr, r % 16, r / 16, lane); continue; } r -= I_UQ;
        if (r < I_UKV) { tr_item<0>(P.w_ukv, 512, 4096, P.kvn_g, (bf16*)(ws + WS_WUKV), scr, r % 8, r / 8, lane); continue; } r -= I_UKV;
        if (r < I_PA)  { tr_item<0>(P.w_pa, 2048, 4096, nullptr, (bf16*)(ws + WS_WPA), scr, r % 32, r / 32, lane, 4096, 0); continue; } r -= I_PA;
        if (r < I_PA)  { tr_item<0>(P.w_pb, 2048, 4096, nullptr, (bf16*)(ws + WS_WPA), scr, r % 32, r / 32, lane, 4096, 2048); continue; } r -= I_PA;
        if (r < I_OUT) { tr_item<0>(P.w_out, 4096, 4096, nullptr, (bf16*)(ws + WS_WOUT), scr, r % 64, r / 64, lane); continue; } r -= I_OUT;
        if (r < I_UP)  { tr_item<3>(P.w_up, 4096, 22016, nullptr, (bf16*)(ws + WS_WUP), scr, r % 64, r / 64, lane); continue; } r -= I_UP;
        tr_item<0>(P.w_down, DFF, 4096, nullptr, (bf16*)(ws + WS_WDN), scr, r % (DFF / 64), r / (DFF / 64), lane);
    }
    { const size_t n8 = (size_t)M * DM / 8; GAS v4u* xb = (GAS v4u*)(ws + WS_XB);
      for (size_t i = (size_t)gw * 64 + lane; i < n8; i += (size_t)NGW * 64) { const f32x4 a = *(const GAS f32x4*)(P.x + i * 8), b = *(const GAS f32x4*)(P.x + i * 8 + 4);
          v4u o; o.x = cvt_pk(a[0], a[1]); o.y = cvt_pk(a[2], a[3]); o.z = cvt_pk(b[0], b[1]); o.w = cvt_pk(b[2], b[3]); xb[i] = o; } }
    { GAS v4u* z = (GAS v4u*)(ws + WS_WIN + (size_t)IN_COLS * DM * 2); const size_t nz = (size_t)(N1 - IN_COLS) * DM * 2 / 16;
      for (size_t i = (size_t)gw * 64 + lane; i < nz; i += (size_t)NGW * 64) z[i] = (v4u){0u, 0u, 0u, 0u};
    }
    { GAS float* rt = (GAS float*)(ws + WS_ROPE);
      for (int i = gw * 64 + lane; i < M * 32; i += NGW * 64) { const int m = i >> 5, k = i & 31;
          const double inv = exp2(-(double)k * (13.287712379549449 / 32.0));
          const double rev = (double)P.pos[m] * inv * 0.15915494309189535;
          const float fr = (float)(rev - rint(rev));
          rt[(size_t)m * 64 + k] = __builtin_amdgcn_cosf(fr); rt[(size_t)m * 64 + 32 + k] = __builtin_amdgcn_sinf(fr); } }
}

namespace att {
__device__ __forceinline__ void glds16(const void* sbase, unsigned voff, unsigned lds_dst) {
    unsigned keep;
    asm volatile("s_mov_b32 %0, m0\n\ts_mov_b32 m0, %3\n\ts_nop 0\n\tglobal_load_lds_dwordx4 %1, %2\n\ts_mov_b32 m0, %0" : "=&s"(keep) : "v"(voff), "s"(sbase), "s"(lds_dst) : "memory");
}
__device__ __forceinline__ int v_rd_base(int lane) { return ((lane & 3) << 3) | (((lane >> 2) & 3) << 6) | (((lane >> 4) & 1) << 5) | (((lane >> 5) & 1) << 8); }
#define ATT_BAR() asm volatile("s_barrier" ::: "memory")

template <int DQK, int DV, bool ALIBI>
__device__ __forceinline__ void attn_block(LAS unsigned char* lds, const unsigned char* wsb, const bf16* Q, int ldq, unsigned kofs, unsigned ldkB, unsigned vofs, unsigned ldvB,
                                           int qb, float slope2, f32x16 (&o)[DV / 32], float& l_out) {
    constexpr int NQF = DQK / 16, NOD = DV / 32, KROW = DQK * 2, KT = 64 * KROW, VT = 64 * DV * 2, KCH = DQK / 8, NKI = KT / 8192, NVI = VT / 8192;
    const int tid = threadIdx.x, wid = __builtin_amdgcn_readfirstlane(tid >> 6), lane = tid & 63, r32 = lane & 31, hi = lane >> 5;
    const unsigned ldsb = (unsigned)(uintptr_t)lds;
    __builtin_assume(qb >= 0); __builtin_assume(qb < 32);
    const int NT = 4 * (qb + 1);
    constexpr bool KEEP = (DV == 128);
    constexpr int NB = (DV == 128) ? 3 : 2;
    static_assert(NB * (KT + VT) <= RING_BYTES, "tile buffers must fit the ring");
#define KSW(cs_, row_) (DQK == 128 ? ((cs_) ^ ((row_) & 15)) : (((cs_) & ~7) | (((cs_) ^ ((row_) >> 1)) & 7)))
    unsigned krel[NKI], vrel[NVI];
#pragma unroll
    for (int j = 0; j < (KEEP ? NKI : 1); ++j) { const int p = (j * 8 + wid) * 64 + lane, row = p / KCH, cs = p - row * KCH, c = KSW(cs, row); krel[j] = kofs + (unsigned)row * ldkB + (unsigned)c * 16u; }
#pragma unroll
    for (int j = 0; j < (KEEP ? NVI : 1); ++j) { const int p = (j * 8 + wid) * 64 + lane, s = p >> 5, rr = (p & 31) >> 2, cc = p & 3, kg = s / NOD, d0 = s - kg * NOD, kk = kg * 8 + rr;
        const int key = (kk & ~0xC) | ((kk & 4) << 1) | ((kk & 8) >> 1); vrel[j] = vofs + (unsigned)key * ldvB + (unsigned)(d0 * 32 + cc * 8) * 2u; }
    static_assert(KEEP || (KCH == 16 && NOD == 8), "the one-offset form assumes a piece step of 32 K rows = 16 V keys");
#define ATT_ISSUE(t_, bf_) do { const unsigned kb_ = (unsigned)(t_) * 64u; \
        if (KEEP) { \
        _Pragma("unroll") for (int j = 0; j < NKI; ++j) glds16(wsb, krel[j] + kb_ * ldkB, (unsigned)__builtin_amdgcn_readfirstlane(ldsb + (bf_) * KT + (j * 8 + wid) * 1024)); \
        _Pragma("unroll") for (int j = 0; j < NVI; ++j) glds16(wsb, vrel[j] + kb_ * ldvB, (unsigned)__builtin_amdgcn_readfirstlane(ldsb + NB * KT + (bf_) * VT + (j * 8 + wid) * 1024)); \
        } else { \
        _Pragma("unroll") for (int j = 0; j < NKI; ++j) glds16(wsb + (size_t)(kb_ + 32u * j) * ldkB, krel[0], (unsigned)__builtin_amdgcn_readfirstlane(ldsb + (bf_) * KT + (j * 8 + wid) * 1024)); \
        _Pragma("unroll") for (int j = 0; j < NVI; ++j) glds16(wsb + (size_t)(kb_ + 16u * j) * ldvB, vrel[0], (unsigned)__builtin_amdgcn_readfirstlane(ldsb + NB * KT + (bf_) * VT + (j * 8 + wid) * 1024)); } } while (0)
    ATT_BAR();
    ATT_ISSUE(NT - 1, 0);
    if (NB == 3) ATT_ISSUE(NT - 2, 1);
    bf16x8 qr[NQF];
#pragma unroll
    for (int d0 = 0; d0 < NQF; ++d0) qr[d0] = *(const bf16x8*)(Q + (size_t)(wid * 32 + r32) * ldq + d0 * 16 + hi * 8);
    float m_reg = -1e30f, l_reg = 0.f;
#pragma unroll
    for (int d0 = 0; d0 < NOD; ++d0)
#pragma unroll
        for (int r = 0; r < 16; ++r) o[d0][r] = 0.f;
    const int qi = qb * 256 + wid * 32 + r32;
    asm volatile(".p2align 6");
    int bf = NB == 3 ? -1 : 0;
    for (int i = 0; i < NT; ++i) {
        const int t = NT - 1 - i;
        if (NB == 3) { if (++bf == 3) bf = 0;
            if (i + 1 < NT) asm volatile("s_waitcnt vmcnt(%0)\n\ts_barrier" :: "n"(NKI + NVI) : "memory"); else asm volatile("s_waitcnt vmcnt(0)\n\ts_barrier" ::: "memory");
        } else { bf = i & 1;
            asm volatile("s_waitcnt vmcnt(0)\n\ts_barrier" ::: "memory");
        }
        const int bfn = bf == 0 ? 2 : bf - 1;
        const int jb = t - 4 * qb;
        if (!(jb > (wid >> 1))) {
        f32x16 p0, p1;
        if (ALIBI) {
            float s2o = slope2; asm volatile("" : "+v"(s2o));
            const float h4 = s2o * (float)(4 * hi);
#pragma unroll
            for (int r = 0; r < 16; ++r) { const float cr = (float)((r & 3) + 8 * (r >> 2)); p0[r] = __builtin_fmaf(s2o, cr, h4); p1[r] = __builtin_fmaf(s2o, cr + 32.f, h4); }
        } else {
#pragma unroll
            for (int r = 0; r < 16; ++r) { p0[r] = 0.f; p1[r] = 0.f; }
        }
        { const LAS unsigned char* kt = lds + bf * KT + r32 * KROW;
          const LAS unsigned char* kb4[4];
          const int key = DQK == 128 ? r32 : (r32 >> 1), hb = DQK == 128 ? ((r32 >> 3) & 1) : 0;
#pragma unroll
          for (int dd = 0; dd < 4; ++dd) kb4[dd] = kt + ((((dd * 2 + hi) ^ key) & 7) << 4) + hb * 128;
#define ATT_KADDR(d0_) (DQK == 128 ? kb4[(d0_) & 3] + (((d0_) >> 2) ? 128 - 256 * hb : 0) : kb4[(d0_) & 3] + ((d0_) >> 2) * 128)
          constexpr int PFD = (DV == 128) ? 2 : 0;
          bf16x8 kf[PFD + 1][2];
#pragma unroll
          for (int d0 = 0; d0 < PFD; ++d0) { const LAS unsigned char* a = ATT_KADDR(d0); kf[d0][0] = *(const LAS bf16x8*)a; kf[d0][1] = *(const LAS bf16x8*)(a + 32 * KROW); }
#pragma unroll
          for (int d0 = 0; d0 < NQF; ++d0) {
              if (d0 + PFD < NQF) { const LAS unsigned char* a = ATT_KADDR(d0 + PFD); kf[(d0 + PFD) % (PFD + 1)][0] = *(const LAS bf16x8*)a; kf[(d0 + PFD) % (PFD + 1)][1] = *(const LAS bf16x8*)(a + 32 * KROW); }
              if (PFD) __builtin_amdgcn_sched_barrier(0);
              p0 = __builtin_amdgcn_mfma_f32_32x32x16_bf16(kf[d0 % (PFD + 1)][0], qr[d0], p0, 0, 0, 0);
              p1 = __builtin_amdgcn_mfma_f32_32x32x16_bf16(kf[d0 % (PFD + 1)][1], qr[d0], p1, 0, 0, 0);
              if (PFD) __builtin_amdgcn_sched_barrier(0); }
#undef ATT_KADDR
        }
        __builtin_amdgcn_sched_barrier(0);
        const int kb = t * 64;
        float bq = 0.f;
        if (ALIBI) bq = slope2 * (float)(kb - qi);
        if (jb == (wid >> 1)) { const int dq = qi - kb - 4 * hi; const float NEG = -__builtin_inff();
#pragma unroll
            for (int r = 0; r < 16; ++r) { const int c = (r & 3) + 8 * (r >> 2); if (c > dq) p0[r] = NEG; if (c + 32 > dq) p1[r] = NEG; } }
        float pmax = p0[0];
#pragma unroll
        for (int r = 1; r < 16; ++r) pmax = fmaxf(pmax, p0[r]);
#pragma unroll
        for (int r = 0; r < 16; ++r) pmax = fmaxf(pmax, p1[r]);
        { auto rr = __builtin_amdgcn_permlane32_swap(__float_as_uint(pmax), __float_as_uint(pmax), false, false); pmax = fmaxf(__uint_as_float(rr[0]), __uint_as_float(rr[1])); }
        const float mx = pmax + bq;
        float alpha = 1.f;
        if (!__all(mx - m_reg <= 8.f)) { const float mn = fmaxf(m_reg, mx); alpha = __builtin_amdgcn_exp2f(m_reg - mn); m_reg = mn;
#pragma unroll
            for (int d0 = 0; d0 < NOD; ++d0)
#pragma unroll
                for (int r = 0; r < 16; ++r) o[d0][r] *= alpha; }
        if (NB == 2 && i + 1 < NT) ATT_ISSUE(t - 1, bf ^ 1);
        const float ms = m_reg - bq;
        float ps = 0.f;
#pragma unroll
        for (int r = 0; r < 16; ++r) { p0[r] = __builtin_amdgcn_exp2f(p0[r] - ms); ps += p0[r]; }
#pragma unroll
        for (int r = 0; r < 16; ++r) { p1[r] = __builtin_amdgcn_exp2f(p1[r] - ms); ps += p1[r]; }
        { auto rr = __builtin_amdgcn_permlane32_swap(__float_as_uint(ps), __float_as_uint(ps), false, false); ps = __uint_as_float(rr[0]) + __uint_as_float(rr[1]); }
        l_reg = l_reg * alpha + ps;
        bf16x8 pa0, pa1, pa2, pa3;
#define ATT_PK4(P, B_, OUT) do { const unsigned a0 = cvt_pk(P[B_ + 0], P[B_ + 1]), a1 = cvt_pk(P[B_ + 2], P[B_ + 3]), b0 = cvt_pk(P[B_ + 4], P[B_ + 5]), b1 = cvt_pk(P[B_ + 6], P[B_ + 7]); \
        auto r0 = __builtin_amdgcn_permlane32_swap(a0, b0, false, false); auto r1 = __builtin_amdgcn_permlane32_swap(a1, b1, false, false); \
        v4u w = {r0[0], r1[0], r0[1], r1[1]}; OUT = __builtin_bit_cast(bf16x8, w); } while (0)
        ATT_PK4(p0, 0, pa0); ATT_PK4(p0, 8, pa1); ATT_PK4(p1, 0, pa2); ATT_PK4(p1, 8, pa3);
#undef ATT_PK4
        __builtin_amdgcn_sched_barrier(0);
        { const unsigned vb0 = ldsb + NB * KT + bf * VT + v_rd_base(lane);
#define ATT_TRRD(dst, off) asm volatile("ds_read_b64_tr_b16 %0, %1 offset:%2" : "=&v"(dst) : "v"(vb0), "i"(off) : "memory")
#pragma unroll
          for (int d0 = 0; d0 < NOD; ++d0) { s16x4 l0, l1, l2, l3, h0, h1, h2, h3;
              ATT_TRRD(l0, (0 * NOD + d0) * 512); ATT_TRRD(h0, (1 * NOD + d0) * 512); ATT_TRRD(l1, (2 * NOD + d0) * 512); ATT_TRRD(h1, (3 * NOD + d0) * 512);
              ATT_TRRD(l2, (4 * NOD + d0) * 512); ATT_TRRD(h2, (5 * NOD + d0) * 512); ATT_TRRD(l3, (6 * NOD + d0) * 512); ATT_TRRD(h3, (7 * NOD + d0) * 512);
              asm volatile("s_waitcnt lgkmcnt(0)" ::: "memory"); __builtin_amdgcn_sched_barrier(0);
              o[d0] = __builtin_amdgcn_mfma_f32_32x32x16_bf16((bf16x8){l0[0], l0[1], l0[2], l0[3], h0[0], h0[1], h0[2], h0[3]}, pa0, o[d0], 0, 0, 0);
              o[d0] = __builtin_amdgcn_mfma_f32_32x32x16_bf16((bf16x8){l1[0], l1[1], l1[2], l1[3], h1[0], h1[1], h1[2], h1[3]}, pa1, o[d0], 0, 0, 0);
              o[d0] = __builtin_amdgcn_mfma_f32_32x32x16_bf16((bf16x8){l2[0], l2[1], l2[2], l2[3], h2[0], h2[1], h2[2], h2[3]}, pa2, o[d0], 0, 0, 0);
              o[d0] = __builtin_amdgcn_mfma_f32_32x32x16_bf16((bf16x8){l3[0], l3[1], l3[2], l3[3], h3[0], h3[1], h3[2], h3[3]}, pa3, o[d0], 0, 0, 0); }
#undef ATT_TRRD
        }
        }
        if (NB == 3 && i + 2 < NT) ATT_ISSUE(t - 2, bfn);
        if (NB == 2 && (jb > (wid >> 1)) && i + 1 < NT) ATT_ISSUE(t - 1, bf ^ 1);
    }
#undef ATT_ISSUE
#undef KSW
    l_out = l_reg;
}

#define ATT_ST_PAIR(row_, colg_, A_, B_) do { v2u a_ = (A_), b_ = (B_); \
        auto rx_ = __builtin_amdgcn_permlane32_swap(a_.x, b_.x, false, false); auto ry_ = __builtin_amdgcn_permlane32_swap(a_.y, b_.y, false, false); \
        *(v4u*)((row_) + (colg_) + 8 * hi) = (v4u){rx_[0], ry_[0], rx_[1], ry_[1]}; } while (0)
constexpr int CW_ATTQ = 8192, CW_NMAX = 12288;
__device__ __forceinline__ void attn_phase(const Ptrs& P, LAS unsigned char* lds, volatile LAS unsigned* MISC, gu32* ctl, int qoff) {
    const int tid = threadIdx.x, wid = __builtin_amdgcn_readfirstlane(tid >> 6), lane = tid & 63, r32 = lane & 31, hi = lane >> 5;
    unsigned char* ws = P.ws;
    const bf16* QKV = (const bf16*)(ws + WS_QKV); const bf16* QB = (const bf16*)(ws + WS_QB); bf16* OAB = (bf16*)(ws + WS_OAB);
    float lam;
    { const float s1 = wave_sum(P.lq1[lane] * P.lk1[lane] + P.lq1[lane + 64] * P.lk1[lane + 64]), s2 = wave_sum(P.lq2[lane] * P.lk2[lane] + P.lq2[lane + 64] * P.lk2[lane + 64]);
      lam = expf(s1) - expf(s2) + LAMBDA_INIT; }
    const int q0 = (int)(xb_xcc_id() & 7u);
    if (tid < 64) MISC[64 + tid] = 0u;
    __syncthreads();
    { const int w = tid & 63; unsigned mx = 0u; const GAS unsigned* part = (const GAS unsigned*)(ws + WS_NPART);
      for (int g = tid >> 6; g < (int)gridDim.x; g += 8) { const unsigned v = part[g * 64 + w]; mx = v > mx ? v : mx; }
      __hip_atomic_fetch_max((LAS unsigned*)(MISC + 64 + w), mx, __ATOMIC_RELAXED, __HIP_MEMORY_SCOPE_WORKGROUP); }
    __syncthreads();
    if (tid < 32) { const int b = tid >> 4, h = (tid >> 1) & 7, map = tid & 1;
        const float nq = __uint_as_float(MISC[64 + (b * 16 + h * 2 + map) * 2]), nk = __uint_as_float(MISC[64 + (b * 16 + h * 2 + map) * 2 + 1]);
        const float slope2 = LOG2E * exp2f(-(float)(h + 1));
        const float B = sqrtf(nq * nk) * 1.001f + 0.01f, Wf = (2.f * B + 126.f) / slope2;
        const float wq = ceilf(Wf * (1.0001f / 256.f) + 0.001f);
        MISC[32 + tid] = wq < 1000.f ? (unsigned)wq : 1000u; }
    __syncthreads();
    for (int dq = 0; dq < 8; ++dq) {
        const int q = (q0 + dq) & 7, b = q >> 2, qx = q & 3;
        for (;;) {
            if (tid == 0) MISC[16] = __hip_atomic_fetch_add((unsigned*)(ctl + CW_ATTQ + qoff + 64 * q), 1u, __ATOMIC_RELAXED, __HIP_MEMORY_SCOPE_AGENT);
            __syncthreads();
            const int n = (int)__builtin_amdgcn_readfirstlane(MISC[16]);
            __syncthreads();
            if (n >= 64) break;
            const int h = (n < 32) ? 7 - qx : qx, qb = 31 - (n & 31);
            const float slope2 = LOG2E * exp2f(-(float)(h + 1));
            unsigned char* scrb = ws + WS_O0 + (size_t)blockIdx.x * 262144 + (size_t)wid * 32768;
            const size_t rowq = (size_t)b * SEQ + (size_t)qb * 256;
#pragma unroll 1
            for (int map = 0; map < 2; ++map) {
                int qs = qb - (int)MISC[32 + (b * 8 + h) * 2 + map]; qs = __builtin_amdgcn_readfirstlane(qs > 0 ? qs : 0);
                f32x16 o[8]; float l;
                attn_block<128, 256, true>(lds, ws, QKV + rowq * 6144 + h * 256 + map * 128, 6144,
                                           (unsigned)(WS_QKV + (((size_t)b * SEQ + (size_t)qs * 256) * 6144 + 2048 + h * 256 + map * 128) * 2), 12288u,
                                           (unsigned)(WS_QKV + (((size_t)b * SEQ + (size_t)qs * 256) * 6144 + 4096 + h * 256) * 2), 12288u, qb - qs, slope2, o, l);
                const float inv = 1.f / l;
                unsigned so = (unsigned)lane * 16u; asm volatile("" : "+v"(so));
                f32x4* scr = (f32x4*)(scrb + so);
                if (map == 0) {
#pragma unroll
                    for (int d0 = 0; d0 < 8; ++d0)
#pragma unroll
                        for (int g = 0; g < 4; ++g) scr[(d0 * 4 + g) * 64] = (f32x4){o[d0][4 * g] * inv, o[d0][4 * g + 1] * inv, o[d0][4 * g + 2] * inv, o[d0][4 * g + 3] * inv};
                } else {
                    const float li = lam * inv; float ss = 0.f;
#pragma unroll
                    for (int d0 = 0; d0 < 8; ++d0) {
#pragma unroll
                        for (int g = 0; g < 4; ++g) { const f32x4 a = scr[(d0 * 4 + g) * 64];
#pragma unroll
                            for (int e = 0; e < 4; ++e) { const float v = a[e] - li * o[d0][4 * g + e]; ss += v * v; } }
                        asm volatile("" : "+v"(ss) :: "memory"); }
                    { auto rr = __builtin_amdgcn_permlane32_swap(__float_as_uint(ss), __float_as_uint(ss), false, false); ss = __uint_as_float(rr[0]) + __uint_as_float(rr[1]); }
                    const float rs = __builtin_amdgcn_rsqf(ss * (1.f / 256.f) + RMS_EPS) * (1.f - LAMBDA_INIT);
                    unsigned oo = (unsigned)((wid * 32 + r32) * 4096) * 2u; asm volatile("" : "+v"(oo));
                    bf16* orow = (bf16*)((unsigned char*)(OAB + rowq * 4096 + h * 256) + oo);
#pragma unroll
                    for (int d0 = 0; d0 < 8; ++d0) {
#pragma unroll
                        for (int g = 0; g < 4; g += 2) { v2u w[2];
#pragma unroll
                            for (int q = 0; q < 2; ++q) { const f32x4 a = scr[(d0 * 4 + g + q) * 64]; const f32x4 gg = *(const f32x4*)(P.subln_g + d0 * 32 + 8 * (g + q) + 4 * hi);
                                float v[4];
#pragma unroll
                                for (int e = 0; e < 4; ++e) v[e] = (a[e] - li * o[d0][4 * (g + q) + e]) * rs * gg[e];
                                w[q].x = cvt_pk(v[0], v[1]); w[q].y = cvt_pk(v[2], v[3]); }
                            ATT_ST_PAIR(orow, d0 * 32 + 8 * g, w[0], w[1]); }
                        asm volatile("" ::: "memory"); }
                }
            }
        }
    }
    for (int dq = 0; dq < 8; ++dq) {
        const int q = (q0 + dq) & 7, b = q >> 2, qx = q & 3;
        for (;;) {
            if (tid == 0) MISC[16] = __hip_atomic_fetch_add((unsigned*)(ctl + CW_ATTQ + qoff + 64 * (8 + q)), 1u, __ATOMIC_RELAXED, __HIP_MEMORY_SCOPE_AGENT);
            __syncthreads();
            const int n = (int)__builtin_amdgcn_readfirstlane(MISC[16]);
            __syncthreads();
            if (n >= 128) break;
            const int h = 4 * qx + (n & 3), qb = 31 - (n >> 2);
            const size_t rowq = (size_t)b * SEQ + (size_t)qb * 256;
            f32x16 o[4]; float l;
            const unsigned kofs = (unsigned)(WS_KVB + ((size_t)b * SEQ * KVLD + h * 320) * 2);
            attn_block<192, 128, false>(lds, ws, QB + rowq * 3072 + h * 192, 3072, kofs, (unsigned)(KVLD * 2), kofs + 384u, (unsigned)(KVLD * 2), qb, 0.f, o, l);
            const float inv = 1.f / l;
            unsigned oo = (unsigned)((wid * 32 + r32) * 4096) * 2u; asm volatile("" : "+v"(oo));
            bf16* orow = (bf16*)((unsigned char*)(OAB + rowq * 4096 + 2048 + h * 128) + oo);
#pragma unroll
            for (int d0 = 0; d0 < 4; ++d0)
#pragma unroll
                for (int g = 0; g < 4; g += 2) { v2u w0, w1;
                    w0.x = cvt_pk(o[d0][4 * g] * inv, o[d0][4 * g + 1] * inv); w0.y = cvt_pk(o[d0][4 * g + 2] * inv, o[d0][4 * g + 3] * inv);
                    w1.x = cvt_pk(o[d0][4 * g + 4] * inv, o[d0][4 * g + 5] * inv); w1.y = cvt_pk(o[d0][4 * g + 6] * inv, o[d0][4 * g + 7] * inv);
                    ATT_ST_PAIR(orow, d0 * 32 + 8 * g, w0, w1); }
        }
    }
}
}

__device__ __forceinline__ void rowss_phase(const bf16* LAT, float* rowss, int gw, int NGW, int lane) {
    for (int m = gw; m < M; m += NGW) {
        const GAS v4u* r = (const GAS v4u*)(LAT + (size_t)m * 1536) + lane;
        float sq = 0.f, sk = 0.f;
#pragma unroll
        for (int j = 0; j < 3; ++j) { const v4u w = r[64 * j]; f32x4 a, b; pg8::unpack8(w, a, b);
            const float t = (a[0] * a[0] + a[1] * a[1]) + (a[2] * a[2] + a[3] * a[3]) + (b[0] * b[0] + b[1] * b[1]) + (b[2] * b[2] + b[3] * b[3]);
            if (j < 2) sq += t; else sk += t; }
        sq = wave_sum(sq); sk = wave_sum(sk);
        if (lane == 0) { rowss[m] = sq; rowss[M + m] = sk; }
    }
}
__device__ __forceinline__ void normmax_phase(const bf16* QKV, volatile LAS unsigned* nmax  , int gw, int NGW, int lane) {
    float mq[4] = {0.f, 0.f, 0.f, 0.f}, mk[4] = {0.f, 0.f, 0.f, 0.f}; int cur_b = -1;
    for (int m = gw; ; m += NGW) {
        const int b = m < M ? m / SEQ : -2;
        if (b != cur_b) {
            if (cur_b >= 0 && (lane & 15) == 0) {
#pragma unroll
                for (int j = 0; j < 4; ++j) { const int v = j * 4 + (lane >> 4);
                    __hip_atomic_fetch_max((LAS unsigned*)(nmax + (cur_b * 16 + v) * 2), __float_as_uint(mq[j]), __ATOMIC_RELAXED, __HIP_MEMORY_SCOPE_WORKGROUP);
                    __hip_atomic_fetch_max((LAS unsigned*)(nmax + (cur_b * 16 + v) * 2 + 1), __float_as_uint(mk[j]), __ATOMIC_RELAXED, __HIP_MEMORY_SCOPE_WORKGROUP); } }
#pragma unroll
            for (int j = 0; j < 4; ++j) { mq[j] = 0.f; mk[j] = 0.f; }
            cur_b = b;
        }
        if (m >= M) break;
        const GAS v4u* rq = (const GAS v4u*)(QKV + (size_t)m * 6144) + lane;
#pragma unroll
        for (int j = 0; j < 4; ++j) {
            f32x4 a, c; pg8::unpack8(rq[64 * j], a, c);
            float tq = (a[0] * a[0] + a[1] * a[1]) + (a[2] * a[2] + a[3] * a[3]) + (c[0] * c[0] + c[1] * c[1]) + (c[2] * c[2] + c[3] * c[3]);
            pg8::unpack8(rq[256 + 64 * j], a, c);
            float tk = (a[0] * a[0] + a[1] * a[1]) + (a[2] * a[2] + a[3] * a[3]) + (c[0] * c[0] + c[1] * c[1]) + (c[2] * c[2] + c[3] * c[3]);
#pragma unroll
            for (int o = 1; o < 16; o <<= 1) { tq += __shfl_xor(tq, o); tk += __shfl_xor(tk, o); }
            mq[j] = fmaxf(mq[j], tq); mk[j] = fmaxf(mk[j], tk);
        }
    }
}
__device__ __forceinline__ void ln_phase(const bf16* in, const float* g, const float* bta, float* of, bf16* ob, float* stat  , int gw, int NGW, int lane) {
    for (int m = gw; m < M; m += NGW) {
        GAS const v4u* xr = (GAS const v4u*)(in + (size_t)m * DM) + lane;
        f32x4 v[8][2]; float s = 0.f;
#pragma unroll
        for (int j = 0; j < 8; ++j) { const v4u w = xr[64 * j]; pg8::unpack8h(w, v[j][0], v[j][1]);
            s += ((v[j][0][0] + v[j][0][1]) + (v[j][0][2] + v[j][0][3])) + ((v[j][1][0] + v[j][1][1]) + (v[j][1][2] + v[j][1][3])); }
        const float mean = wave_sum(s) * (1.f / DM); float s2 = 0.f;
#pragma unroll
        for (int j = 0; j < 8; ++j)
#pragma unroll
            for (int h = 0; h < 2; ++h) { v[j][h] = v[j][h] - mean; s2 += (v[j][h][0] * v[j][h][0] + v[j][h][1] * v[j][h][1]) + (v[j][h][2] * v[j][h][2] + v[j][h][3] * v[j][h][3]); }
        const float rstd = 1.f / sqrtf(wave_sum(s2) * (1.f / DM) + LN_EPS);
        if (stat && lane == 0) { stat[m] = mean; stat[M + m] = rstd; }
#pragma unroll
        for (int j = 0; j < 8; ++j) { const int c = 8 * lane + 512 * j;
            const f32x4 y0 = v[j][0] * rstd * *(const f32x4*)(g + c) + *(const f32x4*)(bta + c), y1 = v[j][1] * rstd * *(const f32x4*)(g + c + 4) + *(const f32x4*)(bta + c + 4);
            if (of) { GAS f32x4* o = (GAS f32x4*)(of + (size_t)m * DM + c); o[0] = y0; o[1] = y1; }
            if (ob) *((GAS v4u*)(ob + (size_t)m * DM + c)) = pg8::pack8(y0, y1); }
    }
}
__device__ __forceinline__ void conv_fix_phase(const bf16* SIDE, const float* cw, const float* cb, bf16* ACT, int gw, int NGW, int lane) {
    constexpr int NCG = (DFF + 511) / 512, NCH = M / 64;
    for (int it = gw; it < NCG * NCH; it += NGW) {
        const int cg = it % NCG, c = it / NCG, ch = cg * 512 + lane * 8;
        if (ch >= DFF) continue;
        const bool first = (c % (SEQ / 64)) == 0;
        f32x4 u[4][2][2];
#pragma unroll
        for (int j = 0; j < 4; ++j)
#pragma unroll
            for (int gv = 0; gv < 2; ++gv) {
                if (j < 2 && first) { u[j][gv][0] = (f32x4){0.f, 0.f, 0.f, 0.f}; u[j][gv][1] = (f32x4){0.f, 0.f, 0.f, 0.f}; }
                else { const int cc = j < 2 ? c - 1 : c, jj = j < 2 ? j + 2 : j - 2;
                    pg8::unpack8(*(const v4u*)(SIDE + ((size_t)(cc * 4 + jj) * 2 + gv) * DFF + ch), u[j][gv][0], u[j][gv][1]); } }
#pragma unroll
        for (int r = 0; r < 2; ++r) {
            float o[8];
#pragma unroll
            for (int e = 0; e < 8; ++e) {
                const int h = e >> 2, q = e & 3;
                const float cgate = cb[ch + e] + cw[ch + e] * u[r][0][h][q] + cw[(size_t)2 * DFF + ch + e] * u[r + 1][0][h][q] + cw[(size_t)4 * DFF + ch + e] * u[r + 2][0][h][q];
                const float cval = cb[DFF + ch + e] + cw[DFF + ch + e] * u[r][1][h][q] + cw[(size_t)3 * DFF + ch + e] * u[r + 1][1][h][q] + cw[(size_t)5 * DFF + ch + e] * u[r + 2][1][h][q];
                o[e] = cgate * pg8::sigmoidf_(cgate) * cval;
            }
            v4u w; w.x = cvt_pk(o[0], o[1]); w.y = cvt_pk(o[2], o[3]); w.z = cvt_pk(o[4], o[5]); w.w = cvt_pk(o[6], o[7]);
            *(v4u*)(ACT + (size_t)(c * 64 + r) * DFF + ch) = w;
        }
    }
}

struct Args { const void* in[24]; float* out; unsigned char* ws; int ph_lo, ph_hi, li, pad; };
constexpr int N_PHASES = 11;
__global__ void __launch_bounds__(NWAVES * 64, 2) mk_fwd(Args args) {
    extern __shared__ __attribute__((aligned(16))) unsigned char lds_raw[];
    LAS unsigned char* lds = (LAS unsigned char*)lds_raw;
    volatile LAS unsigned* MISC = (volatile LAS unsigned*)(lds + MISC_OFF);
    const int tid = threadIdx.x, lane = tid & 63, wave = __builtin_amdgcn_readfirstlane(tid >> 6);
    const int G = gridDim.x; const int bx = blockIdx.x; const int vcu = (G % 8 == 0) ? (bx % 8) * (G / 8) + bx / 8 : bx;
    Ptrs P;
    P.x = (const float*)args.in[0]; P.pos = (const int*)args.in[1]; P.w_in = (const float*)args.in[2]; P.b_gate = (const float*)args.in[3];
    P.lq1 = (const float*)args.in[4]; P.lk1 = (const float*)args.in[5]; P.lq2 = (const float*)args.in[6]; P.lk2 = (const float*)args.in[7];
    P.subln_g = (const float*)args.in[8]; P.qn_g = (const float*)args.in[9]; P.kvn_g = (const float*)args.in[10];
    P.w_uq = (const float*)args.in[11]; P.w_ukv = (const float*)args.in[12]; P.w_pa = (const float*)args.in[13]; P.w_pb = (const float*)args.in[14]; P.w_out = (const float*)args.in[15];
    P.ln1_g = (const float*)args.in[16]; P.ln1_b = (const float*)args.in[17]; P.w_up = (const float*)args.in[18]; P.conv_w = (const float*)args.in[19]; P.conv_b = (const float*)args.in[20];
    P.w_down = (const float*)args.in[21]; P.ln2_g = (const float*)args.in[22]; P.ln2_b = (const float*)args.in[23];
    P.out = args.out; P.ws = args.ws;
    unsigned char* ws = args.ws;
    gu32* ctl = (gu32*)(ws + WS_CTL);
    for (int u = tid; u < (LDS_BYTES - LDSCTL_OFF) / 4; u += NWAVES * 64) ((LAS unsigned*)(lds + LDSCTL_OFF))[u] = 0u;
    __syncthreads();
    XcdBarrier bar = xcd_barrier_post((unsigned*)(ctl + 4096) + args.li * XCD_BAR_WORDS, MISC + 8);
    const int lo = args.ph_lo, hi = args.ph_hi;
#define IN(k) (lo <= (k) && (k) < hi)
#define SEAM(k) do { if (IN(k) && IN((k) + 1)) xcd_barrier(bar); } while (0)
#define SEAM2B() do { if (IN(2)) xcd_barrier(bar); } while (0)
    const int gw = vcu * NWAVES + wave, NGW = G * NWAVES;
    typedef pg8::bf16_t bt;
    const int xcd_rot = bx & 7;
#define KOFF(K_) ((((K_) / 64) * xcd_rot / 8) & ~1)

#define PH_ALIGN(n) asm volatile(".p2align 8\n\t.rept %0\n\ts_nop 0\n\t.endr" :: "n"(n))
    if (IN(0)) { p0_prologue(P, lds, vcu, G, wave, lane); } SEAM(0);

    if (IN(1)) {
        PH_ALIGN(0);
        pg8::Gemm g{(const bt*)(ws + WS_XB), (const bt*)(ws + WS_WIN), M, N1, DM, DM, DM, KOFF(DM)}; pg8::StaticOrder S; S.init(M, N1, G, bx);
        pg8::EpiIn E{(bt*)(ws + WS_QKV), (bt*)(ws + WS_LAT), (bt*)(ws + WS_G), (bt*)(ws + WS_KVB), (float*)(ws + WS_ROWSS), P.b_gate, (const float*)(ws + WS_ROPE), C2A, M};
        pg8::gemm_phase<pg8::EpiIn, pg8::StaticOrder, true, true>(lds, g, S, E);
    } SEAM(1);

    if (IN(2)) {
        if (tid < 64) MISC[64 + tid] = 0u;
        __syncthreads();
        rowss_phase((const bf16*)(ws + WS_LAT), (float*)(ws + WS_ROWSS), gw, NGW, lane);
        normmax_phase((const bf16*)(ws + WS_QKV), MISC + 64, gw, NGW, lane);
        __syncthreads();
        if (tid < 64) ((GAS unsigned*)(ws + WS_NPART))[bx * 64 + tid] = MISC[64 + tid];
    } SEAM2B();

    if (IN(2)) {
        PH_ALIGN(0);
        { pg8::Gemm g{(const bt*)(ws + WS_LAT), (const bt*)(ws + WS_WUQ), M, 3072, 1024, 1536, 1024, KOFF(1024)}; pg8::StaticOrder S; S.init(M, 3072, G, bx);
          pg8::EpiQb E{(bt*)(ws + WS_QB), (const float*)(ws + WS_ROWSS), (const float*)(ws + WS_ROPE), C2B};
          pg8::gemm_phase<pg8::EpiQb, pg8::StaticOrder, true, true>(lds, g, S, E); }
        { pg8::Gemm g{(const bt*)(ws + WS_LAT) + 1024, (const bt*)(ws + WS_WUKV), M, 4096, 512, 1536, 512, KOFF(512)}; pg8::StaticOrder S; S.init(M, 4096, G, bx);
          pg8::EpiKv E{(bt*)(ws + WS_KVB), (const float*)(ws + WS_ROWSS) + M};
          pg8::gemm_phase<pg8::EpiKv, pg8::StaticOrder, true, true>(lds, g, S, E); }
    } SEAM(2);

    if (IN(3)) { PH_ALIGN(0); att::attn_phase(P, lds, MISC, ctl, 0); } SEAM(3);

    if (IN(4)) { PH_ALIGN(0);
        pg8::Gemm g{(const bt*)(ws + WS_OAB), (const bt*)(ws + WS_WPA), M, 4096, 4096, 4096, 4096, 0}; pg8::StaticOrder S; S.init(M, 4096, G, bx);
        pg8::EpiMerge E{(const bt*)(ws + WS_G), (bt*)(ws + WS_MRG)};
        pg8::gemm_phase<pg8::EpiMerge, pg8::StaticOrder, true, true>(lds, g, S, E);
    } SEAM(4);

    if (IN(5)) { PH_ALIGN(0);
        pg8::Gemm g{(const bt*)(ws + WS_MRG), (const bt*)(ws + WS_WOUT), M, 4096, 4096, 4096, 4096, KOFF(4096)}; pg8::StaticOrder S; S.init(M, 4096, G, bx);
        pg8::EpiRes E{P.x, (bt*)(ws + WS_YB), ALPHA};
        pg8::gemm_phase<pg8::EpiRes, pg8::StaticOrder, true, true>(lds, g, S, E);
    } SEAM(5);

    if (IN(6)) { PH_ALIGN(0); ln_phase((const bf16*)(ws + WS_YB), P.ln1_g, P.ln1_b, nullptr, (bf16*)(ws + WS_H1B), (float*)(ws + WS_ROWSS), gw, NGW, lane); } SEAM(6);

    if (IN(7)) { PH_ALIGN(0);
        pg8::Gemm g{(const bt*)(ws + WS_H1B), (const bt*)(ws + WS_WUP), M, 22016, 4096, 4096, 4096, KOFF(4096)}; pg8::StaticOrder S; S.init(M, 22016, G, bx);
        pg8::EpiConv E{(bt*)(ws + WS_ACT), (bt*)(ws + WS_SIDE), P.conv_w, P.conv_b, DFF};
        pg8::gemm_phase<pg8::EpiConv, pg8::StaticOrder, true, true>(lds, g, S, E);
    } SEAM(7);

    if (IN(8)) { PH_ALIGN(0); conv_fix_phase((const bf16*)(ws + WS_SIDE), P.conv_w, P.conv_b, (bf16*)(ws + WS_ACT), gw, NGW, lane); } SEAM(8);

    if (IN(9)) { PH_ALIGN(0);
        pg8::Gemm g{(const bt*)(ws + WS_ACT), (const bt*)(ws + WS_WDN), M, 4096, DFF, DFF, DFF, KOFF(DFF)}; pg8::StaticOrder S; S.init(M, 4096, G, bx);
        pg8::EpiDown E{(const bt*)(ws + WS_YB), (bt*)(ws + WS_Y2B), (const float*)(ws + WS_ROWSS), P.ln1_g, P.ln1_b, ALPHA, M};
        pg8::gemm_phase<pg8::EpiDown, pg8::StaticOrder, true, true>(lds, g, S, E);
    } SEAM(9);

    if (IN(10)) { PH_ALIGN(0); ln_phase((const bf16*)(ws + WS_Y2B), P.ln2_g, P.ln2_b, P.out, nullptr, nullptr, gw, NGW, lane); }
#undef IN
#undef SEAM
#undef SEAM2B
}

extern "C" void kernel_launch(void* const* d_in, const int* in_sizes, int n_in, void* d_out, int out_size, void* d_ws, size_t ws_size, hipStream_t stream) {
    static int grid = 0;
    if (grid == 0) {
        if (n_in != 24 || in_sizes[0] != M * DM || out_size != M * DM || ws_size < WS_END) { fprintf(stderr, "kernel_launch: unexpected shapes (n_in %d, x %d, out %d, ws %zu < %zu)\n", n_in, n_in > 0 ? in_sizes[0] : -1, out_size, ws_size, (size_t)WS_END); grid = -1; return; }
        int dev = 0, cus = 0, per_cu = 0;
        if (hipGetDevice(&dev) != hipSuccess || hipDeviceGetAttribute(&cus, hipDeviceAttributeMultiprocessorCount, dev) != hipSuccess) { grid = -1; return; }
        if (hipFuncSetAttribute((const void*)mk_fwd, hipFuncAttributeMaxDynamicSharedMemorySize, LDS_BYTES) != hipSuccess) { fprintf(stderr, "kernel_launch: hipFuncSetAttribute failed\n"); grid = -1; return; }
        if (hipOccupancyMaxActiveBlocksPerMultiprocessor(&per_cu, (const void*)mk_fwd, NWAVES * 64, LDS_BYTES) != hipSuccess || per_cu < 1) fprintf(stderr, "kernel_launch: occupancy query says %d\n", per_cu);
        (void)hipGetLastError();
        grid = cus < 256 ? cus : 256;
    }
    if (grid < 0) return;
    if (hipMemsetAsync((char*)d_ws + WS_CTL, 0, CTL_ZERO_BYTES, stream) != hipSuccess) return;
    Args a{};
    for (int i = 0; i < 24; ++i) a.in[i] = d_in[i];
    a.out = (float*)d_out; a.ws = (unsigned char*)d_ws;
    constexpr int NL = MK_N_LAUNCHES;
    for (int li = 0; li < NL; ++li) {
        constexpr bool ONE = (MK_N_LAUNCHES == 1);
        a.ph_lo = ONE ? 0 : li; a.ph_hi = ONE ? N_PHASES : li + 1; a.li = ONE ? 0 : li; a.pad = 0;
        hipLaunchKernelGGL(mk_fwd, dim3(grid), dim3(NWAVES * 64), LDS_BYTES, stream, a);
        const hipError_t le = hipPeekAtLastError();
        if (le != hipSuccess) { fprintf(stderr, "kernel_launch: launch %d failed: %s\n", li, hipGetErrorName(le)); break; }
    }
}
```

```cpp
#include <hip/hip_runtime.h>
#include <cstdio>
#include <cstdint>

#ifndef MK_N_LAUNCHES
#define MK_N_LAUNCHES 1
#endif

constexpr int BATCH = 2, SEQ = 8192, DM = 4096, M = BATCH * SEQ;
constexpr int DA_H = 8, ML_H = 16, DFF = 11008;
constexpr int IN_COLS = 15936, N1 = 16128;
constexpr float ALPHA = 1.189207115002721f;
constexpr float LN_EPS = 1e-5f, RMS_EPS = 1e-6f;
constexpr float LOG2E = 1.4426950408889634f;
constexpr float C2A = 0.08838834764831845f * LOG2E;
constexpr float C2B = 0.07216878364870323f * LOG2E;
constexpr float LAMBDA_INIT = 0.2f;

constexpr size_t MiB = 1u << 20;
constexpr size_t WS_CTL = 0, CTL_ZERO_BYTES = 65536;
constexpr size_t WS_ROPE = 1 * MiB;
constexpr size_t WS_ROWSS = 5 * MiB;
constexpr size_t WS_NPART = 6 * MiB;
constexpr size_t WS_WIN = 8 * MiB, WS_WUQ = 134 * MiB, WS_WUKV = 140 * MiB, WS_WPA = 144 * MiB, WS_WPB = 160 * MiB, WS_WOUT = 176 * MiB, WS_WUP = 208 * MiB, WS_WDN = 380 * MiB;
constexpr size_t WS_XB = 466 * MiB;
constexpr size_t WS_OAB = WS_XB, WS_H1B = WS_XB;
constexpr size_t WS_QKV = 594 * MiB;
constexpr size_t WS_QB = 786 * MiB;
constexpr size_t WS_KVB = 882 * MiB;
constexpr size_t WS_LAT = 1042 * MiB;
constexpr size_t WS_G = 1090 * MiB;
constexpr size_t WS_TMP = 594 * MiB;
constexpr size_t WS_MRG = 850 * MiB;
constexpr size_t WS_SIDE = 594 * MiB;
constexpr size_t WS_ACT = 640 * MiB;
constexpr size_t WS_O0 = 8 * MiB;
constexpr size_t WS_YB = 1000 * MiB;
constexpr size_t WS_Y2B = 1136 * MiB;
constexpr size_t WS_END = 1376 * MiB;
constexpr int KVLD = 5120;

constexpr int RING_BYTES = 131072, LDSCTL_OFF = RING_BYTES, MISC_OFF = LDSCTL_OFF + 320, LDS_BYTES = 147456;
constexpr int NWAVES = 8;

#define GAS __attribute__((address_space(1)))
#define LAS __attribute__((address_space(3)))
typedef unsigned short bf16;
typedef unsigned v4u __attribute__((ext_vector_type(4)));
typedef unsigned v2u __attribute__((ext_vector_type(2)));
typedef float f32x4 __attribute__((ext_vector_type(4)));
typedef float f32x2 __attribute__((ext_vector_type(2)));
typedef float f32x16 __attribute__((ext_vector_type(16)));
typedef short bf16x8 __attribute__((ext_vector_type(8)));
typedef short s16x4 __attribute__((ext_vector_type(4)));
typedef GAS unsigned gu32;
#define RLX_AGENT __ATOMIC_RELAXED, __HIP_MEMORY_SCOPE_AGENT
#define LDS_WAIT() asm volatile("s_waitcnt lgkmcnt(0)" ::: "memory")
#define VM_WAIT() asm volatile("s_waitcnt vmcnt(0)" ::: "memory")
typedef __bf16 bf16x2_t __attribute__((ext_vector_type(2)));
__device__ __forceinline__ unsigned cvt_pk(float lo, float hi) { const f32x2 v = {lo, hi}; const bf16x2_t b = __builtin_convertvector(v, bf16x2_t); return __builtin_bit_cast(unsigned, b); }
__device__ __forceinline__ float bf_lo(unsigned w) { return __uint_as_float(w << 16); }
__device__ __forceinline__ float bf_hi(unsigned w) { return __uint_as_float(w & 0xffff0000u); }
__device__ __forceinline__ float wave_sum(float v) {
#pragma unroll
    for (int o = 1; o < 64; o <<= 1) v += __shfl_xor(v, o);
    return v;
}
namespace pg8 {
#define PG8_LAS __attribute__((address_space(3)))
typedef unsigned short bf16_t;
typedef short bf16x8 __attribute__((ext_vector_type(8)));
typedef float f32x4 __attribute__((ext_vector_type(4)));
typedef unsigned u32x4 __attribute__((ext_vector_type(4)));
constexpr int BM = 256, BK = 64, HALF = 128, HTB = HALF * BK * 2  , STAGE_BYTES = 8 * HTB, NXCD = 8, WGM = 8;

__host__ __device__ __forceinline__ int lds_byte(int r, int c) { const int st = (r >> 4) * 2 + (c >> 5), rr = r & 15, cc = c & 31, ob = rr * 64 + cc * 2; return st * 1024 + (ob ^ (((ob >> 9) & 1) << 5)); }
__host__ __device__ __forceinline__ void stage_rc(int b, int& R, int& C) { const int st = b / 1024, sb = b % 1024, swz = sb ^ (((sb >> 9) & 1) << 5); R = (st >> 1) * 16 + swz / 64; C = (st & 1) * 32 + (swz % 64) / 2; }
__host__ __device__ __forceinline__ int perm32(int rho) { const int n = rho >> 4, i = rho & 15; return 8 * (i >> 2) + 4 * n + (i & 3); }

struct Unit { int pm, pn; };
struct Gemm { const bf16_t* A; const bf16_t* Bt; int M, N, K, lda, ldb, koff; };

struct StaticOrder {
    int nM, nN, nwg, G, c;
    __host__ __device__ void init(int M, int N, int G_, int c_) { nM = M / BM; nN = N / BM; nwg = nM * nN; G = G_; c = c_; }
    __host__ __device__ bool next(int i, Unit& u) const {
        const long L = (long)i * G + c; if (L >= nwg) return false;
        int wgid = (int)L; { const int q = nwg / NXCD, r = nwg % NXCD, xcd = wgid % NXCD, off = wgid / NXCD; wgid = (xcd < r ? xcd * (q + 1) : r * (q + 1) + (xcd - r) * q) + off; }
        const int nig = WGM * nN, gid = wgid / nig, fm = gid * WGM, gsz = (nM - fm) < WGM ? (nM - fm) : WGM;
        u.pm = fm + ((wgid % nig) % gsz); u.pn = (wgid % nig) / gsz; return true;
    }
    __device__ __forceinline__ void a_ready(const Unit&) const {}
    __device__ __forceinline__ void done(const Unit&) const {}
};

__device__ __forceinline__ unsigned cvt_pk_bf16(float lo, float hi) { return ::cvt_pk(lo, hi); }
typedef float f32x2 __attribute__((ext_vector_type(2)));
__device__ __forceinline__ u32x4 pack8(f32x4 a, f32x4 b) { u32x4 w; w.x = cvt_pk_bf16(a[0], a[1]); w.y = cvt_pk_bf16(a[2], a[3]); w.z = cvt_pk_bf16(b[0], b[1]); w.w = cvt_pk_bf16(b[2], b[3]); return w; }
__device__ __forceinline__ float bflo(unsigned w) { return __uint_as_float(w << 16); }
__device__ __forceinline__ float bfhi(unsigned w) { return __uint_as_float(w & 0xffff0000u); }
__device__ __forceinline__ float sigmoidf_(float x) { return __builtin_amdgcn_rcpf(1.f + __builtin_amdgcn_exp2f(-1.4426950408889634f * x)); }
__device__ __forceinline__ void rope8(f32x4& v0, f32x4& v1, const float* cs  , int i0) {
    const f32x4 c = *(const f32x4*)(cs + i0), s = *(const f32x4*)(cs + 32 + i0);
    const f32x4 a = v0, b = v1;
    v0[0] = a[0] * c[0] - a[1] * s[0]; v0[1] = a[0] * s[0] + a[1] * c[0];
    v0[2] = a[2] * c[1] - a[3] * s[1]; v0[3] = a[2] * s[1] + a[3] * c[1];
    v1[0] = b[0] * c[2] - b[1] * s[2]; v1[1] = b[0] * s[2] + b[1] * c[2];
    v1[2] = b[2] * c[3] - b[3] * s[3]; v1[3] = b[2] * s[3] + b[3] * c[3];
}
#define PG8_ROWLOOP _Pragma("unroll") for (int ai = 0; ai < 2; ++ai) _Pragma("unroll") for (int m = 0; m < 4; ++m)

struct EpiIn {
    static constexpr bool PERM = true, AFTER_DRAIN = false, MID = false;
    bf16_t* qkv; bf16_t* lat; bf16_t* gate; bf16_t* kvb; float* rowss; const float* bgate; const float* rope; float c2a; int Mrows;
    __device__ __forceinline__ void operator()(const f32x4 (&acc)[2][2][4][2], const Unit& u, int wr, int wc, int fr, int fq) const {
        const int row0 = u.pm * BM + wr * 64 + fr, lc0 = wc * 32 + 8 * fq, pn = u.pn;
        if (pn < 24) {
            const float sc = pn < 8 ? c2a : 1.f;
            PG8_ROWLOOP { bf16_t* rowp = qkv + (size_t)(row0 + ai * HALF + m * 16) * 6144 + pn * 256 + lc0;
#pragma unroll
                for (int bj = 0; bj < 2; ++bj) *(u32x4*)(rowp + bj * HALF) = pack8(acc[ai][bj][m][0] * sc, acc[ai][bj][m][1] * sc); }
        } else if (pn < 30) {
            PG8_ROWLOOP { bf16_t* rowp = lat + (size_t)(row0 + ai * HALF + m * 16) * 1536 + (pn - 24) * 256 + lc0;
#pragma unroll
                for (int bj = 0; bj < 2; ++bj) *(u32x4*)(rowp + bj * HALF) = pack8(acc[ai][bj][m][0], acc[ai][bj][m][1]); }
        } else if (pn < 62) {
            const int gc0 = (pn - 30) * 256 + lc0;
            f32x4 bv[2][2];
#pragma unroll
            for (int bj = 0; bj < 2; ++bj)
#pragma unroll
                for (int n = 0; n < 2; ++n) bv[bj][n] = *(const f32x4*)(bgate + gc0 + bj * HALF + 4 * n);
            PG8_ROWLOOP { bf16_t* rowp = gate + (size_t)(row0 + ai * HALF + m * 16) * 8192 + gc0;
#pragma unroll
                for (int bj = 0; bj < 2; ++bj) { f32x4 a = acc[ai][bj][m][0] + bv[bj][0], b = acc[ai][bj][m][1] + bv[bj][1];
#pragma unroll
                    for (int e = 0; e < 4; ++e) { a[e] = sigmoidf_(a[e]); b[e] = sigmoidf_(b[e]); }
                    *(u32x4*)(rowp + bj * HALF) = pack8(a, b); } }
        } else {
            if (wc < 2) {
                PG8_ROWLOOP { const int row = row0 + ai * HALF + m * 16; f32x4 a = acc[ai][0][m][0], b = acc[ai][0][m][1];
                    rope8(a, b, rope + (size_t)row * 64, lc0 >> 1);
                    const u32x4 w = pack8(a, b); bf16_t* rowp = kvb + (size_t)row * 5120 + 128 + lc0;
#pragma unroll
                    for (int h = 0; h < 16; ++h) *(u32x4*)(rowp + h * 320) = w; }
            }
        }
    }
};
struct EpiQb {
    static constexpr bool PERM = true, AFTER_DRAIN = false, MID = false;
    bf16_t* qb; const float* rowss; const float* rope; float c2b;
    __device__ __forceinline__ void operator()(const f32x4 (&acc)[2][2][4][2], const Unit& u, int wr, int wc, int fr, int fq) const {
        const int row0 = u.pm * BM + wr * 64 + fr, lc0 = wc * 32 + 8 * fq;
        int col[2], i0[2]; bool isr[2];
#pragma unroll
        for (int bj = 0; bj < 2; ++bj) { col[bj] = u.pn * 256 + bj * HALF + lc0; const int h = col[bj] / 192, j = col[bj] - h * 192; isr[bj] = j >= 128; i0[bj] = (j - 128) >> 1; }
        PG8_ROWLOOP { const int row = row0 + ai * HALF + m * 16; const float rs = __builtin_amdgcn_rsqf(rowss[row] * (1.f / 1024.f) + 1e-6f) * c2b;
#pragma unroll
            for (int bj = 0; bj < 2; ++bj) { f32x4 a = acc[ai][bj][m][0] * rs, b = acc[ai][bj][m][1] * rs;
                if (isr[bj]) rope8(a, b, rope + (size_t)row * 64, i0[bj]);
                *(u32x4*)(qb + (size_t)row * 3072 + col[bj]) = pack8(a, b); } }
    }
};
struct EpiKv {
    static constexpr bool PERM = true, AFTER_DRAIN = false, MID = false;
    bf16_t* kvb; const float* rowss;
    __device__ __forceinline__ void operator()(const f32x4 (&acc)[2][2][4][2], const Unit& u, int wr, int wc, int fr, int fq) const {
        const int row0 = u.pm * BM + wr * 64 + fr, lc0 = wc * 32 + 8 * fq;
        PG8_ROWLOOP { const int row = row0 + ai * HALF + m * 16; const float rs = __builtin_amdgcn_rsqf(rowss[row] * (1.f / 512.f) + 1e-6f);
            bf16_t* rowp = kvb + (size_t)row * 5120 + u.pn * 320 + lc0;
            *(u32x4*)(rowp) = pack8(acc[ai][0][m][0] * rs, acc[ai][0][m][1] * rs);
            *(u32x4*)(rowp + 192) = pack8(acc[ai][1][m][0] * rs, acc[ai][1][m][1] * rs); }
    }
};
__device__ __forceinline__ void unpack8(const u32x4 w, f32x4& a, f32x4& b) { a[0] = bflo(w.x); a[1] = bfhi(w.x); a[2] = bflo(w.y); a[3] = bfhi(w.y); b[0] = bflo(w.z); b[1] = bfhi(w.z); b[2] = bflo(w.w); b[3] = bfhi(w.w); }
typedef _Float16 h16x2 __attribute__((ext_vector_type(2)));
__device__ __forceinline__ unsigned cvt_pk_h(float a, float b) { const f32x2 v = {a, b}; return __builtin_bit_cast(unsigned, __builtin_convertvector(v, h16x2)); }
__device__ __forceinline__ u32x4 pack8h(f32x4 a, f32x4 b) { u32x4 w; w.x = cvt_pk_h(a[0], a[1]); w.y = cvt_pk_h(a[2], a[3]); w.z = cvt_pk_h(b[0], b[1]); w.w = cvt_pk_h(b[2], b[3]); return w; }
__device__ __forceinline__ f32x2 h2f(unsigned w) { return __builtin_convertvector(__builtin_bit_cast(h16x2, w), f32x2); }
__device__ __forceinline__ void unpack8h(const u32x4 w, f32x4& a, f32x4& b) { const f32x2 p = h2f(w.x), q = h2f(w.y), r = h2f(w.z), t = h2f(w.w); a[0] = p[0]; a[1] = p[1]; a[2] = q[0]; a[3] = q[1]; b[0] = r[0]; b[1] = r[1]; b[2] = t[0]; b[3] = t[1]; }
struct EpiMerge {
    static constexpr bool PERM = true, AFTER_DRAIN = false, MID = true;
    const bf16_t* gate; bf16_t* mrg;
    __device__ __forceinline__ void mid(f32x4 (&acc)[2][2][4][2], const Unit& u, int wr, int wc, int fr, int fq) const {
        int fro = fr; asm volatile("" : "+v"(fro));
        const int row0 = u.pm * BM + wr * 64 + fro, c0 = u.pn * 256 + wc * 32 + 8 * fq;
        u32x4 wa[2][2], wb[2][2];
#define MRG_LD(S_, g_) do { const bf16_t* gp = gate + (size_t)(row0 + ((g_) >> 2) * HALF + ((g_) & 3) * 16) * 8192 + c0; \
            _Pragma("unroll") for (int bj = 0; bj < 2; ++bj) { wa[S_][bj] = *(const u32x4*)(gp + bj * HALF); wb[S_][bj] = *(const u32x4*)(gp + 4096 + bj * HALF); } } while (0)
        MRG_LD(0, 0);
#pragma unroll
        for (int g = 0; g < 8; ++g) { const int ai = g >> 2, m = g & 3;
            if (g + 1 < 8) MRG_LD((g + 1) & 1, g + 1);
#pragma unroll
            for (int bj = 0; bj < 2; ++bj) { f32x4 a0, a1, b0, b1; unpack8(wa[g & 1][bj], a0, a1); unpack8(wb[g & 1][bj], b0, b1);
#pragma unroll
                for (int e = 0; e < 4; ++e) { acc[ai][bj][m][0][e] *= a0[e] * __builtin_amdgcn_rcpf(fmaxf(b0[e], 1e-30f)); acc[ai][bj][m][1][e] *= a1[e] * __builtin_amdgcn_rcpf(fmaxf(b1[e], 1e-30f)); } }
            asm volatile("" : "+v"(acc[ai][0][m][0]), "+v"(acc[ai][0][m][1]), "+v"(acc[ai][1][m][0]), "+v"(acc[ai][1][m][1]) :: "memory"); }
#undef MRG_LD
    }
    __device__ __forceinline__ void operator()(const f32x4 (&acc)[2][2][4][2], const Unit& u, int wr, int wc, int fr, int fq) const {
        const int row0 = u.pm * BM + wr * 64 + fr, c0 = u.pn * 256 + wc * 32 + 8 * fq;
        PG8_ROWLOOP { const int row = row0 + ai * HALF + m * 16;
#pragma unroll
            for (int bj = 0; bj < 2; ++bj) { const int c = c0 + bj * HALF; f32x4 b0, b1; unpack8(*(const u32x4*)(gate + (size_t)row * 8192 + 4096 + c), b0, b1);
#pragma unroll
                for (int e = 0; e < 4; ++e) { b0[e] = fmaxf(b0[e], 1e-30f); b1[e] = fmaxf(b1[e], 1e-30f); }
                *(u32x4*)(mrg + (size_t)row * 4096 + c) = pack8(acc[ai][bj][m][0] * b0, acc[ai][bj][m][1] * b1); } }
    }
};
struct EpiRes {
    static constexpr bool PERM = true, AFTER_DRAIN = false, MID = false;
    const float* base; bf16_t* out; float alpha;
    __device__ __forceinline__ void operator()(const f32x4 (&acc)[2][2][4][2], const Unit& u, int wr, int wc, int fr, int fq) const {
        const int row0 = u.pm * BM + wr * 64 + fr, c0 = u.pn * 256 + wc * 32 + 8 * fq;
        PG8_ROWLOOP { const size_t ro = (size_t)(row0 + ai * HALF + m * 16) * 4096;
#pragma unroll
            for (int bj = 0; bj < 2; ++bj) { const size_t off = ro + c0 + bj * HALF; const f32x4 xa = *(const f32x4*)(base + off), xb = *(const f32x4*)(base + off + 4);
                *(u32x4*)(out + off) = pack8h(xa * alpha + acc[ai][bj][m][0], xb * alpha + acc[ai][bj][m][1]); } }
    }
};
struct EpiDown {
    static constexpr bool PERM = true, AFTER_DRAIN = false, MID = false;
    const bf16_t* yb; bf16_t* out; const float* stat; const float* g; const float* b; float alpha; int Mrows;
    __device__ __forceinline__ void operator()(const f32x4 (&acc)[2][2][4][2], const Unit& u, int wr, int wc, int fr, int fq) const {
        const int row0 = u.pm * BM + wr * 64 + fr, c0 = u.pn * 256 + wc * 32 + 8 * fq;
        f32x4 gv[2][2], bv[2][2];
#pragma unroll
        for (int bj = 0; bj < 2; ++bj)
#pragma unroll
            for (int n = 0; n < 2; ++n) { gv[bj][n] = *(const f32x4*)(g + c0 + bj * HALF + 4 * n) * alpha; bv[bj][n] = *(const f32x4*)(b + c0 + bj * HALF + 4 * n) * alpha; }
        PG8_ROWLOOP { const int row = row0 + ai * HALF + m * 16; const size_t ro = (size_t)row * 4096; const float mean = stat[row], rstd = stat[Mrows + row];
#pragma unroll
            for (int bj = 0; bj < 2; ++bj) { const size_t off = ro + c0 + bj * HALF; f32x4 ya, yc; unpack8h(*(const u32x4*)(yb + off), ya, yc);
                *(u32x4*)(out + off) = pack8h((ya - mean) * rstd * gv[bj][0] + bv[bj][0] + acc[ai][bj][m][0], (yc - mean) * rstd * gv[bj][1] + bv[bj][1] + acc[ai][bj][m][1]); } }
    }
};
__device__ __forceinline__ float dpp_prev(float prev_grp, float cur, int k) {
    const int pg = __builtin_bit_cast(int, prev_grp), cu = __builtin_bit_cast(int, cur);
    const int ro = k == 1 ? __builtin_amdgcn_mov_dpp(pg, 0x121, 0xf, 0xf, false) : __builtin_amdgcn_mov_dpp(pg, 0x122, 0xf, 0xf, false);
    const int r = k == 1 ? __builtin_amdgcn_update_dpp(ro, cu, 0x111, 0xf, 0xf, false) : __builtin_amdgcn_update_dpp(ro, cu, 0x112, 0xf, 0xf, false);
    return __builtin_bit_cast(float, r);
}
struct EpiConv {
    static constexpr bool PERM = true, AFTER_DRAIN = false, MID = false;
    bf16_t* act; bf16_t* side; const float* cw; const float* cb; int dff;
    __device__ __forceinline__ void operator()(const f32x4 (&acc)[2][2][4][2], const Unit& u, int wr, int wc, int fr, int fq) const {
        const int ch0 = u.pn * 128 + wc * 32 + 8 * fq;
#pragma unroll
        for (int n = 0; n < 2; ++n) {
            const int ch = ch0 + 4 * n;
            f32x4 wg[3], wv[3];
#pragma unroll
            for (int k = 0; k < 3; ++k) { wg[k] = *(const f32x4*)(cw + (size_t)k * 2 * dff + ch); wv[k] = *(const f32x4*)(cw + (size_t)k * 2 * dff + dff + ch); }
            const f32x4 bg = *(const f32x4*)(cb + ch), bv = *(const f32x4*)(cb + dff + ch);
#pragma unroll
            for (int ai = 0; ai < 2; ++ai) {
                const int rowc = u.pm * BM + ai * HALF + wr * 64;
#pragma unroll
                for (int m = 0; m < 4; ++m) {
                    const f32x4 g0 = acc[ai][0][m][n], v0 = acc[ai][1][m][n];
                    const f32x4 gp = m > 0 ? acc[ai][0][m - 1][n] : (f32x4){0.f, 0.f, 0.f, 0.f}, vp = m > 0 ? acc[ai][1][m - 1][n] : (f32x4){0.f, 0.f, 0.f, 0.f};
                    f32x4 o;
#pragma unroll
                    for (int e = 0; e < 4; ++e) {
                        const float g1 = dpp_prev(gp[e], g0[e], 1), g2 = dpp_prev(gp[e], g0[e], 2), v1 = dpp_prev(vp[e], v0[e], 1), v2 = dpp_prev(vp[e], v0[e], 2);
                        const float cg = bg[e] + wg[0][e] * g2 + wg[1][e] * g1 + wg[2][e] * g0[e];
                        const float cv = bv[e] + wv[0][e] * v2 + wv[1][e] * v1 + wv[2][e] * v0[e];
                        o[e] = cg * sigmoidf_(cg) * cv;
                    }
                    const int row = rowc + m * 16 + fr;
                    typedef unsigned u32x2 __attribute__((ext_vector_type(2)));
                    if (m > 0 || fr >= 2) { u32x2 w; w.x = cvt_pk_bf16(o[0], o[1]); w.y = cvt_pk_bf16(o[2], o[3]); *(u32x2*)(act + (size_t)row * dff + ch) = w; }
                    if ((m == 0 && fr < 2) || (m == 3 && fr >= 14)) {
                        const int j = m == 0 ? fr : fr - 12;
                        bf16_t* sp = side + ((size_t)((rowc >> 6) * 4 + j) * 2) * dff + ch;
                        u32x2 wgt; wgt.x = cvt_pk_bf16(g0[0], g0[1]); wgt.y = cvt_pk_bf16(g0[2], g0[3]); *(u32x2*)sp = wgt;
                        u32x2 wvl; wvl.x = cvt_pk_bf16(v0[0], v0[1]); wvl.y = cvt_pk_bf16(v0[2], v0[3]); *(u32x2*)(sp + dff) = wvl;
                    }
                }
            }
        }
    }
};
template <class Epi, class Sched, bool ALIGN_EPI = false, bool SP2 = false>
__device__ __forceinline__ void gemm_phase(PG8_LAS unsigned char* lds, const Gemm g, const Sched& S, const Epi& E) {
    const int tid = threadIdx.x, wid = __builtin_amdgcn_readfirstlane(tid >> 6), lane = tid & 63, wr = wid >> 2, wc = wid & 3, fr = lane & 15, fq = lane >> 4;
    const int K = g.K, nt = K / BK;
    unsigned voffA[2], voffB[2];
#pragma unroll
    for (int i = 0; i < 2; ++i) { int R, C; stage_rc(tid * 16 + i * 8192, R, C); const int Rb = Epi::PERM ? ((R & ~31) + perm32(R & 31)) : R;
        voffA[i] = (unsigned)(R * g.lda + C) * 2u; voffB[i] = (unsigned)(Rb * g.ldb + C) * 2u; }
    const size_t kstep = (size_t)(BK * 2);
    const int koff = g.koff; const size_t kob = (size_t)koff * kstep;
#define PG8_KP(base, t_) ((base) + (size_t)(((t_) + koff) >= nt ? (t_) + koff - nt : (t_) + koff) * kstep)
    const size_t hstepA = (size_t)HALF * g.lda * 2, hstepB = (size_t)HALF * g.ldb * 2;
    const size_t tstepA = 2 * hstepA, tstepB = 2 * hstepB;
    const unsigned ldsw = (unsigned)wid * 1024u;
    const int aoff = lds_byte(wr * 64 + fr, fq * 8), boff = lds_byte(wc * 32 + fr, fq * 8);
#define PG8_SA(b, h) (((b) * 2 + (h)) * HTB)
#define PG8_SB(b, h) ((4 + (b) * 2 + (h)) * HTB)
    const __amdgpu_buffer_rsrc_t rsrc_voffA = __builtin_amdgcn_make_buffer_rsrc((void*)g.A, (short)0, 0x7ffffff0, 0x00020000);
    const __amdgpu_buffer_rsrc_t rsrc_voffB = __builtin_amdgcn_make_buffer_rsrc((void*)g.Bt, (short)0, 0x7ffffff0, 0x00020000);
    const char* const base_voffA = (const char*)g.A; const char* const base_voffB = (const char*)g.Bt;
#define PG8_STAGE(bufoff, gbase, voff) do { const int so_ = (int)((const char*)(gbase) - base_##voff); _Pragma("unroll") for (int _i = 0; _i < 2; ++_i) \
        __builtin_amdgcn_raw_ptr_buffer_load_lds(rsrc_##voff, (PG8_LAS void*)(lds + (bufoff) + ldsw + _i * 8192), 16, (int)(voff)[_i], so_, 0, 0); } while (0)
#define PG8_LDA(dst, b, h) do { _Pragma("unroll") for (int m = 0; m < 4; ++m) _Pragma("unroll") for (int k = 0; k < 2; ++k) dst[m][k] = *(const PG8_LAS bf16x8*)(lds + PG8_SA(b, h) + aoff + m * 2048 + k * 1024); } while (0)
#define PG8_LDB(dst, b, h) do { _Pragma("unroll") for (int n = 0; n < 2; ++n) _Pragma("unroll") for (int k = 0; k < 2; ++k) dst[n][k] = *(const PG8_LAS bf16x8*)(lds + PG8_SB(b, h) + boff + n * 2048 + k * 1024); } while (0)
#define PG8_MMA(ai, bj, At, Bt) do { __builtin_amdgcn_s_setprio(1); _Pragma("unroll") for (int m = 0; m < 4; ++m) _Pragma("unroll") for (int n = 0; n < 2; ++n) _Pragma("unroll") for (int k = 0; k < 2; ++k) \
        acc[ai][bj][m][n] = __builtin_amdgcn_mfma_f32_16x16x32_bf16(Bt[n][k], At[m][k], acc[ai][bj][m][n], 0, 0, 0); __builtin_amdgcn_s_setprio(0); } while (0)
#define PG8_WAIT_V(n) asm volatile("s_waitcnt vmcnt(" #n ")" ::: "memory")
#define PG8_WAIT_L(n) asm volatile("s_waitcnt lgkmcnt(" #n ")" ::: "memory")
#define PG8_BAR __builtin_amdgcn_s_barrier()
#define PG8_SCHED __builtin_amdgcn_sched_barrier(0)
    Unit cur, nxt; int ui = 0;
    if (!S.next(0, cur)) return;
    f32x4 acc[2][2][4][2];
#pragma unroll
    for (int a = 0; a < 2; ++a)
#pragma unroll
        for (int b = 0; b < 2; ++b)
#pragma unroll
            for (int m = 0; m < 4; ++m)
#pragma unroll
                for (int n = 0; n < 2; ++n) acc[a][b][m][n] = (f32x4){0.f, 0.f, 0.f, 0.f};
    bf16x8 At[4][2], B0[2][2], B1[2][2];
    const char* cA = (const char*)g.A + (size_t)cur.pm * tstepA; const char* cB = (const char*)g.Bt + (size_t)cur.pn * tstepB;
    S.a_ready(cur);
    if constexpr (SP2) {
        PG8_STAGE(PG8_SB(0, 0), cB + kob, voffB); PG8_STAGE(PG8_SB(0, 1), cB + kob + hstepB, voffB); PG8_STAGE(PG8_SA(0, 0), cA + kob, voffA); PG8_STAGE(PG8_SA(0, 1), cA + kob + hstepA, voffA);
        if (wr == 1) PG8_BAR;
        PG8_WAIT_V(2); PG8_BAR;
        PG8_STAGE(PG8_SB(1, 0), cB + kob + kstep, voffB); PG8_STAGE(PG8_SA(1, 0), cA + kob + kstep, voffA); PG8_STAGE(PG8_SB(1, 1), cB + kob + hstepB + kstep, voffB);
        PG8_WAIT_V(6); PG8_BAR;
    } else {
        PG8_STAGE(PG8_SB(0, 0), cB + kob, voffB); PG8_STAGE(PG8_SA(0, 0), cA + kob, voffA); PG8_STAGE(PG8_SB(0, 1), cB + kob + hstepB, voffB); PG8_STAGE(PG8_SA(0, 1), cA + kob + hstepA, voffA);
        if (wr == 1) PG8_BAR;
        PG8_WAIT_V(4); PG8_BAR;
        PG8_STAGE(PG8_SB(1, 0), cB + kob + kstep, voffB); PG8_STAGE(PG8_SA(1, 0), cA + kob + kstep, voffA); PG8_STAGE(PG8_SB(1, 1), cB + kob + hstepB + kstep, voffB);
        PG8_WAIT_V(6); PG8_BAR;
    }
    for (;;) {
        const bool has_next = S.next(ui + 1, nxt);
        const char* nA = has_next ? (const char*)g.A + (size_t)nxt.pm * tstepA : cA; const char* nB = has_next ? (const char*)g.Bt + (size_t)nxt.pn * tstepB : cB;
        asm volatile(".p2align 6");
        for (int t = 0; t < nt; t += 2) {
            if constexpr (Epi::MID) { if (t == nt / 2) E.mid(acc, cur, wr, wc, fr, fq); }
            const bool last = (t == nt - 2);
            const char* a1 = PG8_KP(cA, t + 1);
            const char* a2 = last ? nA + kob : PG8_KP(cA, t + 2); const char* b2 = last ? nB + kob : PG8_KP(cB, t + 2);
            const char* a3 = a2 + kstep; const char* b3 = b2 + kstep;
            if (last && has_next) S.a_ready(nxt);
            if constexpr (SP2) {
            PG8_LDB(B0, 0, 0); PG8_LDB(B1, 0, 1); PG8_SCHED; PG8_LDA(At, 0, 0); PG8_STAGE(PG8_SA(1, 1), a1 + hstepA, voffA);
            PG8_WAIT_V(8); PG8_WAIT_L(0); PG8_BAR; PG8_MMA(0, 0, At, B0); PG8_MMA(0, 1, At, B1); PG8_BAR; PG8_SCHED;
            PG8_LDA(At, 0, 1); PG8_STAGE(PG8_SB(0, 0), b2, voffB); PG8_STAGE(PG8_SB(0, 1), b2 + hstepB, voffB); PG8_STAGE(PG8_SA(0, 0), a2, voffA);
            PG8_WAIT_V(8); PG8_WAIT_L(0); PG8_BAR; PG8_MMA(1, 0, At, B0); PG8_MMA(1, 1, At, B1); PG8_BAR; PG8_SCHED;
            PG8_LDB(B0, 1, 0); PG8_LDB(B1, 1, 1); PG8_SCHED; PG8_LDA(At, 1, 0); PG8_STAGE(PG8_SA(0, 1), a2 + hstepA, voffA);
            PG8_WAIT_V(8); PG8_WAIT_L(0); PG8_BAR; PG8_MMA(0, 0, At, B0); PG8_MMA(0, 1, At, B1); PG8_BAR; PG8_SCHED;
            PG8_LDA(At, 1, 1); PG8_STAGE(PG8_SB(1, 0), b3, voffB); PG8_STAGE(PG8_SB(1, 1), b3 + hstepB, voffB); PG8_STAGE(PG8_SA(1, 0), a3, voffA);
            PG8_WAIT_V(8); PG8_WAIT_L(0); PG8_BAR; PG8_MMA(1, 0, At, B0); PG8_MMA(1, 1, At, B1); PG8_BAR; PG8_SCHED;
            } else {
            PG8_LDB(B0, 0, 0); PG8_SCHED; PG8_LDA(At, 0, 0); PG8_STAGE(PG8_SA(1, 1), a1 + hstepA, voffA);
            PG8_WAIT_L(8); PG8_BAR; PG8_WAIT_L(0); PG8_MMA(0, 0, At, B0); PG8_BAR; PG8_SCHED;
            PG8_LDB(B1, 0, 1); PG8_STAGE(PG8_SB(0, 0), b2, voffB);
            PG8_BAR; PG8_WAIT_L(0); PG8_MMA(0, 1, At, B1); PG8_BAR;
            PG8_LDA(At, 0, 1); PG8_STAGE(PG8_SA(0, 0), a2, voffA);
            PG8_BAR; PG8_WAIT_L(0); PG8_MMA(1, 0, At, B0); PG8_BAR; PG8_SCHED;
            PG8_STAGE(PG8_SB(0, 1), b2 + hstepB, voffB);
            PG8_WAIT_V(6); PG8_BAR; PG8_MMA(1, 1, At, B1); PG8_BAR;
            PG8_LDB(B0, 1, 0); PG8_SCHED; PG8_LDA(At, 1, 0); PG8_STAGE(PG8_SA(0, 1), a2 + hstepA, voffA);
            PG8_WAIT_L(8); PG8_BAR; PG8_WAIT_L(0); PG8_MMA(0, 0, At, B0); PG8_BAR; PG8_SCHED;
            PG8_LDB(B1, 1, 1); PG8_STAGE(PG8_SB(1, 0), b3, voffB);
            PG8_BAR; PG8_WAIT_L(0); PG8_MMA(0, 1, At, B1); PG8_BAR;
            PG8_LDA(At, 1, 1); PG8_STAGE(PG8_SA(1, 0), a3, voffA);
            PG8_BAR; PG8_WAIT_L(0); PG8_MMA(1, 0, At, B0); PG8_BAR; PG8_SCHED;
            PG8_STAGE(PG8_SB(1, 1), b3 + hstepB, voffB);
            PG8_WAIT_V(6); PG8_BAR; PG8_MMA(1, 1, At, B1); PG8_BAR;
            }
        }
        if constexpr (ALIGN_EPI) { if (wr == 0) PG8_BAR; }
        if constexpr (!Epi::AFTER_DRAIN) { E(acc, cur, wr, wc, fr, fq); S.done(cur); }
        if (!has_next) break;
#pragma unroll
        for (int a = 0; a < 2; ++a)
#pragma unroll
            for (int b = 0; b < 2; ++b)
#pragma unroll
                for (int m = 0; m < 4; ++m)
#pragma unroll
                    for (int n = 0; n < 2; ++n) acc[a][b][m][n] = (f32x4){0.f, 0.f, 0.f, 0.f};
        cur = nxt; cA = nA; cB = nB; ++ui;
        if constexpr (ALIGN_EPI) { if (wr == 1) PG8_BAR; }
    }
    PG8_WAIT_V(0);
    if constexpr (!ALIGN_EPI) { if (wr == 0) PG8_BAR; }
    PG8_BAR;
    if constexpr (Epi::AFTER_DRAIN) { E.fused(acc, cur, wr, wc, fr, fq, lds, wid, lane); S.done(cur); }
#undef PG8_KP
#undef PG8_SA
#undef PG8_SB
#undef PG8_STAGE
#undef PG8_LDA
#undef PG8_LDB
#undef PG8_MMA
#undef PG8_WAIT_V
#undef PG8_WAIT_L
#undef PG8_BAR
#undef PG8_SCHED
}
}
#define XB_TMO      128
#define XB_XCNT(j)  (256  + 64 * (j))
#define XB_XSUB(j)  (1280 + 64 * (j))
#define XB_XGEN(j)  (2304 + 64 * (j))
#define XB_TOP      3328
#define XB_TOPGEN   3392
#define XCD_BAR_WORDS 3456
#define XB_SPIN_CAP (1u << 18)

__device__ __forceinline__ unsigned xb_ld(unsigned* p)              { return __hip_atomic_load(p, __ATOMIC_RELAXED, __HIP_MEMORY_SCOPE_AGENT); }
__device__ __forceinline__ unsigned xb_add(unsigned* p, unsigned v) { return __hip_atomic_fetch_add(p, v, __ATOMIC_RELAXED, __HIP_MEMORY_SCOPE_AGENT); }
__device__ __forceinline__ unsigned xb_xcc_id() { return (unsigned)__builtin_amdgcn_s_getreg((3 << 11) | 20) & 0xFu; }
#define XB_SPIN(cond, bar) do { unsigned _sp = 0; while (cond) { __builtin_amdgcn_s_sleep(1); \
    if ((++_sp & 255u) == 0u) { if (xb_ld(&(bar)[XB_TMO])) break; if (_sp > XB_SPIN_CAP) { atomicAdd(&(bar)[XB_TMO], 1u); break; } } } } while (0)

struct XcdBarrier {
    unsigned* bar; unsigned x;
    volatile LAS unsigned* st;
};

__device__ __forceinline__ XcdBarrier xcd_barrier_post(unsigned* bar, volatile LAS unsigned* st) {
    XcdBarrier b; b.bar = bar; b.x = xb_xcc_id(); b.st = st;
    if (threadIdx.x == 0) (void)xb_add(&bar[XB_XCNT(b.x)], 1u);
    return b;
}
__device__ __forceinline__ void xcd_barrier_complete(unsigned* bar, unsigned x, unsigned& nloc, unsigned& nx) {
    const unsigned G = gridDim.x * gridDim.y * gridDim.z;
    unsigned sum, cnt, mine, sp = 0u;
    for (;;) {
        sum = 0u; cnt = 0u; mine = 0u;
#pragma unroll
        for (unsigned j = 0; j < 16; ++j) { const unsigned c = xb_ld(&bar[XB_XCNT(j)]); sum += c; cnt += (c > 0u) ? 1u : 0u; mine = (j == x) ? c : mine; }
        if (sum == G) break;
        __builtin_amdgcn_s_sleep(1);
        if ((++sp & 255u) == 0u) { if (xb_ld(&bar[XB_TMO])) break; if (sp > XB_SPIN_CAP) { atomicAdd(&bar[XB_TMO], 1u); break; } }
    }
    nloc = mine > 0u ? mine : 1u; nx = cnt > 0u ? cnt : 1u;
}

__device__ __forceinline__ void xcd_barrier(const XcdBarrier& b) {
    asm volatile("s_waitcnt vmcnt(0)" ::: "memory");
    __syncthreads();
    if (threadIdx.x == 0) {
        unsigned* bar = b.bar;
        __builtin_amdgcn_s_waitcnt(0);
        unsigned nloc = b.st[0], nx = b.st[1];
        if (nloc == 0u) { xcd_barrier_complete(bar, b.x, nloc, nx); b.st[0] = nloc; b.st[1] = nx; }
        const unsigned old = xb_add(&bar[XB_XSUB(b.x)], 1u);
        const unsigned gen = old / nloc;
        if (old + 1u == (gen + 1u) * nloc) {
            __builtin_amdgcn_fence(__ATOMIC_RELEASE, "agent");
            asm volatile("s_waitcnt vmcnt(0)" ::: "memory");
            const unsigned og = xb_add(&bar[XB_TOP], 1u);
            const unsigned tg = og / nx;
            if (og + 1u == (tg + 1u) * nx) xb_add(&bar[XB_TOPGEN], 1u);
            else XB_SPIN(xb_ld(&bar[XB_TOPGEN]) == tg, bar);
            __builtin_amdgcn_fence(__ATOMIC_ACQUIRE, "agent");
            xb_add(&bar[XB_XGEN(b.x)], 1u);
            asm volatile("s_waitcnt vmcnt(0)" ::: "memory");
        } else {
            XB_SPIN(xb_ld(&bar[XB_XGEN(b.x)]) == gen, bar);
            __builtin_amdgcn_fence(__ATOMIC_ACQUIRE, "agent");
            asm volatile("s_waitcnt vmcnt(0)" ::: "memory");
        }
    }
    __syncthreads();
}
template <int MODE> __device__ __forceinline__ int dest_row(int n) {
    if (MODE == 1) { if (n < 7680) return n; if (n < 7744) { const int i = n - 7680; return 15872 + (i < 32 ? 2 * i : 2 * (i - 32) + 1); } return n - 64; }
    if (MODE == 2) { const int h = n / 192, j = n - h * 192; if (j < 128) return n; const int i = j - 128; return h * 192 + 128 + (i < 32 ? 2 * i : 2 * (i - 32) + 1); }
    if (MODE == 3) { const int isv = n >= DFF ? 1 : 0, ch = n - isv * DFF; return (ch >> 7) * 256 + isv * 128 + (ch & 127); }
    return n;
}
template <int MODE>
__device__ __forceinline__ void tr_item(const float* W, int K, int N, const float* gk, bf16* WT, LAS unsigned* scr, int kb, int nb, int lane, int ldk = 0, int kofs = 0) {
    const int k0 = kb * 64, n0 = nb * 64;
    const float* src = W + (size_t)k0 * N + n0 + lane;
#pragma unroll
    for (int i = 0; i < 32; ++i) {
        float a = src[(size_t)(2 * i) * N], b = src[(size_t)(2 * i + 1) * N];
        if (gk) { a *= gk[k0 + 2 * i]; b *= gk[k0 + 2 * i + 1]; }
        scr[i * 65 + lane] = cvt_pk(a, b);
    }
    LDS_WAIT(); asm volatile("" ::: "memory");
    const int c = lane & 7;
#pragma unroll
    for (int j = 0; j < 8; ++j) { const int n = (lane >> 3) + 8 * j; const LAS unsigned* s = scr + (4 * c) * 65 + n;
        v4u o; o.x = s[0]; o.y = s[65]; o.z = s[130]; o.w = s[195];
        *(GAS v4u*)(WT + (size_t)dest_row<MODE>(n0 + n) * (ldk ? ldk : K) + kofs + k0 + 8 * c) = o; }
    LDS_WAIT(); asm volatile("" ::: "memory");
}

struct Ptrs {
    const float* x; const int* pos; const float* w_in; const float* b_gate; const float *lq1, *lk1, *lq2, *lk2; const float* subln_g; const float *qn_g, *kvn_g;
    const float *w_uq, *w_ukv, *w_pa, *w_pb, *w_out, *ln1_g, *ln1_b, *w_up, *conv_w, *conv_b, *w_down, *ln2_g, *ln2_b;
    float* out; unsigned char* ws;
};

__device__ __forceinline__ void p0_prologue(const Ptrs& P, LAS unsigned char* lds, int vcu, int G, int wave, int lane) {
    LAS unsigned* scr = (LAS unsigned*)(lds + wave * 8448);
    const int gw = vcu * NWAVES + wave, NGW = G * NWAVES;
    unsigned char* ws = P.ws;
    constexpr int I_IN = (IN_COLS / 64) * (DM / 64), I_UQ = (3072 / 64) * (1024 / 64), I_UKV = (4096 / 64) * (512 / 64), I_PA = (4096 / 64) * (2048 / 64), I_OUT = (4096 / 64) * (4096 / 64),
                  I_UP = (22016 / 64) * (4096 / 64), I_DN = (4096 / 64) * (DFF / 64);
    constexpr int NITEMS = I_IN + I_UQ + I_UKV + 2 * I_PA + I_OUT + I_UP + I_DN;
    for (int it = gw; it < NITEMS; it += NGW) {
        int r = it;
        if (r < I_IN)  { tr_item<1>(P.w_in, DM, IN_COLS, nullptr, (bf16*)(ws + WS_WIN), scr, r % (DM / 64), r / (DM / 64), lane); continue; } r -= I_IN;
        if (r < I_UQ)  { tr_item<2>(P.w_uq, 1024, 3072, P.qn_g, (bf16*)(ws + WS_WUQ), scr, r % 16, r / 16, lane); continue; } r -= I_UQ;
        if (r < I_UKV) { tr_item<0>(P.w_ukv, 512, 4096, P.kvn_g, (bf16*)(ws + WS_WUKV), scr, r % 8, r / 8, lane); continue; } r -= I_UKV;
        if (r < I_PA)  { tr_item<0>(P.w_pa, 2048, 4096, nullptr, (bf16*)(ws + WS_WPA), scr, r % 32, r / 32, lane, 4096, 0); continue; } r -= I_PA;
        if (r < I_PA)  { tr_item<0>(P.w_pb, 2048, 4096, nullptr, (bf16*)(ws + WS_WPA), scr, r % 32, r / 32, lane, 4096, 2048); continue; } r -= I_PA;
        if (r < I_OUT) { tr_item<0>(P.w_out, 4096, 4096, nullptr, (bf16*)(ws + WS_WOUT), scr, r % 64, r / 64, lane); continue; } r -= I_OUT;
        if (r < I_UP)  { tr_item<3>(P.w_up, 4096, 22016, nullptr, (bf16*)(ws + WS_WUP), scr, r % 64, r / 64, lane); continue; } r -= I_UP;
        tr_item<0>(P.w_down, DFF, 4096, nullptr, (bf16*)(ws + WS_WDN), scr, r % (DFF / 64), r / (DFF / 64), lane);
    }
    { const size_t n8 = (size_t)M * DM / 8; GAS v4u* xb = (GAS v4u*)(ws + WS_XB);
      for (size_t i = (size_t)gw * 64 + lane; i < n8; i += (size_t)NGW * 64) { const f32x4 a = *(const GAS f32x4*)(P.x + i * 8), b = *(const GAS f32x4*)(P.x + i * 8 + 4);
          v4u o; o.x = cvt_pk(a[0], a[1]); o.y = cvt_pk(a[2], a[3]); o.z = cvt_pk(b[0], b[1]); o.w = cvt_pk(b[2], b[3]); xb[i] = o; } }
    { GAS v4u* z = (GAS v4u*)(ws + WS_WIN + (size_t)IN_COLS * DM * 2); const size_t nz = (size_t)(N1 - IN_COLS) * DM * 2 / 16;
      for (size_t i = (size_t)gw * 64 + lane; i < nz; i += (size_t)NGW * 64) z[i] = (v4u){0u, 0u, 0u, 0u};
    }
    { GAS float* rt = (GAS float*)(ws + WS_ROPE);
      for (int i = gw * 64 + lane; i < M * 32; i += NGW * 64) { const int m = i >> 5, k = i & 31;
          const double inv = exp2(-(double)k * (13.287712379549449 / 32.0));
          const double rev = (double)P.pos[m] * inv * 0.15915494309189535;
          const float fr = (float)(rev - rint(rev));
          rt[(size_t)m * 64 + k] = __builtin_amdgcn_cosf(fr); rt[(size_t)m * 64 + 32 + k] = __builtin_amdgcn_sinf(fr); } }
}

namespace att {
__device__ __forceinline__ void glds16(const void* sbase, unsigned voff, unsigned lds_dst) {
    unsigned keep;
    asm volatile("s_mov_b32 %0, m0\n\ts_mov_b32 m0, %3\n\ts_nop 0\n\tglobal_load_lds_dwordx4 %1, %2\n\ts_mov_b32 m0, %0" : "=&s"(keep) : "v"(voff), "s"(sbase), "s"(lds_dst) : "memory");
}
__device__ __forceinline__ int v_rd_base(int lane) { return ((lane & 3) << 3) | (((lane >> 2) & 3) << 6) | (((lane >> 4) & 1) << 5) | (((lane >> 5) & 1) << 8); }
#define ATT_BAR() asm volatile("s_barrier" ::: "memory")

template <int DQK, int DV, bool ALIBI>
__device__ __forceinline__ void attn_block(LAS unsigned char* lds, const unsigned char* wsb, const bf16* Q, int ldq, unsigned kofs, unsigned ldkB, unsigned vofs, unsigned ldvB,
                                           int qb, float slope2, f32x16 (&o)[DV / 32], float& l_out) {
    constexpr int NQF = DQK / 16, NOD = DV / 32, KROW = DQK * 2, KT = 64 * KROW, VT = 64 * DV * 2, KCH = DQK / 8, NKI = KT / 8192, NVI = VT / 8192;
    const int tid = threadIdx.x, wid = __builtin_amdgcn_readfirstlane(tid >> 6), lane = tid & 63, r32 = lane & 31, hi = lane >> 5;
    const unsigned ldsb = (unsigned)(uintptr_t)lds;
    __builtin_assume(qb >= 0); __builtin_assume(qb < 32);
    const int NT = 4 * (qb + 1);
    constexpr bool KEEP = (DV == 128);
    constexpr int NB = (DV == 128) ? 3 : 2;
    static_assert(NB * (KT + VT) <= RING_BYTES, "tile buffers must fit the ring");
#define KSW(cs_, row_) (DQK == 128 ? ((cs_) ^ ((row_) & 15)) : (((cs_) & ~7) | (((cs_) ^ ((row_) >> 1)) & 7)))
    unsigned krel[NKI], vrel[NVI];
#pragma unroll
    for (int j = 0; j < (KEEP ? NKI : 1); ++j) { const int p = (j * 8 + wid) * 64 + lane, row = p / KCH, cs = p - row * KCH, c = KSW(cs, row); krel[j] = kofs + (unsigned)row * ldkB + (unsigned)c * 16u; }
#pragma unroll
    for (int j = 0; j < (KEEP ? NVI : 1); ++j) { const int p = (j * 8 + wid) * 64 + lane, s = p >> 5, rr = (p & 31) >> 2, cc = p & 3, kg = s / NOD, d0 = s - kg * NOD, kk = kg * 8 + rr;
        const int key = (kk & ~0xC) | ((kk & 4) << 1) | ((kk & 8) >> 1); vrel[j] = vofs + (unsigned)key * ldvB + (unsigned)(d0 * 32 + cc * 8) * 2u; }
    static_assert(KEEP || (KCH == 16 && NOD == 8), "the one-offset form assumes a piece step of 32 K rows = 16 V keys");
#define ATT_ISSUE(t_, bf_) do { const unsigned kb_ = (unsigned)(t_) * 64u; \
        if (KEEP) { \
        _Pragma("unroll") for (int j = 0; j < NKI; ++j) glds16(wsb, krel[j] + kb_ * ldkB, (unsigned)__builtin_amdgcn_readfirstlane(ldsb + (bf_) * KT + (j * 8 + wid) * 1024)); \
        _Pragma("unroll") for (int j = 0; j < NVI; ++j) glds16(wsb, vrel[j] + kb_ * ldvB, (unsigned)__builtin_amdgcn_readfirstlane(ldsb + NB * KT + (bf_) * VT + (j * 8 + wid) * 1024)); \
        } else { \
        _Pragma("unroll") for (int j = 0; j < NKI; ++j) glds16(wsb + (size_t)(kb_ + 32u * j) * ldkB, krel[0], (unsigned)__builtin_amdgcn_readfirstlane(ldsb + (bf_) * KT + (j * 8 + wid) * 1024)); \
        _Pragma("unroll") for (int j = 0; j < NVI; ++j) glds16(wsb + (size_t)(kb_ + 16u * j) * ldvB, vrel[0], (unsigned)__builtin_amdgcn_readfirstlane(ldsb + NB * KT + (bf_) * VT + (j * 8 + wid) * 1024)); } } while (0)
    ATT_BAR();
    ATT_ISSUE(NT - 1, 0);
    if (NB == 3) ATT_ISSUE(NT - 2, 1);
    bf16x8 qr[NQF];
#pragma unroll
    for (int d0 = 0; d0 < NQF; ++d0) qr[d0] = *(const bf16x8*)(Q + (size_t)(wid * 32 + r32) * ldq + d0 * 16 + hi * 8);
    float m_reg = -1e30f, l_reg = 0.f;
#pragma unroll
    for (int d0 = 0; d0 < NOD; ++d0)
#pragma unroll
        for (int r = 0; r < 16; ++r) o[d0][r] = 0.f;
    const int qi = qb * 256 + wid * 32 + r32;
    asm volatile(".p2align 6");
    int bf = NB == 3 ? -1 : 0;
    for (int i = 0; i < NT; ++i) {
        const int t = NT - 1 - i;
        if (NB == 3) { if (++bf == 3) bf = 0;
            if (i + 1 < NT) asm volatile("s_waitcnt vmcnt(%0)\n\ts_barrier" :: "n"(NKI + NVI) : "memory"); else asm volatile("s_waitcnt vmcnt(0)\n\ts_barrier" ::: "memory");
        } else { bf = i & 1;
            asm volatile("s_waitcnt vmcnt(0)\n\ts_barrier" ::: "memory");
        }
        const int bfn = bf == 0 ? 2 : bf - 1;
        const int jb = t - 4 * qb;
        if (!(jb > (wid >> 1))) {
        f32x16 p0, p1;
        if (ALIBI) {
            float s2o = slope2; asm volatile("" : "+v"(s2o));
            const float h4 = s2o * (float)(4 * hi);
#pragma unroll
            for (int r = 0; r < 16; ++r) { const float cr = (float)((r & 3) + 8 * (r >> 2)); p0[r] = __builtin_fmaf(s2o, cr, h4); p1[r] = __builtin_fmaf(s2o, cr + 32.f, h4); }
        } else {
#pragma unroll
            for (int r = 0; r < 16; ++r) { p0[r] = 0.f; p1[r] = 0.f; }
        }
        { const LAS unsigned char* kt = lds + bf * KT + r32 * KROW;
          const LAS unsigned char* kb4[4];
          const int key = DQK == 128 ? r32 : (r32 >> 1), hb = DQK == 128 ? ((r32 >> 3) & 1) : 0;
#pragma unroll
          for (int dd = 0; dd < 4; ++dd) kb4[dd] = kt + ((((dd * 2 + hi) ^ key) & 7) << 4) + hb * 128;
#define ATT_KADDR(d0_) (DQK == 128 ? kb4[(d0_) & 3] + (((d0_) >> 2) ? 128 - 256 * hb : 0) : kb4[(d0_) & 3] + ((d0_) >> 2) * 128)
          constexpr int PFD = (DV == 128) ? 2 : 0;
          bf16x8 kf[PFD + 1][2];
#pragma unroll
          for (int d0 = 0; d0 < PFD; ++d0) { const LAS unsigned char* a = ATT_KADDR(d0); kf[d0][0] = *(const LAS bf16x8*)a; kf[d0][1] = *(const LAS bf16x8*)(a + 32 * KROW); }
#pragma unroll
          for (int d0 = 0; d0 < NQF; ++d0) {
              if (d0 + PFD < NQF) { const LAS unsigned char* a = ATT_KADDR(d0 + PFD); kf[(d0 + PFD) % (PFD + 1)][0] = *(const LAS bf16x8*)a; kf[(d0 + PFD) % (PFD + 1)][1] = *(const LAS bf16x8*)(a + 32 * KROW); }
              if (PFD) __builtin_amdgcn_sched_barrier(0);
              p0 = __builtin_amdgcn_mfma_f32_32x32x16_bf16(kf[d0 % (PFD + 1)][0], qr[d0], p0, 0, 0, 0);
              p1 = __builtin_amdgcn_mfma_f32_32x32x16_bf16(kf[d0 % (PFD + 1)][1], qr[d0], p1, 0, 0, 0);
              if (PFD) __builtin_amdgcn_sched_barrier(0); }
#undef ATT_KADDR
        }
        __builtin_amdgcn_sched_barrier(0);
        const int kb = t * 64;
        float bq = 0.f;
        if (ALIBI) bq = slope2 * (float)(kb - qi);
        if (jb == (wid >> 1)) { const int dq = qi - kb - 4 * hi; const float NEG = -__builtin_inff();
#pragma unroll
            for (int r = 0; r < 16; ++r) { const int c = (r & 3) + 8 * (r >> 2); if (c > dq) p0[r] = NEG; if (c + 32 > dq) p1[r] = NEG; } }
        float pmax = p0[0];
#pragma unroll
        for (int r = 1; r < 16; ++r) pmax = fmaxf(pmax, p0[r]);
#pragma unroll
        for (int r = 0; r < 16; ++r) pmax = fmaxf(pmax, p1[r]);
        { auto rr = __builtin_amdgcn_permlane32_swap(__float_as_uint(pmax), __float_as_uint(pmax), false, false); pmax = fmaxf(__uint_as_float(rr[0]), __uint_as_float(rr[1])); }
        const float mx = pmax + bq;
        float alpha = 1.f;
        if (!__all(mx - m_reg <= 8.f)) { const float mn = fmaxf(m_reg, mx); alpha = __builtin_amdgcn_exp2f(m_reg - mn); m_reg = mn;
#pragma unroll
            for (int d0 = 0; d0 < NOD; ++d0)
#pragma unroll
                for (int r = 0; r < 16; ++r) o[d0][r] *= alpha; }
        if (NB == 2 && i + 1 < NT) ATT_ISSUE(t - 1, bf ^ 1);
        const float ms = m_reg - bq;
        float ps = 0.f;
#pragma unroll
        for (int r = 0; r < 16; ++r) { p0[r] = __builtin_amdgcn_exp2f(p0[r] - ms); ps += p0[r]; }
#pragma unroll
        for (int r = 0; r < 16; ++r) { p1[r] = __builtin_amdgcn_exp2f(p1[r] - ms); ps += p1[r]; }
        { auto rr = __builtin_amdgcn_permlane32_swap(__float_as_uint(ps), __float_as_uint(ps), false, false); ps = __uint_as_float(rr[0]) + __uint_as_float(rr[1]); }
        l_reg = l_reg * alpha + ps;
        bf16x8 pa0, pa1, pa2, pa3;
#define ATT_PK4(P, B_, OUT) do { const unsigned a0 = cvt_pk(P[B_ + 0], P[B_ + 1]), a1 = cvt_pk(P[B_ + 2], P[B_ + 3]), b0 = cvt_pk(P[B_ + 4], P[B_ + 5]), b1 = cvt_pk(P[B_ + 6], P[B_ + 7]); \
        auto r0 = __builtin_amdgcn_permlane32_swap(a0, b0, false, false); auto r1 = __builtin_amdgcn_permlane32_swap(a1, b1, false, false); \
        v4u w = {r0[0], r1[0], r0[1], r1[1]}; OUT = __builtin_bit_cast(bf16x8, w); } while (0)
        ATT_PK4(p0, 0, pa0); ATT_PK4(p0, 8, pa1); ATT_PK4(p1, 0, pa2); ATT_PK4(p1, 8, pa3);
#undef ATT_PK4
        __builtin_amdgcn_sched_barrier(0);
        { const unsigned vb0 = ldsb + NB * KT + bf * VT + v_rd_base(lane);
#define ATT_TRRD(dst, off) asm volatile("ds_read_b64_tr_b16 %0, %1 offset:%2" : "=&v"(dst) : "v"(vb0), "i"(off) : "memory")
#pragma unroll
          for (int d0 = 0; d0 < NOD; ++d0) { s16x4 l0, l1, l2, l3, h0, h1, h2, h3;
              ATT_TRRD(l0, (0 * NOD + d0) * 512); ATT_TRRD(h0, (1 * NOD + d0) * 512); ATT_TRRD(l1, (2 * NOD + d0) * 512); ATT_TRRD(h1, (3 * NOD + d0) * 512);
              ATT_TRRD(l2, (4 * NOD + d0) * 512); ATT_TRRD(h2, (5 * NOD + d0) * 512); ATT_TRRD(l3, (6 * NOD + d0) * 512); ATT_TRRD(h3, (7 * NOD + d0) * 512);
              asm volatile("s_waitcnt lgkmcnt(0)" ::: "memory"); __builtin_amdgcn_sched_barrier(0);
              o[d0] = __builtin_amdgcn_mfma_f32_32x32x16_bf16((bf16x8){l0[0], l0[1], l0[2], l0[3], h0[0], h0[1], h0[2], h0[3]}, pa0, o[d0], 0, 0, 0);
              o[d0] = __builtin_amdgcn_mfma_f32_32x32x16_bf16((bf16x8){l1[0], l1[1], l1[2], l1[3], h1[0], h1[1], h1[2], h1[3]}, pa1, o[d0], 0, 0, 0);
              o[d0] = __builtin_amdgcn_mfma_f32_32x32x16_bf16((bf16x8){l2[0], l2[1], l2[2], l2[3], h2[0], h2[1], h2[2], h2[3]}, pa2, o[d0], 0, 0, 0);
              o[d0] = __builtin_amdgcn_mfma_f32_32x32x16_bf16((bf16x8){l3[0], l3[1], l3[2], l3[3], h3[0], h3[1], h3[2], h3[3]}, pa3, o[d0], 0, 0, 0); }
#undef ATT_TRRD
        }
        }
        if (NB == 3 && i + 2 < NT) ATT_ISSUE(t - 2, bfn);
        if (NB == 2 && (jb > (wid >> 1)) && i + 1 < NT) ATT_ISSUE(t - 1, bf ^ 1);
    }
#undef ATT_ISSUE
#undef KSW
    l_out = l_reg;
}

#define ATT_ST_PAIR(row_, colg_, A_, B_) do { v2u a_ = (A_), b_ = (B_); \
        auto rx_ = __builtin_amdgcn_permlane32_swap(a_.x, b_.x, false, false); auto ry_ = __builtin_amdgcn_permlane32_swap(a_.y, b_.y, false, false); \
        *(v4u*)((row_) + (colg_) + 8 * hi) = (v4u){rx_[0], ry_[0], rx_[1], ry_[1]}; } while (0)
constexpr int CW_ATTQ = 8192, CW_NMAX = 12288;
__device__ __forceinline__ void attn_phase(const Ptrs& P, LAS unsigned char* lds, volatile LAS unsigned* MISC, gu32* ctl, int qoff) {
    const int tid = threadIdx.x, wid = __builtin_amdgcn_readfirstlane(tid >> 6), lane = tid & 63, r32 = lane & 31, hi = lane >> 5;
    unsigned char* ws = P.ws;
    const bf16* QKV = (const bf16*)(ws + WS_QKV); const bf16* QB = (const bf16*)(ws + WS_QB); bf16* OAB = (bf16*)(ws + WS_OAB);
    float lam;
    { const float s1 = wave_sum(P.lq1[lane] * P.lk1[lane] + P.lq1[lane + 64] * P.lk1[lane + 64]), s2 = wave_sum(P.lq2[lane] * P.lk2[lane] + P.lq2[lane + 64] * P.lk2[lane + 64]);
      lam = expf(s1) - expf(s2) + LAMBDA_INIT; }
    const int q0 = (int)(xb_xcc_id() & 7u);
    if (tid < 64) MISC[64 + tid] = 0u;
    __syncthreads();
    { const int w = tid & 63; unsigned mx = 0u; const GAS unsigned* part = (const GAS unsigned*)(ws + WS_NPART);
      for (int g = tid >> 6; g < (int)gridDim.x; g += 8) { const unsigned v = part[g * 64 + w]; mx = v > mx ? v : mx; }
      __hip_atomic_fetch_max((LAS unsigned*)(MISC + 64 + w), mx, __ATOMIC_RELAXED, __HIP_MEMORY_SCOPE_WORKGROUP); }
    __syncthreads();
    if (tid < 32) { const int b = tid >> 4, h = (tid >> 1) & 7, map = tid & 1;
        const float nq = __uint_as_float(MISC[64 + (b * 16 + h * 2 + map) * 2]), nk = __uint_as_float(MISC[64 + (b * 16 + h * 2 + map) * 2 + 1]);
        const float slope2 = LOG2E * exp2f(-(float)(h + 1));
        const float B = sqrtf(nq * nk) * 1.001f + 0.01f, Wf = (2.f * B + 126.f) / slope2;
        const float wq = ceilf(Wf * (1.0001f / 256.f) + 0.001f);
        MISC[32 + tid] = wq < 1000.f ? (unsigned)wq : 1000u; }
    __syncthreads();
    for (int dq = 0; dq < 8; ++dq) {
        const int q = (q0 + dq) & 7, b = q >> 2, qx = q & 3;
        for (;;) {
            if (tid == 0) MISC[16] = __hip_atomic_fetch_add((unsigned*)(ctl + CW_ATTQ + qoff + 64 * q), 1u, __ATOMIC_RELAXED, __HIP_MEMORY_SCOPE_AGENT);
            __syncthreads();
            const int n = (int)__builtin_amdgcn_readfirstlane(MISC[16]);
            __syncthreads();
            if (n >= 64) break;
            const int h = (n < 32) ? 7 - qx : qx, qb = 31 - (n & 31);
            const float slope2 = LOG2E * exp2f(-(float)(h + 1));
            unsigned char* scrb = ws + WS_O0 + (size_t)blockIdx.x * 262144 + (size_t)wid * 32768;
            const size_t rowq = (size_t)b * SEQ + (size_t)qb * 256;
#pragma unroll 1
            for (int map = 0; map < 2; ++map) {
                int qs = qb - (int)MISC[32 + (b * 8 + h) * 2 + map]; qs = __builtin_amdgcn_readfirstlane(qs > 0 ? qs : 0);
                f32x16 o[8]; float l;
                attn_block<128, 256, true>(lds, ws, QKV + rowq * 6144 + h * 256 + map * 128, 6144,
                                           (unsigned)(WS_QKV + (((size_t)b * SEQ + (size_t)qs * 256) * 6144 + 2048 + h * 256 + map * 128) * 2), 12288u,
                                           (unsigned)(WS_QKV + (((size_t)b * SEQ + (size_t)qs * 256) * 6144 + 4096 + h * 256) * 2), 12288u, qb - qs, slope2, o, l);
                const float inv = 1.f / l;
                unsigned so = (unsigned)lane * 16u; asm volatile("" : "+v"(so));
                f32x4* scr = (f32x4*)(scrb + so);
                if (map == 0) {
#pragma unroll
                    for (int d0 = 0; d0 < 8; ++d0)
#pragma unroll
                        for (int g = 0; g < 4; ++g) scr[(d0 * 4 + g) * 64] = (f32x4){o[d0][4 * g] * inv, o[d0][4 * g + 1] * inv, o[d0][4 * g + 2] * inv, o[d0][4 * g + 3] * inv};
                } else {
                    const float li = lam * inv; float ss = 0.f;
#pragma unroll
                    for (int d0 = 0; d0 < 8; ++d0) {
#pragma unroll
                        for (int g = 0; g < 4; ++g) { const f32x4 a = scr[(d0 * 4 + g) * 64];
#pragma unroll
                            for (int e = 0; e < 4; ++e) { const float v = a[e] - li * o[d0][4 * g + e]; ss += v * v; } }
                        asm volatile("" : "+v"(ss) :: "memory"); }
                    { auto rr = __builtin_amdgcn_permlane32_swap(__float_as_uint(ss), __float_as_uint(ss), false, false); ss = __uint_as_float(rr[0]) + __uint_as_float(rr[1]); }
                    const float rs = __builtin_amdgcn_rsqf(ss * (1.f / 256.f) + RMS_EPS) * (1.f - LAMBDA_INIT);
                    unsigned oo = (unsigned)((wid * 32 + r32) * 4096) * 2u; asm volatile("" : "+v"(oo));
                    bf16* orow = (bf16*)((unsigned char*)(OAB + rowq * 4096 + h * 256) + oo);
#pragma unroll
                    for (int d0 = 0; d0 < 8; ++d0) {
#pragma unroll
                        for (int g = 0; g < 4; g += 2) { v2u w[2];
#pragma unroll
                            for (int q = 0; q < 2; ++q) { const f32x4 a = scr[(d0 * 4 + g + q) * 64]; const f32x4 gg = *(const f32x4*)(P.subln_g + d0 * 32 + 8 * (g + q) + 4 * hi);
                                float v[4];
#pragma unroll
                                for (int e = 0; e < 4; ++e) v[e] = (a[e] - li * o[d0][4 * (g + q) + e]) * rs * gg[e];
                                w[q].x = cvt_pk(v[0], v[1]); w[q].y = cvt_pk(v[2], v[3]); }
                            ATT_ST_PAIR(orow, d0 * 32 + 8 * g, w[0], w[1]); }
                        asm volatile("" ::: "memory"); }
                }
            }
        }
    }
    for (int dq = 0; dq < 8; ++dq) {
        const int q = (q0 + dq) & 7, b = q >> 2, qx = q & 3;
        for (;;) {
            if (tid == 0) MISC[16] = __hip_atomic_fetch_add((unsigned*)(ctl + CW_ATTQ + qoff + 64 * (8 + q)), 1u, __ATOMIC_RELAXED, __HIP_MEMORY_SCOPE_AGENT);
            __syncthreads();
            const int n = (int)__builtin_amdgcn_readfirstlane(MISC[16]);
            __syncthreads();
            if (n >= 128) break;
            const int h = 4 * qx + (n & 3), qb = 31 - (n >> 2);
            const size_t rowq = (size_t)b * SEQ + (size_t)qb * 256;
            f32x16 o[4]; float l;
            const unsigned kofs = (unsigned)(WS_KVB + ((size_t)b * SEQ * KVLD + h * 320) * 2);
            attn_block<192, 128, false>(lds, ws, QB + rowq * 3072 + h * 192, 3072, kofs, (unsigned)(KVLD * 2), kofs + 384u, (unsigned)(KVLD * 2), qb, 0.f, o, l);
            const float inv = 1.f / l;
            unsigned oo = (unsigned)((wid * 32 + r32) * 4096) * 2u; asm volatile("" : "+v"(oo));
            bf16* orow = (bf16*)((unsigned char*)(OAB + rowq * 4096 + 2048 + h * 128) + oo);
#pragma unroll
            for (int d0 = 0; d0 < 4; ++d0)
#pragma unroll
                for (int g = 0; g < 4; g += 2) { v2u w0, w1;
                    w0.x = cvt_pk(o[d0][4 * g] * inv, o[d0][4 * g + 1] * inv); w0.y = cvt_pk(o[d0][4 * g + 2] * inv, o[d0][4 * g + 3] * inv);
                    w1.x = cvt_pk(o[d0][4 * g + 4] * inv, o[d0][4 * g + 5] * inv); w1.y = cvt_pk(o[d0][4 * g + 6] * inv, o[d0][4 * g + 7] * inv);
                    ATT_ST_PAIR(orow, d0 * 32 + 8 * g, w0, w1); }
        }
    }
}
}

__device__ __forceinline__ void rowss_phase(const bf16* LAT, float* rowss, int gw, int NGW, int lane) {
    for (int m = gw; m < M; m += NGW) {
        const GAS v4u* r = (const GAS v4u*)(LAT + (size_t)m * 1536) + lane;
        float sq = 0.f, sk = 0.f;
#pragma unroll
        for (int j = 0; j < 3; ++j) { const v4u w = r[64 * j]; f32x4 a, b; pg8::unpack8(w, a, b);
            const float t = (a[0] * a[0] + a[1] * a[1]) + (a[2] * a[2] + a[3] * a[3]) + (b[0] * b[0] + b[1] * b[1]) + (b[2] * b[2] + b[3] * b[3]);
            if (j < 2) sq += t; else sk += t; }
        sq = wave_sum(sq); sk = wave_sum(sk);
        if (lane == 0) { rowss[m] = sq; rowss[M + m] = sk; }
    }
}
__device__ __forceinline__ void normmax_phase(const bf16* QKV, volatile LAS unsigned* nmax  , int gw, int NGW, int lane) {
    float mq[4] = {0.f, 0.f, 0.f, 0.f}, mk[4] = {0.f, 0.f, 0.f, 0.f}; int cur_b = -1;
    for (int m = gw; ; m += NGW) {
        const int b = m < M ? m / SEQ : -2;
        if (b != cur_b) {
            if (cur_b >= 0 && (lane & 15) == 0) {
#pragma unroll
                for (int j = 0; j < 4; ++j) { const int v = j * 4 + (lane >> 4);
                    __hip_atomic_fetch_max((LAS unsigned*)(nmax + (cur_b * 16 + v) * 2), __float_as_uint(mq[j]), __ATOMIC_RELAXED, __HIP_MEMORY_SCOPE_WORKGROUP);
                    __hip_atomic_fetch_max((LAS unsigned*)(nmax + (cur_b * 16 + v) * 2 + 1), __float_as_uint(mk[j]), __ATOMIC_RELAXED, __HIP_MEMORY_SCOPE_WORKGROUP); } }
#pragma unroll
            for (int j = 0; j < 4; ++j) { mq[j] = 0.f; mk[j] = 0.f; }
            cur_b = b;
        }
        if (m >= M) break;
        const GAS v4u* rq = (const GAS v4u*)(QKV + (size_t)m * 6144) + lane;
#pragma unroll
        for (int j = 0; j < 4; ++j) {
            f32x4 a, c; pg8::unpack8(rq[64 * j], a, c);
            float tq = (a[0] * a[0] + a[1] * a[1]) + (a[2] * a[2] + a[3] * a[3]) + (c[0] * c[0] + c[1] * c[1]) + (c[2] * c[2] + c[3] * c[3]);
            pg8::unpack8(rq[256 + 64 * j], a, c);
            float tk = (a[0] * a[0] + a[1] * a[1]) + (a[2] * a[2] + a[3] * a[3]) + (c[0] * c[0] + c[1] * c[1]) + (c[2] * c[2] + c[3] * c[3]);
#pragma unroll
            for (int o = 1; o < 16; o <<= 1) { tq += __shfl_xor(tq, o); tk += __shfl_xor(tk, o); }
            mq[j] = fmaxf(mq[j], tq); mk[j] = fmaxf(mk[j], tk);
        }
    }
}
__device__ __forceinline__ void ln_phase(const bf16* in, const float* g, const float* bta, float* of, bf16* ob, float* stat  , int gw, int NGW, int lane) {
    for (int m = gw; m < M; m += NGW) {
        GAS const v4u* xr = (GAS const v4u*)(in + (size_t)m * DM) + lane;
        f32x4 v[8][2]; float s = 0.f;
#pragma unroll
        for (int j = 0; j < 8; ++j) { const v4u w = xr[64 * j]; pg8::unpack8h(w, v[j][0], v[j][1]);
            s += ((v[j][0][0] + v[j][0][1]) + (v[j][0][2] + v[j][0][3])) + ((v[j][1][0] + v[j][1][1]) + (v[j][1][2] + v[j][1][3])); }
        const float mean = wave_sum(s) * (1.f / DM); float s2 = 0.f;
#pragma unroll
        for (int j = 0; j < 8; ++j)
#pragma unroll
            for (int h = 0; h < 2; ++h) { v[j][h] = v[j][h] - mean; s2 += (v[j][h][0] * v[j][h][0] + v[j][h][1] * v[j][h][1]) + (v[j][h][2] * v[j][h][2] + v[j][h][3] * v[j][h][3]); }
        const float rstd = 1.f / sqrtf(wave_sum(s2) * (1.f / DM) + LN_EPS);
        if (stat && lane == 0) { stat[m] = mean; stat[M + m] = rstd; }
#pragma unroll
        for (int j = 0; j < 8; ++j) { const int c = 8 * lane + 512 * j;
            const f32x4 y0 = v[j][0] * rstd * *(const f32x4*)(g + c) + *(const f32x4*)(bta + c), y1 = v[j][1] * rstd * *(const f32x4*)(g + c + 4) + *(const f32x4*)(bta + c + 4);
            if (of) { GAS f32x4* o = (GAS f32x4*)(of + (size_t)m * DM + c); o[0] = y0; o[1] = y1; }
            if (ob) *((GAS v4u*)(ob + (size_t)m * DM + c)) = pg8::pack8(y0, y1); }
    }
}
__device__ __forceinline__ void conv_fix_phase(const bf16* SIDE, const float* cw, const float* cb, bf16* ACT, int gw, int NGW, int lane) {
    constexpr int NCG = (DFF + 511) / 512, NCH = M / 64;
    for (int it = gw; it < NCG * NCH; it += NGW) {
        const int cg = it % NCG, c = it / NCG, ch = cg * 512 + lane * 8;
        if (ch >= DFF) continue;
        const bool first = (c % (SEQ / 64)) == 0;
        f32x4 u[4][2][2];
#pragma unroll
        for (int j = 0; j < 4; ++j)
#pragma unroll
            for (int gv = 0; gv < 2; ++gv) {
                if (j < 2 && first) { u[j][gv][0] = (f32x4){0.f, 0.f, 0.f, 0.f}; u[j][gv][1] = (f32x4){0.f, 0.f, 0.f, 0.f}; }
                else { const int cc = j < 2 ? c - 1 : c, jj = j < 2 ? j + 2 : j - 2;
                    pg8::unpack8(*(const v4u*)(SIDE + ((size_t)(cc * 4 + jj) * 2 + gv) * DFF + ch), u[j][gv][0], u[j][gv][1]); } }
#pragma unroll
        for (int r = 0; r < 2; ++r) {
            float o[8];
#pragma unroll
            for (int e = 0; e < 8; ++e) {
                const int h = e >> 2, q = e & 3;
                const float cgate = cb[ch + e] + cw[ch + e] * u[r][0][h][q] + cw[(size_t)2 * DFF + ch + e] * u[r + 1][0][h][q] + cw[(size_t)4 * DFF + ch + e] * u[r + 2][0][h][q];
                const float cval = cb[DFF + ch + e] + cw[DFF + ch + e] * u[r][1][h][q] + cw[(size_t)3 * DFF + ch + e] * u[r + 1][1][h][q] + cw[(size_t)5 * DFF + ch + e] * u[r + 2][1][h][q];
                o[e] = cgate * pg8::sigmoidf_(cgate) * cval;
            }
            v4u w; w.x = cvt_pk(o[0], o[1]); w.y = cvt_pk(o[2], o[3]); w.z = cvt_pk(o[4], o[5]); w.w = cvt_pk(o[6], o[7]);
            *(v4u*)(ACT + (size_t)(c * 64 + r) * DFF + ch) = w;
        }
    }
}

struct Args { const void* in[24]; float* out; unsigned char* ws; int ph_lo, ph_hi, li, pad; };
constexpr int N_PHASES = 11;
__global__ void __launch_bounds__(NWAVES * 64, 2) mk_fwd(Args args) {
    extern __shared__ __attribute__((aligned(16))) unsigned char lds_raw[];
    LAS unsigned char* lds = (LAS unsigned char*)lds_raw;
    volatile LAS unsigned* MISC = (volatile LAS unsigned*)(lds + MISC_OFF);
    const int tid = threadIdx.x, lane = tid & 63, wave = __builtin_amdgcn_readfirstlane(tid >> 6);
    const int G = gridDim.x; const int bx = blockIdx.x; const int vcu = (G % 8 == 0) ? (bx % 8) * (G / 8) + bx / 8 : bx;
    Ptrs P;
    P.x = (const float*)args.in[0]; P.pos = (const int*)args.in[1]; P.w_in = (const float*)args.in[2]; P.b_gate = (const float*)args.in[3];
    P.lq1 = (const float*)args.in[4]; P.lk1 = (const float*)args.in[5]; P.lq2 = (const float*)args.in[6]; P.lk2 = (const float*)args.in[7];
    P.subln_g = (const float*)args.in[8]; P.qn_g = (const float*)args.in[9]; P.kvn_g = (const float*)args.in[10];
    P.w_uq = (const float*)args.in[11]; P.w_ukv = (const float*)args.in[12]; P.w_pa = (const float*)args.in[13]; P.w_pb = (const float*)args.in[14]; P.w_out = (const float*)args.in[15];
    P.ln1_g = (const float*)args.in[16]; P.ln1_b = (const float*)args.in[17]; P.w_up = (const float*)args.in[18]; P.conv_w = (const float*)args.in[19]; P.conv_b = (const float*)args.in[20];
    P.w_down = (const float*)args.in[21]; P.ln2_g = (const float*)args.in[22]; P.ln2_b = (const float*)args.in[23];
    P.out = args.out; P.ws = args.ws;
    unsigned char* ws = args.ws;
    gu32* ctl = (gu32*)(ws + WS_CTL);
    for (int u = tid; u < (LDS_BYTES - LDSCTL_OFF) / 4; u += NWAVES * 64) ((LAS unsigned*)(lds + LDSCTL_OFF))[u] = 0u;
    __syncthreads();
    XcdBarrier bar = xcd_barrier_post((unsigned*)(ctl + 4096) + args.li * XCD_BAR_WORDS, MISC + 8);
    const int lo = args.ph_lo, hi = args.ph_hi;
#define IN(k) (lo <= (k) && (k) < hi)
#define SEAM(k) do { if (IN(k) && IN((k) + 1)) xcd_barrier(bar); } while (0)
#define SEAM2B() do { if (IN(2)) xcd_barrier(bar); } while (0)
    const int gw = vcu * NWAVES + wave, NGW = G * NWAVES;
    typedef pg8::bf16_t bt;
    const int xcd_rot = bx & 7;
#define KOFF(K_) ((((K_) / 64) * xcd_rot / 8) & ~1)

#define PH_ALIGN(n) asm volatile(".p2align 8\n\t.rept %0\n\ts_nop 0\n\t.endr" :: "n"(n))
    if (IN(0)) { p0_prologue(P, lds, vcu, G, wave, lane); } SEAM(0);

    if (IN(1)) {
        PH_ALIGN(0);
        pg8::Gemm g{(const bt*)(ws + WS_XB), (const bt*)(ws + WS_WIN), M, N1, DM, DM, DM, KOFF(DM)}; pg8::StaticOrder S; S.init(M, N1, G, bx);
        pg8::EpiIn E{(bt*)(ws + WS_QKV), (bt*)(ws + WS_LAT), (bt*)(ws + WS_G), (bt*)(ws + WS_KVB), (float*)(ws + WS_ROWSS), P.b_gate, (const float*)(ws + WS_ROPE), C2A, M};
        pg8::gemm_phase<pg8::EpiIn, pg8::StaticOrder, true, true>(lds, g, S, E);
    } SEAM(1);

    if (IN(2)) {
        if (tid < 64) MISC[64 + tid] = 0u;
        __syncthreads();
        rowss_phase((const bf16*)(ws + WS_LAT), (float*)(ws + WS_ROWSS), gw, NGW, lane);
        normmax_phase((const bf16*)(ws + WS_QKV), MISC + 64, gw, NGW, lane);
        __syncthreads();
        if (tid < 64) ((GAS unsigned*)(ws + WS_NPART))[bx * 64 + tid] = MISC[64 + tid];
    } SEAM2B();

    if (IN(2)) {
        PH_ALIGN(0);
        { pg8::Gemm g{(const bt*)(ws + WS_LAT), (const bt*)(ws + WS_WUQ), M, 3072, 1024, 1536, 1024, KOFF(1024)}; pg8::StaticOrder S; S.init(M, 3072, G, bx);
          pg8::EpiQb E{(bt*)(ws + WS_QB), (const float*)(ws + WS_ROWSS), (const float*)(ws + WS_ROPE), C2B};
          pg8::gemm_phase<pg8::EpiQb, pg8::StaticOrder, true, true>(lds, g, S, E); }
        { pg8::Gemm g{(const bt*)(ws + WS_LAT) + 1024, (const bt*)(ws + WS_WUKV), M, 4096, 512, 1536, 512, KOFF(512)}; pg8::StaticOrder S; S.init(M, 4096, G, bx);
          pg8::EpiKv E{(bt*)(ws + WS_KVB), (const float*)(ws + WS_ROWSS) + M};
          pg8::gemm_phase<pg8::EpiKv, pg8::StaticOrder, true, true>(lds, g, S, E); }
    } SEAM(2);

    if (IN(3)) { PH_ALIGN(0); att::attn_phase(P, lds, MISC, ctl, 0); } SEAM(3);

    if (IN(4)) { PH_ALIGN(0);
        pg8::Gemm g{(const bt*)(ws + WS_OAB), (const bt*)(ws + WS_WPA), M, 4096, 4096, 4096, 4096, 0}; pg8::StaticOrder S; S.init(M, 4096, G, bx);
        pg8::EpiMerge E{(const bt*)(ws + WS_G), (bt*)(ws + WS_MRG)};
        pg8::gemm_phase<pg8::EpiMerge, pg8::StaticOrder, true, true>(lds, g, S, E);
    } SEAM(4);

    if (IN(5)) { PH_ALIGN(0);
        pg8::Gemm g{(const bt*)(ws + WS_MRG), (const bt*)(ws + WS_WOUT), M, 4096, 4096, 4096, 4096, KOFF(4096)}; pg8::StaticOrder S; S.init(M, 4096, G, bx);
        pg8::EpiRes E{P.x, (bt*)(ws + WS_YB), ALPHA};
        pg8::gemm_phase<pg8::EpiRes, pg8::StaticOrder, true, true>(lds, g, S, E);
    } SEAM(5);

    if (IN(6)) { PH_ALIGN(0); ln_phase((const bf16*)(ws + WS_YB), P.ln1_g, P.ln1_b, nullptr, (bf16*)(ws + WS_H1B), (float*)(ws + WS_ROWSS), gw, NGW, lane); } SEAM(6);

    if (IN(7)) { PH_ALIGN(0);
        pg8::Gemm g{(const bt*)(ws + WS_H1B), (const bt*)(ws + WS_WUP), M, 22016, 4096, 4096, 4096, KOFF(4096)}; pg8::StaticOrder S; S.init(M, 22016, G, bx);
        pg8::EpiConv E{(bt*)(ws + WS_ACT), (bt*)(ws + WS_SIDE), P.conv_w, P.conv_b, DFF};
        pg8::gemm_phase<pg8::EpiConv, pg8::StaticOrder, true, true>(lds, g, S, E);
    } SEAM(7);

    if (IN(8)) { PH_ALIGN(0); conv_fix_phase((const bf16*)(ws + WS_SIDE), P.conv_w, P.conv_b, (bf16*)(ws + WS_ACT), gw, NGW, lane); } SEAM(8);

    if (IN(9)) { PH_ALIGN(0);
        pg8::Gemm g{(const bt*)(ws + WS_ACT), (const bt*)(ws + WS_WDN), M, 4096, DFF, DFF, DFF, KOFF(DFF)}; pg8::StaticOrder S; S.init(M, 4096, G, bx);
        pg8::EpiDown E{(const bt*)(ws + WS_YB), (bt*)(ws + WS_Y2B), (const float*)(ws + WS_ROWSS), P.ln1_g, P.ln1_b, ALPHA, M};
        pg8::gemm_phase<pg8::EpiDown, pg8::StaticOrder, true, true>(lds, g, S, E);
    } SEAM(9);

    if (IN(10)) { PH_ALIGN(0); ln_phase((const bf16*)(ws + WS_Y2B), P.ln2_g, P.ln2_b, P.out, nullptr, nullptr, gw, NGW, lane); }
#undef IN
#undef SEAM
#undef SEAM2B
}

extern "C" void kernel_launch(void* const* d_in, const int* in_sizes, int n_in, void* d_out, int out_size, void* d_ws, size_t ws_size, hipStream_t stream) {
    static int grid = 0;
    if (grid == 0) {
        if (n_in != 24 || in_sizes[0] != M * DM || out_size != M * DM || ws_size < WS_END) { fprintf(stderr, "kernel_launch: unexpected shapes (n_in %d, x %d, out %d, ws %zu < %zu)\n", n_in, n_in > 0 ? in_sizes[0] : -1, out_size, ws_size, (size_t)WS_END); grid = -1; return; }
        int dev = 0, cus = 0, per_cu = 0;
        if (hipGetDevice(&dev) != hipSuccess || hipDeviceGetAttribute(&cus, hipDeviceAttributeMultiprocessorCount, dev) != hipSuccess) { grid = -1; return; }
        if (hipFuncSetAttribute((const void*)mk_fwd, hipFuncAttributeMaxDynamicSharedMemorySize, LDS_BYTES) != hipSuccess) { fprintf(stderr, "kernel_launch: hipFuncSetAttribute failed\n"); grid = -1; return; }
        if (hipOccupancyMaxActiveBlocksPerMultiprocessor(&per_cu, (const void*)mk_fwd, NWAVES * 64, LDS_BYTES) != hipSuccess || per_cu < 1) fprintf(stderr, "kernel_launch: occupancy query says %d\n", per_cu);
        (void)hipGetLastError();
        grid = cus < 256 ? cus : 256;
    }
    if (grid < 0) return;
    if (hipMemsetAsync((char*)d_ws + WS_CTL, 0, CTL_ZERO_BYTES, stream) != hipSuccess) return;
    Args a{};
    for (int i = 0; i < 24; ++i) a.in[i] = d_in[i];
    a.out = (float*)d_out; a.ws = (unsigned char*)d_ws;
    constexpr int NL = MK_N_LAUNCHES;
    for (int li = 0; li < NL; ++li) {
        constexpr bool ONE = (MK_N_LAUNCHES == 1);
        a.ph_lo = ONE ? 0 : li; a.ph_hi = ONE ? N_PHASES : li + 1; a.li = ONE ? 0 : li; a.pad = 0;
        hipLaunchKernelGGL(mk_fwd, dim3(grid), dim3(NWAVES * 64), LDS_BYTES, stream, a);
        const hipError_t le = hipPeekAtLastError();
        if (le != hipSuccess) { fprintf(stderr, "kernel_launch: launch %d failed: %s\n", li, hipGetErrorName(le)); break; }
    }
}
```
